# Optimizing an MI355X kernel written in HIP

```python
import jax, jax.numpy as jnp
from jax import lax
import numpy as np

D_MODEL = 1024
BATCH = 4
SEQ = 8192
DEPTH = 2

M_HEADS = 4
M_HEAD_DIM = D_MODEL // 8
M_WIDTH = M_HEADS * M_HEAD_DIM
A_HEADS = 8
A_HEAD_DIM = D_MODEL // 16
A_WIDTH = A_HEADS * A_HEAD_DIM
D_MIX = M_WIDTH + A_WIDTH
CONV_K = 4
MLSTM_CHUNK = 64
GATE_SOFTCAP = 15.0
MOBA_BLOCK = 256
MOBA_TOPK = 3
MOBA_Q_BLOCK = 64
ROPE_THETA = 500000.0
ROPE_DIM = A_HEAD_DIM // 4
N_EXPERTS = 32
TOP_K = 4
D_FF = D_MODEL
SWIGLU_LIMIT = 7.0
SWIGLU_ALPHA = 1.702
EXPERT_ROWS = 128
NORM_EPS = 1e-5
IN_SPLITS = (M_WIDTH, M_WIDTH, M_WIDTH, M_WIDTH, M_HEADS, M_HEADS, A_WIDTH, A_WIDTH, A_WIDTH)
N_IN = sum(IN_SPLITS)

kernel_name = 'hybrid_mlstm_moba_moe_adaln'


def rms_norm(x, g):
    xf = x.astype(jnp.float32)
    y = xf * lax.rsqrt(jnp.mean(xf * xf, axis=-1, keepdims=True) + NORM_EPS)
    return (y * g.astype(jnp.float32)).astype(x.dtype)


def soft_cap(t):
    t = t.astype(jnp.float32)
    return GATE_SOFTCAP * jnp.tanh(t / GATE_SOFTCAP)


def causal_depthwise_conv(x, w, b):
    y = lax.conv_general_dilated(x, w[:, None, :].astype(x.dtype), window_strides=(1,),
                                 padding=[(CONV_K - 1, 0)],
                                 dimension_numbers=('NWC', 'WIO', 'NWC'),
                                 feature_group_count=x.shape[-1])
    return y + b


def partial_rotary(x, positions):
    half = ROPE_DIM // 2
    inv_freq = ROPE_THETA ** (-jnp.arange(0, ROPE_DIM, 2, dtype=jnp.float32) / ROPE_DIM)
    ang = positions.astype(jnp.float32)[:, None, :, None] * inv_freq
    cos, sin = jnp.cos(ang), jnp.sin(ang)
    xr = x[..., :ROPE_DIM].astype(jnp.float32)
    x1, x2 = xr[..., :half], xr[..., half:]
    rot = jnp.concatenate([x1 * cos - x2 * sin, x2 * cos + x1 * sin], axis=-1)
    return jnp.concatenate([rot.astype(x.dtype), x[..., ROPE_DIM:]], axis=-1)


def mlstm_chunkwise(q, k, v, i_pre, f_pre):
    B, H, S, d = q.shape
    L = MLSTM_CHUNK
    nc = S // L
    f32 = jnp.float32
    q = q.astype(f32).reshape(B, H, nc, L, d)
    k = (k.astype(f32) * d ** -0.5).reshape(B, H, nc, L, d)
    v = v.astype(f32).reshape(B, H, nc, L, d)
    ig = i_pre.astype(f32).reshape(B, H, nc, L)
    b = jnp.cumsum(jax.nn.log_sigmoid(f_pre.astype(f32)).reshape(B, H, nc, L), axis=-1)
    g = b[..., -1]
    w = g[..., None] - b + ig
    wmax = jnp.max(w, axis=-1)
    ew = jnp.exp(w - wmax[..., None])
    kv = jnp.einsum('bhcl,bhcld,bhcle->cbhde', ew, k, v)
    ksum = jnp.einsum('bhcl,bhcld->cbhd', ew, k)

    def step(carry, inp):
        c_st, n_st, m_st = carry
        kv_c, ks_c, g_c, wm_c = inp
        m_new = jnp.maximum(g_c + m_st, wm_c)
        decay = jnp.exp(g_c + m_st - m_new)
        inj = jnp.exp(wm_c - m_new)
        c_new = decay[..., None, None] * c_st + inj[..., None, None] * kv_c
        n_new = decay[..., None] * n_st + inj[..., None] * ks_c
        return (c_new, n_new, m_new), (c_st, n_st, m_st)

    init = (jnp.zeros((B, H, d, d), f32), jnp.zeros((B, H, d), f32), jnp.full((B, H), -jnp.inf, f32))
    _, (c_prev, n_prev, m_prev) = lax.scan(step, init, (kv, ksum, g.transpose(2, 0, 1), wmax.transpose(2, 0, 1)))
    m_prev = m_prev.transpose(1, 2, 0)
    a = b + m_prev[..., None]
    causal = jnp.tril(jnp.ones((L, L), dtype=bool))
    dmat = jnp.where(causal, b[..., :, None] - b[..., None, :] + ig[..., None, :], -jnp.inf)
    m_t = jnp.maximum(a, jnp.max(dmat, axis=-1))
    s = jnp.einsum('bhctd,bhcsd->bhcts', q, k) * jnp.exp(dmat - m_t[..., None])
    inter = jnp.exp(a - m_t)
    num = jnp.einsum('bhcts,bhcse->bhcte', s, v) + inter[..., None] * jnp.einsum('bhctd,cbhde->bhcte', q, c_prev)
    den = jnp.sum(s, axis=-1) + inter * jnp.einsum('bhctd,cbhd->bhct', q, n_prev)
    h = num / jnp.maximum(jnp.abs(den), jnp.exp(-m_t))[..., None]
    return h.reshape(B, H, S, d)


def moba_attention(q, k, v):
    B, H, S, dh = q.shape
    nb = -(-S // MOBA_BLOCK)
    pad = nb * MOBA_BLOCK - S
    kp = jnp.pad(k, ((0, 0), (0, 0), (0, pad), (0, 0)))
    vp = jnp.pad(v, ((0, 0), (0, 0), (0, pad), (0, 0)))
    kb = kp.reshape(B, H, nb, MOBA_BLOCK, dh)
    vb = vp.reshape(B, H, nb, MOBA_BLOCK, dh)
    kmean = jnp.mean(kb.astype(jnp.float32), axis=3)
    n_sel = min(MOBA_TOPK, nb)
    scale = dh ** -0.5
    bi = jnp.arange(B)[:, None, None, None]
    hi = jnp.arange(H)[None, :, None, None]
    blk_ids = jnp.arange(nb)

    def one_query_block(ci):
        start = ci * MOBA_Q_BLOCK
        own = start // MOBA_BLOCK
        qb = lax.dynamic_slice_in_dim(q, start, MOBA_Q_BLOCK, axis=2).astype(jnp.float32)
        gate = jnp.einsum('bhqd,bhnd->bhqn', qb, kmean)
        gate = jnp.where(blk_ids < own, gate, -jnp.inf)
        topv, topi = lax.top_k(gate, n_sel)
        sel_ok = topv > -jnp.inf
        kg = kb[bi, hi, topi]
        vg = vb[bi, hi, topi]
        s_sel = jnp.einsum('bhqd,bhqjkd->bhqjk', qb, kg) * scale
        s_sel = jnp.where(sel_ok[..., None], s_sel, -jnp.inf).reshape(B, H, MOBA_Q_BLOCK, n_sel * MOBA_BLOCK)
        kown = lax.dynamic_slice_in_dim(kp, own * MOBA_BLOCK, MOBA_BLOCK, axis=2)
        vown = lax.dynamic_slice_in_dim(vp, own * MOBA_BLOCK, MOBA_BLOCK, axis=2)
        s_own = jnp.einsum('bhqd,bhkd->bhqk', qb, kown) * scale
        qpos = start + jnp.arange(MOBA_Q_BLOCK)
        kpos = own * MOBA_BLOCK + jnp.arange(MOBA_BLOCK)
        s_own = jnp.where(kpos[None, :] <= qpos[:, None], s_own, -jnp.inf)
        p = jax.nn.softmax(jnp.concatenate([s_sel, s_own], axis=-1), axis=-1)
        p_sel = p[..., :n_sel * MOBA_BLOCK].reshape(B, H, MOBA_Q_BLOCK, n_sel, MOBA_BLOCK)
        out = jnp.einsum('bhqjk,bhqjkd->bhqd', p_sel, vg) + jnp.einsum('bhqk,bhkd->bhqd', p[..., n_sel * MOBA_BLOCK:], vown)
        return out.astype(q.dtype)

    out = lax.map(one_query_block, jnp.arange(S // MOBA_Q_BLOCK))
    return out.transpose(1, 2, 0, 3, 4).reshape(B, H, S, dh)


def hybrid_mixer(h, positions, w_in, conv_w, conv_b, b_igate, b_fgate, mlstm_norm_g, w_out):
    B, S, _ = h.shape
    offsets = np.cumsum(IN_SPLITS)[:-1].tolist()
    z = h @ w_in
    mq, mk, mv, mo, mi, mf, aq, ak, av = jnp.split(z, offsets, axis=-1)

    def heads(t, n, d):
        return t.reshape(B, S, n, d).transpose(0, 2, 1, 3)

    qk = jax.nn.silu(causal_depthwise_conv(jnp.concatenate([mq, mk], axis=-1), conv_w, conv_b))
    mq, mk = jnp.split(qk, 2, axis=-1)
    i_pre = soft_cap(mi + b_igate).transpose(0, 2, 1)
    f_pre = soft_cap(mf + b_fgate).transpose(0, 2, 1)
    hm = mlstm_chunkwise(heads(mq, M_HEADS, M_HEAD_DIM), heads(mk, M_HEADS, M_HEAD_DIM),
                         heads(mv, M_HEADS, M_HEAD_DIM), i_pre, f_pre)
    hm = hm.transpose(0, 2, 1, 3) * jax.nn.sigmoid(mo.astype(jnp.float32)).reshape(B, S, M_HEADS, M_HEAD_DIM)
    hm = rms_norm(hm, mlstm_norm_g.reshape(M_HEADS, M_HEAD_DIM)).reshape(B, S, M_WIDTH).astype(h.dtype)

    qa = partial_rotary(heads(aq, A_HEADS, A_HEAD_DIM), positions)
    ka = partial_rotary(heads(ak, A_HEADS, A_HEAD_DIM), positions)
    ha = moba_attention(qa, ka, heads(av, A_HEADS, A_HEAD_DIM))
    ha = ha.transpose(0, 2, 1, 3).reshape(B, S, A_WIDTH)

    return jnp.concatenate([hm, ha], axis=-1) @ w_out


def moe_ffn(h, w_router, b_router, w_gate, b_gate, w_up, b_up, w_down, b_down):
    B, S, D = h.shape
    T = B * S
    A = T * TOP_K
    xt = h.reshape(T, D)
    logits = (xt @ w_router + b_router).astype(jnp.float32)
    topv, topi = lax.top_k(logits, TOP_K)
    probs = jax.nn.softmax(topv, axis=-1)
    flat_e = topi.reshape(A)
    flat_tok = jnp.arange(A, dtype=jnp.int32) // TOP_K
    flat_p = probs.reshape(A)
    order = jnp.argsort(flat_e)
    se, stok, sp = flat_e[order], flat_tok[order], flat_p[order]
    counts = jnp.bincount(flat_e, length=N_EXPERTS)
    start = jnp.cumsum(counts) - counts
    nblk = (counts + EXPERT_ROWS - 1) // EXPERT_ROWS
    blk_end = jnp.cumsum(nblk)
    blk_start = blk_end - nblk
    slot = blk_start[se] * EXPERT_ROWS + (jnp.arange(A) - start[se])
    n_blocks = (A + EXPERT_ROWS - 1) // EXPERT_ROWS + N_EXPERTS
    P = n_blocks * EXPERT_ROWS
    slot_tok = jnp.zeros((P,), jnp.int32).at[slot].set(stok)
    slot_p = jnp.zeros((P,), jnp.float32).at[slot].set(sp)
    block_e = jnp.minimum(jnp.searchsorted(blk_end, jnp.arange(n_blocks), side='right'), N_EXPERTS - 1)

    def expert_block(args):
        tok, e = args
        xb = xt[tok]
        gt = jnp.minimum(xb @ w_gate[e] + b_gate[e], SWIGLU_LIMIT)
        up = jnp.clip(xb @ w_up[e] + b_up[e], -SWIGLU_LIMIT, SWIGLU_LIMIT)
        act = (up + 1.0) * (gt * jax.nn.sigmoid(SWIGLU_ALPHA * gt))
        return act @ w_down[e] + b_down[e]

    yb = lax.map(expert_block, (slot_tok.reshape(n_blocks, EXPERT_ROWS), block_e))
    yb = yb.reshape(P, D) * slot_p[:, None].astype(yb.dtype)
    y = jnp.zeros((T, D), yb.dtype).at[slot_tok].add(yb)
    return y.reshape(B, S, D).astype(h.dtype)


def setup_inputs(seed: int = 0) -> dict:
    key = jax.random.key(seed)
    ks = jax.random.split(key, 24)
    f32 = jnp.float32

    def nrm(k, shape, scale):
        return jax.random.normal(k, shape, f32) * scale

    x = nrm(ks[0], (BATCH, SEQ, D_MODEL), 1.0)
    c = nrm(ks[1], (BATCH, D_MODEL), 1.0)
    positions = jnp.arange(SEQ, dtype=jnp.int32)[None, :] + jax.random.randint(ks[2], (BATCH, 1), 0, 4096, dtype=jnp.int32)
    w_ada = nrm(ks[3], (DEPTH, D_MODEL, 6 * D_MODEL), 0.5 * D_MODEL ** -0.5)
    b_ada = nrm(ks[4], (DEPTH, 6 * D_MODEL), 0.02)
    norm1_g = 1.0 + nrm(ks[5], (DEPTH, D_MODEL), 0.05)
    w_in = nrm(ks[6], (DEPTH, D_MODEL, N_IN), D_MODEL ** -0.5)
    conv_w = nrm(ks[7], (DEPTH, CONV_K, 2 * M_WIDTH), CONV_K ** -0.5)
    conv_b = nrm(ks[8], (DEPTH, 2 * M_WIDTH), 0.02)
    b_igate = nrm(ks[9], (DEPTH, M_HEADS), 0.1)
    b_fgate = jnp.linspace(3.0, 6.0, M_HEADS, dtype=f32)[None, :] + nrm(ks[10], (DEPTH, M_HEADS), 0.1)
    mlstm_norm_g = 1.0 + nrm(ks[11], (DEPTH, M_WIDTH), 0.05)
    w_out = nrm(ks[12], (DEPTH, D_MIX, D_MODEL), D_MIX ** -0.5)
    norm2_g = 1.0 + nrm(ks[13], (DEPTH, D_MODEL), 0.05)
    w_router = nrm(ks[14], (DEPTH, D_MODEL, N_EXPERTS), D_MODEL ** -0.5)
    b_router = nrm(ks[15], (DEPTH, N_EXPERTS), 0.01)
    w_gate = nrm(ks[16], (DEPTH, N_EXPERTS, D_MODEL, D_FF), D_MODEL ** -0.5)
    b_gate = nrm(ks[17], (DEPTH, N_EXPERTS, D_FF), 0.01)
    w_up = nrm(ks[18], (DEPTH, N_EXPERTS, D_MODEL, D_FF), D_MODEL ** -0.5)
    b_up = nrm(ks[19], (DEPTH, N_EXPERTS, D_FF), 0.01)
    w_down = nrm(ks[20], (DEPTH, N_EXPERTS, D_FF, D_MODEL), D_FF ** -0.5)
    b_down = nrm(ks[21], (DEPTH, N_EXPERTS, D_MODEL), 0.01)
    final_norm_g = 1.0 + nrm(ks[22], (D_MODEL,), 0.05)
    return {'x': x, 'c': c, 'positions': positions, 'w_ada': w_ada, 'b_ada': b_ada, 'norm1_g': norm1_g,
            'w_in': w_in, 'conv_w': conv_w, 'conv_b': conv_b, 'b_igate': b_igate, 'b_fgate': b_fgate,
            'mlstm_norm_g': mlstm_norm_g, 'w_out': w_out, 'norm2_g': norm2_g, 'w_router': w_router,
            'b_router': b_router, 'w_gate': w_gate, 'b_gate': b_gate, 'w_up': w_up, 'b_up': b_up,
            'w_down': w_down, 'b_down': b_down, 'final_norm_g': final_norm_g}


def reference(x, c, positions, w_ada, b_ada, norm1_g, w_in, conv_w, conv_b, b_igate, b_fgate,
              mlstm_norm_g, w_out, norm2_g, w_router, b_router, w_gate, b_gate, w_up, b_up,
              w_down, b_down, final_norm_g):
    cond = jax.nn.silu(c)
    for l in range(DEPTH):
        mod = cond @ w_ada[l] + b_ada[l]
        sh1, sc1, g1, sh2, sc2, g2 = [m[:, None, :] for m in jnp.split(mod, 6, axis=-1)]
        h = rms_norm(x, norm1_g[l]) * (1.0 + sc1) + sh1
        y = hybrid_mixer(h, positions, w_in[l], conv_w[l], conv_b[l], b_igate[l], b_fgate[l],
                         mlstm_norm_g[l], w_out[l])
        x = x + g1 * y
        h = rms_norm(x, norm2_g[l]) * (1.0 + sc2) + sh2
        y = moe_ffn(h, w_router[l], b_router[l], w_gate[l], b_gate[l], w_up[l], b_up[l], w_down[l], b_down[l])
        x = x + g2 * y
    return rms_norm(x, final_norm_g)
```

```cpp
#include <hip/hip_runtime.h>
#include <cstdio>
#include <cstdint>

#ifndef MK_ONE_LAUNCH
#define MK_ONE_LAUNCH 0
#endif

#define LAS __attribute__((address_space(3)))
typedef unsigned short bf16_t;
typedef short bf16x8 __attribute__((ext_vector_type(8)));
typedef float f32x4 __attribute__((ext_vector_type(4)));
typedef unsigned u32x4 __attribute__((ext_vector_type(4)));
typedef unsigned u32x2 __attribute__((ext_vector_type(2)));

constexpr int D = 1024, NB = 4, SEQ = 8192, T = NB * SEQ;
constexpr int NIN = 3592, NZ = 3584;
constexpr int ZQ = 0, ZK = 512, ZV = 1024, ZO = 1536, ZAQ = 2048, ZAK = 2560, ZAV = 3072;
constexpr int NE = 32;
constexpr int MAXT = 544;
constexpr float EPS = 1e-5f;
constexpr int NPH = 22;

constexpr size_t MiB = 1u << 20;
constexpr size_t WS_CTL = 0, CTL_BYTES = 1 * MiB;
constexpr size_t WS_MOD = 1 * MiB;
constexpr size_t WS_IG = 2 * MiB, WS_LF = 2 * MiB + 512 * 1024;
constexpr size_t WS_KPART = 3 * MiB;
constexpr size_t WS_G = 4 * MiB, WS_WMAX = 4 * MiB + 8192, WS_MPREV = 4 * MiB + 16384;
constexpr size_t WS_KS = 5 * MiB;
constexpr size_t WS_PE = 6 * MiB, WS_PROB = 6 * MiB + 512 * 1024;
constexpr size_t WS_ELIST = 7 * MiB;
constexpr size_t WS_PARTL = 11 * MiB;
constexpr size_t WS_WIN = 16 * MiB, WS_WOUT = 30 * MiB;
constexpr size_t WS_WGU = 36 * MiB, WS_WD = 164 * MiB;
constexpr size_t WS_X = 228 * MiB, WS_H = 356 * MiB, WS_POOL = 420 * MiB;
constexpr size_t WS_Z = WS_POOL, WS_CAT = WS_POOL + 224 * MiB, WS_PARTO = WS_POOL + 288 * MiB, WS_KVT = WS_POOL + 416 * MiB, WS_QLIST = WS_POOL + 480 * MiB;
constexpr size_t WS_ACT = WS_POOL, WS_YB = WS_POOL + 272 * MiB;
constexpr size_t WS_END = WS_POOL + 544 * MiB;
constexpr int CW_BAR = 1024;
constexpr int CW_ECNT = 8192;
constexpr int CW_QLEN = 16384;

constexpr int LDS_BYTES = 147456;

__device__ __forceinline__ unsigned f2bf(float f) { unsigned u = __builtin_bit_cast(unsigned, f); return (u + 0x7fffu + ((u >> 16) & 1u)) >> 16; }
__device__ __forceinline__ unsigned pk2(float lo, float hi) { return f2bf(lo) | (f2bf(hi) << 16); }
__device__ __forceinline__ float bf2f(unsigned b) { return __builtin_bit_cast(float, (b & 0xffffu) << 16); }
__device__ __forceinline__ float bflo(unsigned w) { return __builtin_bit_cast(float, w << 16); }
__device__ __forceinline__ float bfhi(unsigned w) { return __builtin_bit_cast(float, w & 0xffff0000u); }
__device__ __forceinline__ float wave_sum(float v) {
#pragma unroll
    for (int o = 1; o < 64; o <<= 1) v += __shfl_xor(v, o);
    return v;
}
__device__ __forceinline__ float sigmoidf_(float x) { return 1.0f / (1.0f + __expf(-x)); }
#define LDS_WAIT() asm volatile("s_waitcnt lgkmcnt(0)" ::: "memory")

#define XB_TMO      128
#define XB_XCNT(j)  (256  + 64 * (j))
#define XB_XSUB(j)  (1280 + 64 * (j))
#define XB_XGEN(j)  (2304 + 64 * (j))
#define XB_TOP      3328
#define XB_TOPGEN   3392
#define XCD_BAR_WORDS 3456
#define XB_SPIN_CAP (1u << 18)
__device__ __forceinline__ unsigned xb_ld(unsigned* p)              { return __hip_atomic_load(p, __ATOMIC_RELAXED, __HIP_MEMORY_SCOPE_AGENT); }
__device__ __forceinline__ unsigned xb_add(unsigned* p, unsigned v) { return __hip_atomic_fetch_add(p, v, __ATOMIC_RELAXED, __HIP_MEMORY_SCOPE_AGENT); }
__device__ __forceinline__ unsigned xb_xcc_id() { return (unsigned)__builtin_amdgcn_s_getreg((3 << 11) | 20) & 0xFu; }
#define XB_SPIN(cond, bar) do { unsigned _sp = 0; while (cond) { __builtin_amdgcn_s_sleep(1); \
    if ((++_sp & 255u) == 0u) { if (xb_ld(&(bar)[XB_TMO])) break; if (_sp > XB_SPIN_CAP) { atomicAdd(&(bar)[XB_TMO], 1u); break; } } } } while (0)
struct XcdBarrier { unsigned* bar; unsigned x; volatile LAS unsigned* st; };
__device__ __forceinline__ XcdBarrier xcd_barrier_post(unsigned* bar, volatile LAS unsigned* st) {
    XcdBarrier b; b.bar = bar; b.x = xb_xcc_id(); b.st = st;
    if (threadIdx.x == 0) (void)xb_add(&bar[XB_XCNT(b.x)], 1u);
    return b;
}
__device__ __forceinline__ void xcd_barrier_complete(unsigned* bar, unsigned x, unsigned& nloc, unsigned& nx) {
    const unsigned G = gridDim.x * gridDim.y * gridDim.z;
    unsigned sum, cnt, mine, sp = 0u;
    for (;;) {
        sum = 0u; cnt = 0u; mine = 0u;
#pragma unroll
        for (unsigned j = 0; j < 16; ++j) { const unsigned c = xb_ld(&bar[XB_XCNT(j)]); sum += c; cnt += (c > 0u) ? 1u : 0u; mine = (j == x) ? c : mine; }
        if (sum == G) break;
        __builtin_amdgcn_s_sleep(1);
        if ((++sp & 255u) == 0u) { if (xb_ld(&bar[XB_TMO])) break; if (sp > XB_SPIN_CAP) { atomicAdd(&bar[XB_TMO], 1u); break; } }
    }
    nloc = mine > 0u ? mine : 1u; nx = cnt > 0u ? cnt : 1u;
}
__device__ __forceinline__ void xcd_barrier(const XcdBarrier& b) {
    asm volatile("s_waitcnt vmcnt(0)" ::: "memory");
    __syncthreads();
    if (threadIdx.x == 0) {
        unsigned* bar = b.bar;
        __builtin_amdgcn_s_waitcnt(0);
        unsigned nloc = b.st[0], nx = b.st[1];
        if (nloc == 0u) { xcd_barrier_complete(bar, b.x, nloc, nx); b.st[0] = nloc; b.st[1] = nx; }
        const unsigned old = xb_add(&bar[XB_XSUB(b.x)], 1u);
        const unsigned gen = old / nloc;
        if (old + 1u == (gen + 1u) * nloc) {
            __builtin_amdgcn_fence(__ATOMIC_RELEASE, "agent");
            asm volatile("s_waitcnt vmcnt(0)" ::: "memory");
            const unsigned og = xb_add(&bar[XB_TOP], 1u);
            const unsigned tg = og / nx;
            if (og + 1u == (tg + 1u) * nx) xb_add(&bar[XB_TOPGEN], 1u);
            else XB_SPIN(xb_ld(&bar[XB_TOPGEN]) == tg, bar);
            __builtin_amdgcn_fence(__ATOMIC_ACQUIRE, "agent");
            xb_add(&bar[XB_XGEN(b.x)], 1u);
            asm volatile("s_waitcnt vmcnt(0)" ::: "memory");
        } else {
            XB_SPIN(xb_ld(&bar[XB_XGEN(b.x)]) == gen, bar);
            __builtin_amdgcn_fence(__ATOMIC_ACQUIRE, "agent");
            asm volatile("s_waitcnt vmcnt(0)" ::: "memory");
        }
    }
    __syncthreads();
}

namespace pg8 {
constexpr int BM = 256, BK = 64, HALF = 128, HTB = HALF * BK * 2, STAGE_BYTES = 8 * HTB, NXCD = 8, WGM = 8;
__device__ __forceinline__ int lds_byte(int r, int c) { const int st = (r >> 4) * 2 + (c >> 5), rr = r & 15, cc = c & 31, ob = rr * 64 + cc * 2; return st * 1024 + (ob ^ (((ob >> 9) & 1) << 5)); }
__device__ __forceinline__ void stage_rc(int b, int& R, int& C) { const int st = b / 1024, sb = b % 1024, swz = sb ^ (((sb >> 9) & 1) << 5); R = (st >> 1) * 16 + swz / 64; C = (st & 1) * 32 + (swz % 64) / 2; }
__device__ __forceinline__ int perm32(int rho) { const int n = rho >> 4, i = rho & 15; return 8 * (i >> 2) + 4 * n + (i & 3); }

struct Unit { int pm, pn, pb, e; };

struct StaticOrder {
    int nM, nN, nwg, G, c;
    __device__ __forceinline__ void init(int M, int N, int G_, int c_) { nM = M / BM; nN = N / BM; nwg = nM * nN; G = G_; c = c_; }
    __device__ __forceinline__ bool next(int i, Unit& u) const {
        const long L = (long)i * G + c; if (L >= nwg) return false;
        int wgid = (int)L; { const int q = nwg / NXCD, r = nwg % NXCD, xcd = wgid % NXCD, off = wgid / NXCD; wgid = (xcd < r ? xcd * (q + 1) : r * (q + 1) + (xcd - r) * q) + off; }
        const int nig = WGM * nN, gid = wgid / nig, fm = gid * WGM, gsz = (nM - fm) < WGM ? (nM - fm) : WGM;
        u.pm = fm + ((wgid % nig) % gsz); u.pn = (wgid % nig) / gsz; u.pb = u.pn; u.e = 0; return true;
    }
    __device__ __forceinline__ int arow(const Unit& u, int r) const { return u.pm * BM + r; }
};
struct MoeOrder {
    const LAS int* tb; const LAS int* cnt; const int* elist; int npn, G, c, gather;
    __device__ __forceinline__ bool next(int i, Unit& u) const {
        const int L = i * G + c; const int NT = tb[32];
        if (L >= NT * npn) return false;
        const int mt = L / npn; u.pn = L - mt * npn; u.pm = mt;
        int e = 0;
        for (int j = 1; j < 32; ++j) e += (tb[j] <= mt) ? 1 : 0;
        u.e = e; u.pb = e * npn + u.pn; return true;
    }
    __device__ __forceinline__ int arow(const Unit& u, int r) const {
        if (!gather) return u.pm * BM + r;
        const int rank = (u.pm - tb[u.e]) * BM + r;
        int row = 0;
        if (rank < cnt[u.e]) row = elist[u.e * 32768 + rank];
        return row;
    }
};

__device__ __forceinline__ unsigned cvt_pk_bf16(float lo, float hi) { unsigned r; asm volatile("v_cvt_pk_bf16_f32 %0, %1, %2" : "=v"(r) : "v"(lo), "v"(hi)); return r; }

struct EpiZ {
    static constexpr bool PERM = true;
    bf16_t* O; int ldc;
    __device__ __forceinline__ void operator()(const f32x4 (&acc)[2][2][4][2], const Unit& u, int wr, int wc, int fr, int fq) const {
        const int row0 = u.pm * BM + wr * 64 + fr, col0 = u.pn * BM + wc * 32 + 8 * fq;
#pragma unroll
        for (int ai = 0; ai < 2; ++ai)
#pragma unroll
            for (int m = 0; m < 4; ++m) { bf16_t* rowp = O + (size_t)(row0 + ai * HALF + m * 16) * ldc + col0;
#pragma unroll
                for (int bj = 0; bj < 2; ++bj) { const f32x4 v0 = acc[ai][bj][m][0], v1 = acc[ai][bj][m][1];
                    u32x4 w; w.x = cvt_pk_bf16(v0[0], v0[1]); w.y = cvt_pk_bf16(v0[2], v0[3]); w.z = cvt_pk_bf16(v1[0], v1[1]); w.w = cvt_pk_bf16(v1[2], v1[3]);
                    *(u32x4*)(rowp + bj * HALF) = w; } }
    }
};
struct EpiRes {
    static constexpr bool PERM = false;
    const float* Xin; float* Xout; const float* gate;
    __device__ __forceinline__ void operator()(const f32x4 (&acc)[2][2][4][2], const Unit& u, int wr, int wc, int fr, int fq) const {
        const int row0 = u.pm * BM + wr * 64 + fr, col0 = u.pn * BM + wc * 32 + 4 * fq;
        const int b = (u.pm * BM) >> 13;
        f32x4 gv[2][2];
#pragma unroll
        for (int bj = 0; bj < 2; ++bj)
#pragma unroll
            for (int n = 0; n < 2; ++n) gv[bj][n] = *(const f32x4*)(gate + b * 6144 + col0 + bj * HALF + n * 16);
#pragma unroll
        for (int ai = 0; ai < 2; ++ai)
#pragma unroll
            for (int m = 0; m < 4; ++m) { const size_t off = (size_t)(row0 + ai * HALF + m * 16) * D + col0;
#pragma unroll
                for (int bj = 0; bj < 2; ++bj)
#pragma unroll
                    for (int n = 0; n < 2; ++n) { const f32x4 xi = *(const f32x4*)(Xin + off + bj * HALF + n * 16);
                        *(f32x4*)(Xout + off + bj * HALF + n * 16) = xi + gv[bj][n] * acc[ai][bj][m][n]; } }
    }
};
struct EpiSwiglu {
    static constexpr bool PERM = true;
    bf16_t* O; const float* bg; const float* bu;
    __device__ __forceinline__ void operator()(const f32x4 (&acc)[2][2][4][2], const Unit& u, int wr, int wc, int fr, int fq) const {
        const int row0 = u.pm * BM + wr * 64 + fr, j0 = u.pn * HALF + wc * 32 + 8 * fq;
        f32x4 g0 = *(const f32x4*)(bg + u.e * 1024 + j0), g1 = *(const f32x4*)(bg + u.e * 1024 + j0 + 4);
        f32x4 u0 = *(const f32x4*)(bu + u.e * 1024 + j0), u1 = *(const f32x4*)(bu + u.e * 1024 + j0 + 4);
#pragma unroll
        for (int ai = 0; ai < 2; ++ai)
#pragma unroll
            for (int m = 0; m < 4; ++m) { bf16_t* rowp = O + (size_t)(row0 + ai * HALF + m * 16) * D + j0;
                float r[8];
#pragma unroll
                for (int n = 0; n < 2; ++n)
#pragma unroll
                    for (int j = 0; j < 4; ++j) {
                        float gt = acc[ai][0][m][n][j] + (n ? g1[j] : g0[j]); float up = acc[ai][1][m][n][j] + (n ? u1[j] : u0[j]);
                        gt = fminf(gt, 7.0f); up = fminf(fmaxf(up, -7.0f), 7.0f);
                        r[n * 4 + j] = (up + 1.0f) * (gt / (1.0f + __expf(-1.702f * gt))); }
                u32x4 w; w.x = cvt_pk_bf16(r[0], r[1]); w.y = cvt_pk_bf16(r[2], r[3]); w.z = cvt_pk_bf16(r[4], r[5]); w.w = cvt_pk_bf16(r[6], r[7]);
                *(u32x4*)rowp = w; }
    }
};
struct EpiDown {
    static constexpr bool PERM = true;
    bf16_t* O; const float* bd;
    __device__ __forceinline__ void operator()(const f32x4 (&acc)[2][2][4][2], const Unit& u, int wr, int wc, int fr, int fq) const {
        const int row0 = u.pm * BM + wr * 64 + fr, col0 = u.pn * BM + wc * 32 + 8 * fq;
#pragma unroll
        for (int bj = 0; bj < 2; ++bj) {
            const f32x4 b0 = *(const f32x4*)(bd + u.e * 1024 + col0 + bj * HALF), b1 = *(const f32x4*)(bd + u.e * 1024 + col0 + bj * HALF + 4);
#pragma unroll
            for (int ai = 0; ai < 2; ++ai)
#pragma unroll
                for (int m = 0; m < 4; ++m) { bf16_t* rowp = O + (size_t)(row0 + ai * HALF + m * 16) * D + col0 + bj * HALF;
                    const f32x4 v0 = acc[ai][bj][m][0] + b0, v1 = acc[ai][bj][m][1] + b1;
                    u32x4 w; w.x = cvt_pk_bf16(v0[0], v0[1]); w.y = cvt_pk_bf16(v0[2], v0[3]); w.z = cvt_pk_bf16(v1[0], v1[1]); w.w = cvt_pk_bf16(v1[2], v1[3]);
                    *(u32x4*)rowp = w; }
            asm volatile("" ::: "memory");
        }
    }
};

template <class Epi, class Sched>
__device__ __forceinline__ void gemm_phase(LAS unsigned char* lds, const bf16_t* A, const bf16_t* Bt, const int K, const Sched& S, const Epi& E) {
    const int tid = threadIdx.x, wid = __builtin_amdgcn_readfirstlane(tid >> 6), lane = tid & 63, wr = wid >> 2, wc = wid & 3, fr = lane & 15, fq = lane >> 4;
    const int nt = K / BK;
    unsigned voffB[2];
#pragma unroll
    for (int i = 0; i < 2; ++i) { int R, C; stage_rc(tid * 16 + i * 8192, R, C); const int Rb = Epi::PERM ? ((R & ~31) + perm32(R & 31)) : R;
        voffB[i] = (unsigned)(Rb * K + C) * 2u; }
    const size_t kstep = (size_t)(BK * 2);
    const size_t hstep = (size_t)HALF * K * 2;
    const size_t tstep = 2 * hstep;
    const unsigned ldsw = (unsigned)wid * 1024u;
    const int aoff = lds_byte(wr * 64 + fr, fq * 8), boff = lds_byte(wc * 32 + fr, fq * 8);
#define PG8_SA(b, h) (((b) * 2 + (h)) * HTB)
#define PG8_SB(b, h) ((4 + (b) * 2 + (h)) * HTB)
#define PG8_STAGE(bufoff, gbase, voff) do { _Pragma("unroll") for (int _i = 0; _i < 2; ++_i) \
        __builtin_amdgcn_global_load_lds((const unsigned*)((const char*)(gbase) + (voff)[_i]), (LAS unsigned*)(lds + (bufoff) + ldsw + _i * 8192), 16, 0, 0); } while (0)
#define PG8_LDA(dst, b, h) do { _Pragma("unroll") for (int m = 0; m < 4; ++m) _Pragma("unroll") for (int k = 0; k < 2; ++k) dst[m][k] = *(const LAS bf16x8*)(lds + PG8_SA(b, h) + aoff + m * 2048 + k * 1024); } while (0)
#define PG8_LDB(dst, b, h) do { _Pragma("unroll") for (int n = 0; n < 2; ++n) _Pragma("unroll") for (int k = 0; k < 2; ++k) dst[n][k] = *(const LAS bf16x8*)(lds + PG8_SB(b, h) + boff + n * 2048 + k * 1024); } while (0)
#define PG8_MMA(ai, bj, At, Bt_) do { __builtin_amdgcn_s_setprio(1); _Pragma("unroll") for (int m = 0; m < 4; ++m) _Pragma("unroll") for (int n = 0; n < 2; ++n) _Pragma("unroll") for (int k = 0; k < 2; ++k) \
        acc[ai][bj][m][n] = __builtin_amdgcn_mfma_f32_16x16x32_bf16(Bt_[n][k], At[m][k], acc[ai][bj][m][n], 0, 0, 0); __builtin_amdgcn_s_setprio(0); } while (0)
#define PG8_WAIT_V(n) asm volatile("s_waitcnt vmcnt(" #n ")" ::: "memory")
#define PG8_WAIT_L(n) asm volatile("s_waitcnt lgkmcnt(" #n ")" ::: "memory")
#define PG8_BAR __builtin_amdgcn_s_barrier()
#define PG8_SCHED __builtin_amdgcn_sched_barrier(0)
#define PG8_OFFS(u, o) do { _Pragma("unroll") for (int _i = 0; _i < 2; ++_i) { int _R, _C; stage_rc(tid * 16 + _i * 8192, _R, _C); \
        _Pragma("unroll") for (int _h = 0; _h < 2; ++_h) { unsigned _o = (unsigned)(S.arow(u, _h * HALF + _R) * K + _C) * 2u; asm volatile("" : "+v"(_o)); o[_h][_i] = _o; } } } while (0)
    Unit cur, nxt; int ui = 0;
    if (!S.next(0, cur)) return;
    f32x4 acc[2][2][4][2];
#pragma unroll
    for (int a = 0; a < 2; ++a)
#pragma unroll
        for (int b = 0; b < 2; ++b)
#pragma unroll
            for (int m = 0; m < 4; ++m)
#pragma unroll
                for (int n = 0; n < 2; ++n) acc[a][b][m][n] = (f32x4){0.f, 0.f, 0.f, 0.f};
    bf16x8 At[4][2], B0[2][2], B1[2][2];
    unsigned oC[2][2];
    PG8_OFFS(cur, oC);
    const char* Ab = (const char*)A;
    const char* cB = (const char*)Bt + (size_t)cur.pb * tstep;
    PG8_STAGE(PG8_SB(0, 0), cB, voffB); PG8_STAGE(PG8_SA(0, 0), Ab, oC[0]); PG8_STAGE(PG8_SB(0, 1), cB + hstep, voffB); PG8_STAGE(PG8_SA(0, 1), Ab, oC[1]);
    if (wr == 1) PG8_BAR;
    PG8_WAIT_V(4); PG8_BAR;
    PG8_STAGE(PG8_SB(1, 0), cB + kstep, voffB); PG8_STAGE(PG8_SA(1, 0), Ab + kstep, oC[0]); PG8_STAGE(PG8_SB(1, 1), cB + hstep + kstep, voffB);
    PG8_WAIT_V(6); PG8_BAR;
    for (;;) {
        const bool has_next = S.next(ui + 1, nxt);
        const char* nB = has_next ? (const char*)Bt + (size_t)nxt.pb * tstep : cB;
        for (int t = 0; t < nt; t += 2) {
            const bool last = (t == nt - 2);
            const char* a1 = Ab + (size_t)(t + 1) * kstep;
            const char* a2 = last ? Ab : Ab + (size_t)(t + 2) * kstep; const char* b2 = last ? nB : cB + (size_t)(t + 2) * kstep;
            const char* a3 = a2 + kstep; const char* b3 = b2 + kstep;
            PG8_LDB(B0, 0, 0); PG8_SCHED; PG8_LDA(At, 0, 0); PG8_STAGE(PG8_SA(1, 1), a1, oC[1]);
            PG8_WAIT_L(8); PG8_BAR; PG8_WAIT_L(0); PG8_MMA(0, 0, At, B0); PG8_BAR; PG8_SCHED;
            if (last && has_next) { PG8_OFFS(nxt, oC); }
            PG8_LDB(B1, 0, 1); PG8_STAGE(PG8_SB(0, 0), b2, voffB);
            PG8_BAR; PG8_WAIT_L(0); PG8_MMA(0, 1, At, B1); PG8_BAR;
            PG8_LDA(At, 0, 1); PG8_STAGE(PG8_SA(0, 0), a2, oC[0]);
            PG8_BAR; PG8_WAIT_L(0); PG8_MMA(1, 0, At, B0); PG8_BAR; PG8_SCHED;
            PG8_STAGE(PG8_SB(0, 1), b2 + hstep, voffB);
            PG8_WAIT_V(6); PG8_BAR; PG8_MMA(1, 1, At, B1); PG8_BAR;
            PG8_LDB(B0, 1, 0); PG8_SCHED; PG8_LDA(At, 1, 0); PG8_STAGE(PG8_SA(0, 1), a2, oC[1]);
            PG8_WAIT_L(8); PG8_BAR; PG8_WAIT_L(0); PG8_MMA(0, 0, At, B0); PG8_BAR; PG8_SCHED;
            PG8_LDB(B1, 1, 1); PG8_STAGE(PG8_SB(1, 0), b3, voffB);
            PG8_BAR; PG8_WAIT_L(0); PG8_MMA(0, 1, At, B1); PG8_BAR;
            PG8_LDA(At, 1, 1); PG8_STAGE(PG8_SA(1, 0), a3, oC[0]);
            PG8_BAR; PG8_WAIT_L(0); PG8_MMA(1, 0, At, B0); PG8_BAR; PG8_SCHED;
            PG8_STAGE(PG8_SB(1, 1), b3 + hstep, voffB);
            PG8_WAIT_V(6); PG8_BAR; PG8_MMA(1, 1, At, B1); PG8_BAR;
        }
        E(acc, cur, wr, wc, fr, fq);
        if (!has_next) break;
#pragma unroll
        for (int a = 0; a < 2; ++a)
#pragma unroll
            for (int b = 0; b < 2; ++b)
#pragma unroll
                for (int m = 0; m < 4; ++m)
#pragma unroll
                    for (int n = 0; n < 2; ++n) acc[a][b][m][n] = (f32x4){0.f, 0.f, 0.f, 0.f};
        cur = nxt; cB = nB; ++ui;
    }
    PG8_WAIT_V(0);
    if (wr == 0) PG8_BAR;
    PG8_BAR;
#undef PG8_SA
#undef PG8_SB
#undef PG8_STAGE
#undef PG8_LDA
#undef PG8_LDB
#undef PG8_MMA
#undef PG8_WAIT_V
#undef PG8_WAIT_L
#undef PG8_BAR
#undef PG8_SCHED
#undef PG8_OFFS
}
}

struct Params {
    const float *x, *c; const int* pos;
    const float *w_ada, *b_ada, *norm1_g, *w_in, *conv_w, *conv_b, *b_ig, *b_fg, *mnorm_g, *w_out, *norm2_g, *w_router, *b_router,
                *w_gate, *b_gate, *w_up, *b_up, *w_down, *b_down, *fnorm_g;
    float* out; unsigned char* ws; int ph_lo, ph_hi;
};
#define WSP(type, off) ((type*)(p.ws + (off)))
#define MFMA16(a, b, c) __builtin_amdgcn_mfma_f32_16x16x32_bf16((a), (b), (c), 0, 0, 0)

__device__ __forceinline__ void tr_item(const float* __restrict__ W, int ldw, int k0, int nsrc0, bf16_t* __restrict__ WT, int K, int drow0, LAS float* scr, int lane) {
#pragma unroll
    for (int i = 0; i < 32; ++i) { const int kk = 2 * i + (lane >> 5); scr[kk * 33 + (lane & 31)] = W[(size_t)(k0 + kk) * ldw + nsrc0 + (lane & 31)]; }
    LDS_WAIT();
    const int c = lane & 7;
#pragma unroll
    for (int j = 0; j < 4; ++j) { const int n = (lane >> 3) + 8 * j; const LAS float* s = scr + (8 * c) * 33 + n;
        u32x4 o; o.x = pk2(s[0 * 33], s[1 * 33]); o.y = pk2(s[2 * 33], s[3 * 33]); o.z = pk2(s[4 * 33], s[5 * 33]); o.w = pk2(s[6 * 33], s[7 * 33]);
        *(u32x4*)(WT + (size_t)(drow0 + n) * K + k0 + 8 * c) = o; }
    LDS_WAIT();
}
__device__ __forceinline__ void convert_moe(const Params& p, int l, LAS unsigned char* lds) {
    const int tid = threadIdx.x, lane = tid & 63, wave = tid >> 6;
    LAS float* scr = (LAS float*)(lds + wave * 8448);
    const int gw = blockIdx.x * 8 + wave, NGW = gridDim.x * 8;
    bf16_t* WGU = WSP(bf16_t, WS_WGU); bf16_t* WD = WSP(bf16_t, WS_WD);
    for (int it = gw; it < NE * 1536; it += NGW) {
        const int e = it / 1536, r = it % 1536, mat = r / 512, q = r % 512, kb = q / 32, nb = q % 32, k0 = kb * 64, n0 = nb * 32;
        const size_t eo = (size_t)(l * NE + e) * 1024 * 1024;
        if (mat == 0) tr_item(p.w_gate + eo, 1024, k0, n0, WGU + (size_t)e * 2048 * 1024, 1024, (n0 >> 7) * 256 + (n0 & 127), scr, lane);
        else if (mat == 1) tr_item(p.w_up + eo, 1024, k0, n0, WGU + (size_t)e * 2048 * 1024, 1024, (n0 >> 7) * 256 + 128 + (n0 & 127), scr, lane);
        else tr_item(p.w_down + eo, 1024, k0, n0, WD + (size_t)e * 1024 * 1024, 1024, n0, scr, lane);
    }
}
__device__ __forceinline__ void prologue_phase(const Params& p, LAS unsigned char* lds) {
    const int tid = threadIdx.x, lane = tid & 63, wave = tid >> 6;
    const int G = gridDim.x;
    {
        LAS float* condl = (LAS float*)(lds + 70000);
        LAS float* red = (LAS float*)(lds + 70000 + 16384);
        for (int i = tid; i < 4096; i += 512) { const float cv = p.c[i]; condl[i] = cv / (1.0f + __expf(-cv)); }
        __syncthreads();
        float* MOD = WSP(float, WS_MOD);
        for (int u = blockIdx.x; u < 192; u += G) {
            const int l = u / 96, n0 = (u % 96) * 64;
            const float* w = p.w_ada + (size_t)l * 1024 * 6144 + n0 + lane;
            float a0 = 0.f, a1 = 0.f, a2 = 0.f, a3 = 0.f;
#pragma unroll 16
            for (int kk = 0; kk < 128; ++kk) { const int k = wave * 128 + kk; const float wv = w[(size_t)k * 6144];
                a0 += condl[k] * wv; a1 += condl[1024 + k] * wv; a2 += condl[2048 + k] * wv; a3 += condl[3072 + k] * wv; }
            red[(wave * 4 + 0) * 64 + lane] = a0; red[(wave * 4 + 1) * 64 + lane] = a1; red[(wave * 4 + 2) * 64 + lane] = a2; red[(wave * 4 + 3) * 64 + lane] = a3;
            __syncthreads();
            if (tid < 256) { const int b = tid >> 6, ln = tid & 63; float s = p.b_ada[l * 6144 + n0 + ln];
#pragma unroll
                for (int w8 = 0; w8 < 8; ++w8) s += red[(w8 * 4 + b) * 64 + ln];
                MOD[(size_t)(l * 4 + b) * 6144 + n0 + ln] = s; }
            __syncthreads();
        }
    }
    {
        LAS float* scr = (LAS float*)(lds + wave * 8448);
        const int gw = blockIdx.x * 8 + wave, NGW = G * 8;
        bf16_t* WIN = WSP(bf16_t, WS_WIN); bf16_t* WOUT = WSP(bf16_t, WS_WOUT);
        constexpr int I_IN = 16 * 112, I_OUT = 16 * 32;
        for (int it = gw; it < 2 * I_IN + 2 * I_OUT; it += NGW) {
            if (it < 2 * I_IN) { const int l = it / I_IN, r = it % I_IN, kb = r / 112, nb = r % 112, n0 = nb * 32;
                tr_item(p.w_in + (size_t)l * 1024 * NIN, NIN, kb * 64, n0 < 2048 ? n0 : n0 + 8, WIN + (size_t)l * NZ * 1024, 1024, n0, scr, lane); }
            else { const int r2 = it - 2 * I_IN, l = r2 / I_OUT, r = r2 % I_OUT, kb = r / 32, nb = r % 32;
                tr_item(p.w_out + (size_t)l * 1024 * 1024, 1024, kb * 64, nb * 32, WOUT + (size_t)l * 1024 * 1024, 1024, nb * 32, scr, lane); }
        }
    }
    convert_moe(p, 0, lds);
}

__device__ __forceinline__ void moe_tile_prefix(const Params& p, int lm, LAS int* tb, LAS int* cnt) {
    if (threadIdx.x == 0) { const unsigned* ec = WSP(unsigned, WS_CTL) + CW_ECNT + lm * 64; int s = 0;
        for (int j = 0; j < 32; ++j) { const int c = (int)ec[j]; cnt[j] = c; tb[j] = s; s += (c + 255) >> 8; } tb[32] = s; }
}
template <int MODE>
__device__ __forceinline__ void norm_phase(const Params& p, int l, LAS unsigned char* lds) {
    const int tid = threadIdx.x, lane = tid & 63, wave = tid >> 6;
    LAS float* Wg = (LAS float*)lds;
    LAS int* tb = (LAS int*)(lds + 32768); LAS int* cnt = tb + 40;
    if (MODE != 2) { const float* wi = p.w_in + (size_t)l * 1024 * NIN + 2048;
        for (int i = tid; i < 8192; i += 512) Wg[i] = wi[(size_t)(i >> 3) * NIN + (i & 7)]; }
    if (MODE >= 1) moe_tile_prefix(p, MODE == 1 ? l - 1 : 1, tb, cnt);
    __syncthreads();
    const int lm = (MODE == 1) ? l - 1 : 1;
    const float* MOD = WSP(float, WS_MOD);
    float* X = WSP(float, WS_X); bf16_t* H = WSP(bf16_t, WS_H);
    const bf16_t* YB = WSP(bf16_t, WS_YB);
    const unsigned* PE = WSP(unsigned, WS_PE); const float* PROB = WSP(float, WS_PROB);
    float* IG = WSP(float, WS_IG); float* LF = WSP(float, WS_LF);
    const int gw = blockIdx.x * 8 + wave, NGW = gridDim.x * 8;
    for (int row = gw; row < T; row += NGW) {
        const int b = row >> 13;
        const float* xr = (MODE == 0 ? p.x : X) + (size_t)row * D;
        f32x4 v[4];
#pragma unroll
        for (int j = 0; j < 4; ++j) v[j] = *(const f32x4*)(xr + 4 * lane + 256 * j);
        if (MODE >= 1) {
            f32x4 y[4];
#pragma unroll
            for (int j = 0; j < 4; ++j) y[j] = (f32x4){0.f, 0.f, 0.f, 0.f};
#pragma unroll
            for (int k = 0; k < 4; ++k) {
                const unsigned pe = PE[row * 4 + k]; const float pr = PROB[row * 4 + k];
                const int e = pe & 255u, rank = pe >> 8; const size_t srow = (size_t)tb[e] * 256 + rank;
                const bf16_t* yb = YB + srow * D;
#pragma unroll
                for (int j = 0; j < 4; ++j) { const u32x2 w = *(const u32x2*)(yb + 4 * lane + 256 * j);
                    y[j][0] += pr * bflo(w.x); y[j][1] += pr * bfhi(w.x); y[j][2] += pr * bflo(w.y); y[j][3] += pr * bfhi(w.y); }
            }
            const float* g2 = MOD + (size_t)(lm * 4 + b) * 6144 + 5120;
#pragma unroll
            for (int j = 0; j < 4; ++j) { const f32x4 gg = *(const f32x4*)(g2 + 4 * lane + 256 * j); v[j] += gg * y[j]; }
            if (MODE == 1) {
#pragma unroll
                for (int j = 0; j < 4; ++j) *(f32x4*)(X + (size_t)row * D + 4 * lane + 256 * j) = v[j];
            }
        }
        float ss = 0.f;
#pragma unroll
        for (int j = 0; j < 4; ++j) ss += (v[j][0] * v[j][0] + v[j][1] * v[j][1]) + (v[j][2] * v[j][2] + v[j][3] * v[j][3]);
        const float rstd = 1.0f / sqrtf(wave_sum(ss) * (1.0f / D) + EPS);
        if (MODE == 2) {
#pragma unroll
            for (int j = 0; j < 4; ++j) { const f32x4 g = *(const f32x4*)(p.fnorm_g + 4 * lane + 256 * j);
                *(f32x4*)(p.out + (size_t)row * D + 4 * lane + 256 * j) = v[j] * rstd * g; }
        } else {
            const float* mb = MOD + (size_t)(l * 4 + b) * 6144;
            float ga[8];
#pragma unroll
            for (int c = 0; c < 8; ++c) ga[c] = 0.f;
#pragma unroll
            for (int j = 0; j < 4; ++j) {
                const int n = 4 * lane + 256 * j;
                const f32x4 g = *(const f32x4*)(p.norm1_g + l * D + n), sh = *(const f32x4*)(mb + n), sc = *(const f32x4*)(mb + 1024 + n);
                const f32x4 h = v[j] * rstd * g * (sc + 1.0f) + sh;
                u32x2 w; w.x = pk2(h[0], h[1]); w.y = pk2(h[2], h[3]);
                *(u32x2*)(H + (size_t)row * D + n) = w;
#pragma unroll
                for (int i = 0; i < 4; ++i) { const f32x4 w0 = *(const LAS f32x4*)(Wg + (n + i) * 8), w1 = *(const LAS f32x4*)(Wg + (n + i) * 8 + 4);
                    ga[0] += h[i] * w0[0]; ga[1] += h[i] * w0[1]; ga[2] += h[i] * w0[2]; ga[3] += h[i] * w0[3];
                    ga[4] += h[i] * w1[0]; ga[5] += h[i] * w1[1]; ga[6] += h[i] * w1[2]; ga[7] += h[i] * w1[3]; }
                asm volatile("" ::: "memory");
            }
#pragma unroll
            for (int c = 0; c < 8; ++c) ga[c] = wave_sum(ga[c]);
            if (lane < 8) {
                float gsel = ga[0];
#pragma unroll
                for (int c = 1; c < 8; ++c) gsel = (lane == c) ? ga[c] : gsel;
                if (lane < 4) { const float t = gsel + p.b_ig[l * 4 + lane]; IG[row * 4 + lane] = 15.0f * tanhf(t * (1.0f / 15.0f)); }
                else { const float t = gsel + p.b_fg[l * 4 + lane - 4]; const float f = 15.0f * tanhf(t * (1.0f / 15.0f));
                    LF[row * 4 + lane - 4] = fminf(f, 0.f) - log1pf(__expf(-fabsf(f))); }
            }
        }
    }
}

__device__ __forceinline__ void conv16(const bf16_t* Zb, int tpos, int zcol, const float* cw, const float* cb, int ch0, float (&o)[16]) {
#pragma unroll
    for (int i = 0; i < 16; ++i) o[i] = cb[ch0 + i];
#pragma unroll
    for (int j = 0; j < 4; ++j) {
        const int tp = tpos - 3 + j;
        if (tp >= 0) {
            const u32x4 a = *(const u32x4*)(Zb + (size_t)tp * NZ + zcol), b = *(const u32x4*)(Zb + (size_t)tp * NZ + zcol + 8);
            const unsigned w[8] = {a.x, a.y, a.z, a.w, b.x, b.y, b.z, b.w};
#pragma unroll
            for (int i = 0; i < 8; ++i) { o[2 * i] += cw[j * 1024 + ch0 + 2 * i] * bflo(w[i]); o[2 * i + 1] += cw[j * 1024 + ch0 + 2 * i + 1] * bfhi(w[i]); }
        }
    }
#pragma unroll
    for (int i = 0; i < 16; ++i) o[i] = o[i] / (1.0f + __expf(-o[i]));
}
__device__ __forceinline__ void mlstm_a_unit(const Params& p, int l, int u, LAS unsigned char* lds) {
    const int tid = threadIdx.x, lane = tid & 63, wave = tid >> 6, fr = lane & 15, fq = lane >> 4;
    const int c = u & 127, hd = (u >> 7) & 3, b = u >> 9;
    LAS bf16_t* kwT = (LAS bf16_t*)lds;
    LAS bf16_t* vT = (LAS bf16_t*)(lds + 18432);
    LAS float* ewl = (LAS float*)(lds + 36864);
    const bf16_t* Zb = WSP(bf16_t, WS_Z) + (size_t)b * SEQ * NZ;
    const int t0 = c * 64;
    if (tid < 64) {
        const int row = b * SEQ + t0 + tid;
        const float lf = WSP(float, WS_LF)[row * 4 + hd], ig = WSP(float, WS_IG)[row * 4 + hd];
        float bc = lf;
#pragma unroll
        for (int o = 1; o < 64; o <<= 1) { const float t = __shfl_up(bc, o); if (lane >= o) bc += t; }
        const float g = __shfl(bc, 63);
        const float w = g - bc + ig;
        float wm = w;
#pragma unroll
        for (int o = 1; o < 64; o <<= 1) wm = fmaxf(wm, __shfl_xor(wm, o));
        ewl[tid] = __expf(w - wm);
        if (tid == 0) { WSP(float, WS_G)[u] = g; WSP(float, WS_WMAX)[u] = wm; }
    }
    __syncthreads();
    {
        const int t = tid >> 3, d0 = (tid & 7) * 16;
        float kc[16];
        conv16(Zb, t0 + t, ZK + hd * 128 + d0, p.conv_w + l * 4096, p.conv_b + l * 1024, 512 + hd * 128 + d0, kc);
        const float sc = 0.08838834764831845f * ewl[t];
#pragma unroll
        for (int i = 0; i < 16; ++i) kwT[(d0 + i) * 72 + t] = (bf16_t)f2bf(kc[i] * sc);
        const bf16_t* vr = Zb + (size_t)(t0 + t) * NZ + ZV + hd * 128 + d0;
        const u32x4 a = *(const u32x4*)vr, bb = *(const u32x4*)(vr + 8);
        const unsigned w[8] = {a.x, a.y, a.z, a.w, bb.x, bb.y, bb.z, bb.w};
#pragma unroll
        for (int i = 0; i < 8; ++i) { vT[(d0 + 2 * i) * 72 + t] = (bf16_t)(w[i] & 0xffffu); vT[(d0 + 2 * i + 1) * 72 + t] = (bf16_t)(w[i] >> 16); }
    }
    __syncthreads();
    if (tid < 128) { float s = 0.f;
        for (int k = 0; k < 64; ++k) s += bf2f(kwT[tid * 72 + k]);
        WSP(float, WS_KS)[u * 128 + tid] = s; }
    {
        const int e0 = wave * 16;
        bf16x8 a[2];
#pragma unroll
        for (int kk = 0; kk < 2; ++kk) a[kk] = *(const LAS bf16x8*)(vT + (e0 + fr) * 72 + kk * 32 + 8 * fq);
        bf16_t* KVT = WSP(bf16_t, WS_KVT) + (size_t)u * 16384;
#pragma unroll
        for (int dt = 0; dt < 8; ++dt) {
            f32x4 acc = (f32x4){0.f, 0.f, 0.f, 0.f};
#pragma unroll
            for (int kk = 0; kk < 2; ++kk) { const bf16x8 bq = *(const LAS bf16x8*)(kwT + (dt * 16 + fr) * 72 + kk * 32 + 8 * fq); acc = MFMA16(a[kk], bq, acc); }
#pragma unroll
            for (int i = 0; i < 4; ++i) KVT[(e0 + 4 * fq + i) * 128 + dt * 16 + fr] = (bf16_t)f2bf(acc[i]);
        }
    }
    __syncthreads();
}
__device__ __forceinline__ void mlstm_b_unit(const Params& p, int u) {
    const int tid = threadIdx.x;
    const int slice = u & 15, bh = u >> 4;
    bf16_t* base = WSP(bf16_t, WS_KVT) + (size_t)bh * 128 * 16384 + slice * 1024 + tid * 2;
    const float* Gs = WSP(float, WS_G) + bh * 128; const float* Wm = WSP(float, WS_WMAX) + bh * 128;
    float* MP = WSP(float, WS_MPREV) + bh * 128; float* KS = WSP(float, WS_KS) + (size_t)bh * 128 * 128;
    const bool don = (slice == 0) && (tid < 128);
    float m = -INFINITY, c0 = 0.f, c1 = 0.f, nst = 0.f;
    for (int cb = 0; cb < 128; cb += 16) {
        unsigned kv[16]; float ksv[16];
#pragma unroll
        for (int i = 0; i < 16; ++i) { kv[i] = *(const unsigned*)(base + (size_t)(cb + i) * 16384); ksv[i] = don ? KS[(cb + i) * 128 + tid] : 0.f; }
#pragma unroll
        for (int i = 0; i < 16; ++i) {
            const int c = cb + i;
            *(unsigned*)(base + (size_t)c * 16384) = pk2(c0, c1);
            if (don) KS[c * 128 + tid] = nst;
            if (slice == 0 && tid == 0) MP[c] = m;
            const float g = Gs[c], wm = Wm[c];
            const float mn = fmaxf(g + m, wm);
            const float dec = __expf(g + m - mn), inj = __expf(wm - mn);
            c0 = dec * c0 + inj * bflo(kv[i]); c1 = dec * c1 + inj * bfhi(kv[i]); nst = dec * nst + inj * ksv[i];
            m = mn;
        }
    }
}
__device__ __forceinline__ void mlstm_c_unit(const Params& p, int l, int u, LAS unsigned char* lds) {
    const int tid = threadIdx.x, lane = tid & 63, wave = tid >> 6, fr = lane & 15, fq = lane >> 4;
    const int c = u & 127, hd = (u >> 7) & 3, b = u >> 9;
    LAS bf16_t* qs = (LAS bf16_t*)lds;
    LAS bf16_t* ks = (LAS bf16_t*)(lds + 17408);
    LAS bf16_t* vT = (LAS bf16_t*)(lds + 34816);
    LAS bf16_t* CT = (LAS bf16_t*)(lds + 53248);
    LAS bf16_t* Ps = (LAS bf16_t*)(lds + 88064);
    LAS float* hb = (LAS float*)(lds + 97280);
    LAS float* sm = (LAS float*)(lds + 131072);
    LAS float* bcum = sm, *igb = sm + 64, *mtv = sm + 128, *inter = sm + 192, *emt = sm + 256, *den0 = sm + 320, *dpart = sm + 384  , *nprev = sm + 512  ;
    const bf16_t* Zb = WSP(bf16_t, WS_Z) + (size_t)b * SEQ * NZ;
    const int t0 = c * 64;
    if (tid < 64) {
        const int row = b * SEQ + t0 + tid;
        const float lf = WSP(float, WS_LF)[row * 4 + hd], ig = WSP(float, WS_IG)[row * 4 + hd];
        float bc = lf;
#pragma unroll
        for (int o = 1; o < 64; o <<= 1) { const float t = __shfl_up(bc, o); if (lane >= o) bc += t; }
        const float a = ig - bc;
        float cm = a;
#pragma unroll
        for (int o = 1; o < 64; o <<= 1) { const float t = __shfl_up(cm, o); if (lane >= o) cm = fmaxf(cm, t); }
        const float mp = WSP(float, WS_MPREV)[u];
        const float mt = bc + fmaxf(mp, cm);
        bcum[tid] = bc; igb[tid] = a; mtv[tid] = mt; inter[tid] = __expf(bc + mp - mt); emt[tid] = __expf(-mt);
    } else if (tid < 192) nprev[tid - 64] = WSP(float, WS_KS)[u * 128 + tid - 64];
    __syncthreads();
    {
        const int t = tid >> 3, d0 = (tid & 7) * 16;
        float qc[16], kc[16];
        conv16(Zb, t0 + t, ZQ + hd * 128 + d0, p.conv_w + l * 4096, p.conv_b + l * 1024, hd * 128 + d0, qc);
        conv16(Zb, t0 + t, ZK + hd * 128 + d0, p.conv_w + l * 4096, p.conv_b + l * 1024, 512 + hd * 128 + d0, kc);
        float dn = 0.f;
#pragma unroll
        for (int i = 0; i < 16; ++i) dn += qc[i] * nprev[d0 + i];
        dn += __shfl_xor(dn, 1); dn += __shfl_xor(dn, 2); dn += __shfl_xor(dn, 4);
        if ((tid & 7) == 0) den0[t] = inter[t] * dn;
        u32x4 w0, w1;
        w0.x = pk2(qc[0], qc[1]); w0.y = pk2(qc[2], qc[3]); w0.z = pk2(qc[4], qc[5]); w0.w = pk2(qc[6], qc[7]);
        w1.x = pk2(qc[8], qc[9]); w1.y = pk2(qc[10], qc[11]); w1.z = pk2(qc[12], qc[13]); w1.w = pk2(qc[14], qc[15]);
        *(LAS u32x4*)(qs + t * 136 + d0) = w0; *(LAS u32x4*)(qs + t * 136 + d0 + 8) = w1;
        const float sc = 0.08838834764831845f;
        w0.x = pk2(kc[0] * sc, kc[1] * sc); w0.y = pk2(kc[2] * sc, kc[3] * sc); w0.z = pk2(kc[4] * sc, kc[5] * sc); w0.w = pk2(kc[6] * sc, kc[7] * sc);
        w1.x = pk2(kc[8] * sc, kc[9] * sc); w1.y = pk2(kc[10] * sc, kc[11] * sc); w1.z = pk2(kc[12] * sc, kc[13] * sc); w1.w = pk2(kc[14] * sc, kc[15] * sc);
        *(LAS u32x4*)(ks + t * 136 + d0) = w0; *(LAS u32x4*)(ks + t * 136 + d0 + 8) = w1;
        const bf16_t* vr = Zb + (size_t)(t0 + t) * NZ + ZV + hd * 128 + d0;
        const u32x4 a = *(const u32x4*)vr, bb = *(const u32x4*)(vr + 8);
        const unsigned w[8] = {a.x, a.y, a.z, a.w, bb.x, bb.y, bb.z, bb.w};
#pragma unroll
        for (int i = 0; i < 8; ++i) { vT[(d0 + 2 * i) * 72 + t] = (bf16_t)(w[i] & 0xffffu); vT[(d0 + 2 * i + 1) * 72 + t] = (bf16_t)(w[i] >> 16); }
        const bf16_t* KVT = WSP(bf16_t, WS_KVT) + (size_t)u * 16384;
#pragma unroll
        for (int k = 0; k < 4; ++k) { const int id = tid + 512 * k, e = id >> 4, dc = id & 15;
            *(LAS u32x4*)(CT + e * 136 + dc * 8) = *(const u32x4*)(KVT + e * 128 + dc * 8); }
    }
    __syncthreads();
    {
        const int tt = wave >> 1;
        float rs[4] = {0.f, 0.f, 0.f, 0.f};
#pragma unroll
        for (int si = 0; si < 2; ++si) {
            const int ss = (wave & 1) * 2 + si;
            f32x4 acc = (f32x4){0.f, 0.f, 0.f, 0.f};
#pragma unroll
            for (int kk = 0; kk < 4; ++kk) { const bf16x8 a = *(const LAS bf16x8*)(qs + (tt * 16 + fr) * 136 + kk * 32 + 8 * fq);
                const bf16x8 bq = *(const LAS bf16x8*)(ks + (ss * 16 + fr) * 136 + kk * 32 + 8 * fq); acc = MFMA16(a, bq, acc); }
            const int s = ss * 16 + fr; const float ib = igb[s];
#pragma unroll
            for (int i = 0; i < 4; ++i) { const int t = tt * 16 + 4 * fq + i;
                const float val = (s <= t) ? acc[i] * __expf(bcum[t] + ib - mtv[t]) : 0.f;
                rs[i] += val; Ps[t * 72 + s] = (bf16_t)f2bf(val); }
        }
#pragma unroll
        for (int i = 0; i < 4; ++i) { float r = rs[i]; r += __shfl_xor(r, 1); r += __shfl_xor(r, 2); r += __shfl_xor(r, 4); r += __shfl_xor(r, 8);
            if (fr == 0) dpart[(wave & 1) * 64 + tt * 16 + 4 * fq + i] = r; }
    }
    __syncthreads();
    {
        const int tt = wave >> 1;
        bf16x8 ap[2], aq[4];
#pragma unroll
        for (int kk = 0; kk < 2; ++kk) ap[kk] = *(const LAS bf16x8*)(Ps + (tt * 16 + fr) * 72 + kk * 32 + 8 * fq);
#pragma unroll
        for (int kk = 0; kk < 4; ++kk) aq[kk] = *(const LAS bf16x8*)(qs + (tt * 16 + fr) * 136 + kk * 32 + 8 * fq);
#pragma unroll
        for (int ei = 0; ei < 4; ++ei) {
            const int et = (wave & 1) * 4 + ei;
            f32x4 a1 = (f32x4){0.f, 0.f, 0.f, 0.f}, a2 = (f32x4){0.f, 0.f, 0.f, 0.f};
#pragma unroll
            for (int kk = 0; kk < 2; ++kk) { const bf16x8 bv = *(const LAS bf16x8*)(vT + (et * 16 + fr) * 72 + kk * 32 + 8 * fq); a1 = MFMA16(ap[kk], bv, a1); }
#pragma unroll
            for (int kk = 0; kk < 4; ++kk) { const bf16x8 bc = *(const LAS bf16x8*)(CT + (et * 16 + fr) * 136 + kk * 32 + 8 * fq); a2 = MFMA16(aq[kk], bc, a2); }
            const int e = et * 16 + fr;
#pragma unroll
            for (int i = 0; i < 4; ++i) { const int t = tt * 16 + 4 * fq + i;
                const float num = a1[i] + inter[t] * a2[i];
                const float den = den0[t] + dpart[t] + dpart[64 + t];
                const float hv = num / fmaxf(fabsf(den), emt[t]);
                const float og = bf2f(Zb[(size_t)(t0 + t) * NZ + ZO + hd * 128 + e]);
                hb[t * 132 + e] = hv * sigmoidf_(og); }
        }
    }
    __syncthreads();
    {
        const int t = tid >> 3, e0 = (tid & 7) * 16;
        float hv[16]; float ssq = 0.f;
#pragma unroll
        for (int i = 0; i < 4; ++i) { const f32x4 x4 = *(const LAS f32x4*)(hb + t * 132 + e0 + 4 * i); hv[4 * i] = x4[0]; hv[4 * i + 1] = x4[1]; hv[4 * i + 2] = x4[2]; hv[4 * i + 3] = x4[3]; }
#pragma unroll
        for (int i = 0; i < 16; ++i) ssq += hv[i] * hv[i];
        ssq += __shfl_xor(ssq, 1); ssq += __shfl_xor(ssq, 2); ssq += __shfl_xor(ssq, 4);
        const float r = 1.0f / sqrtf(ssq * (1.0f / 128.0f) + EPS);
        const float* g = p.mnorm_g + l * 512 + hd * 128 + e0;
        u32x4 w0, w1;
        w0.x = pk2(hv[0] * r * g[0], hv[1] * r * g[1]); w0.y = pk2(hv[2] * r * g[2], hv[3] * r * g[3]); w0.z = pk2(hv[4] * r * g[4], hv[5] * r * g[5]); w0.w = pk2(hv[6] * r * g[6], hv[7] * r * g[7]);
        w1.x = pk2(hv[8] * r * g[8], hv[9] * r * g[9]); w1.y = pk2(hv[10] * r * g[10], hv[11] * r * g[11]); w1.z = pk2(hv[12] * r * g[12], hv[13] * r * g[13]); w1.w = pk2(hv[14] * r * g[14], hv[15] * r * g[15]);
        bf16_t* o = WSP(bf16_t, WS_CAT) + (size_t)(b * SEQ + t0 + t) * D + hd * 128 + e0;
        *(u32x4*)o = w0; *(u32x4*)(o + 8) = w1;
    }
    __syncthreads();
}

__device__ __forceinline__ void moba_prep_unit(const Params& p, int u, LAS unsigned char* lds) {
    const int tid = threadIdx.x, lane = tid & 63, wave = tid >> 6;
    const int qtr = u & 3, blk = (u >> 2) & 31, b = u >> 7;
    LAS float* cs = (LAS float*)lds; LAS float* sn = cs + 512;
    const int r0 = b * SEQ + blk * 256 + qtr * 64;
    { const int t = tid >> 3, i = tid & 7;
      const float inv = powf(500000.0f, -(float)(2 * i) / 16.0f);
      const float ang = (float)p.pos[r0 + t] * inv; float s, c; sincosf(ang, &s, &c); cs[tid] = c; sn[tid] = s; }
    __syncthreads();
    bf16_t* Z = WSP(bf16_t, WS_Z);
    const int h = wave, d = lane;
    float ksum = 0.f;
    for (int tb = 0; tb < 64; tb += 32) {
        unsigned short qv[32], kv[32];
#pragma unroll
        for (int i = 0; i < 32; ++i) { const size_t ro = (size_t)(r0 + tb + i) * NZ + h * 64 + d; qv[i] = Z[ro + ZAQ]; kv[i] = Z[ro + ZAK]; }
#pragma unroll
        for (int i = 0; i < 32; ++i) {
            float q = bf2f(qv[i]), k = bf2f(kv[i]);
            const float qp = __shfl_xor(q, 8), kp = __shfl_xor(k, 8);
            if (d < 16) {
                const float c = cs[(tb + i) * 8 + (d & 7)], s = sn[(tb + i) * 8 + (d & 7)];
                q = (d < 8) ? (q * c - qp * s) : (q * c + qp * s);
                k = (d < 8) ? (k * c - kp * s) : (k * c + kp * s);
                const unsigned qb = f2bf(q), kb = f2bf(k);
                const size_t ro = (size_t)(r0 + tb + i) * NZ + h * 64 + d;
                Z[ro + ZAQ] = (bf16_t)qb; Z[ro + ZAK] = (bf16_t)kb;
                k = bf2f(kb);
            }
            ksum += k;
        }
    }
    WSP(float, WS_KPART)[((((size_t)(b * 8 + h) * 32 + blk) * 4 + qtr) * 64) + d] = ksum;
    __syncthreads();
}
__device__ __forceinline__ void moba_gate_unit(const Params& p, int l, int u, LAS unsigned char* lds) {
    const int tid = threadIdx.x;
    const int tq = u & 15, h = (u >> 4) & 7, b = u >> 7;
    LAS float* km = (LAS float*)lds;
    const float* KP = WSP(float, WS_KPART) + (size_t)(b * 8 + h) * 32 * 4 * 64;
    for (int i = tid; i < 2048; i += 512) { const int j = i >> 6, d = i & 63; const float* s = KP + (size_t)j * 256 + d;
        km[i] = (s[0] + s[64] + s[128] + s[192]) * (1.0f / 256.0f); }
    __syncthreads();
    const int t = tq * 512 + tid, own = t >> 8;
    const bf16_t* qr = WSP(bf16_t, WS_Z) + (size_t)(b * SEQ + t) * NZ + ZAQ + h * 64;
    float q[64];
#pragma unroll
    for (int k = 0; k < 8; ++k) { const u32x4 w = *(const u32x4*)(qr + 8 * k);
        q[8 * k] = bflo(w.x); q[8 * k + 1] = bfhi(w.x); q[8 * k + 2] = bflo(w.y); q[8 * k + 3] = bfhi(w.y); q[8 * k + 4] = bflo(w.z); q[8 * k + 5] = bfhi(w.z); q[8 * k + 6] = bflo(w.w); q[8 * k + 7] = bfhi(w.w); }
    float v0 = -INFINITY, v1 = -INFINITY, v2 = -INFINITY; int i0 = -1, i1 = -1, i2 = -1;
    for (int j = 0; j < own; ++j) {
        float s = 0.f;
#pragma unroll
        for (int d4 = 0; d4 < 16; ++d4) { const f32x4 kk = *(const LAS f32x4*)(km + j * 64 + 4 * d4); s += q[4 * d4] * kk[0] + q[4 * d4 + 1] * kk[1] + q[4 * d4 + 2] * kk[2] + q[4 * d4 + 3] * kk[3]; }
        if (s > v0) { v2 = v1; i2 = i1; v1 = v0; i1 = i0; v0 = s; i0 = j; }
        else if (s > v1) { v2 = v1; i2 = i1; v1 = s; i1 = j; }
        else if (s > v2) { v2 = s; i2 = j; }
    }
    unsigned* QLEN = WSP(unsigned, WS_CTL) + CW_QLEN + l * 1024 + (b * 8 + h) * 32;
    bf16_t* QL = WSP(bf16_t, WS_QLIST) + (size_t)(b * 8 + h) * 32 * 8192;
    const int sel[4] = {i0, i1, i2, own};
#pragma unroll
    for (int s = 0; s < 4; ++s) { const int j = sel[s];
        if (j >= 0) { const unsigned pos = atomicAdd(&QLEN[j], 1u); QL[(size_t)j * 8192 + pos] = (bf16_t)((t << 2) | s); } }
    __syncthreads();
}
__device__ __forceinline__ void moba_attn_unit(const Params& p, int l, int li, int ch, LAS unsigned char* lds) {
    const int tid = threadIdx.x, lane = tid & 63, wave = tid >> 6, fr = lane & 15, fq = lane >> 4;
    const int j = li & 31, h = (li >> 5) & 7, b = li >> 8;
    LAS bf16_t* Ks = (LAS bf16_t*)lds;
    LAS bf16_t* VT = (LAS bf16_t*)(lds + 36864);
    LAS bf16_t* Pw = (LAS bf16_t*)(lds + 36864 + 33792 + wave * 8448);
    const bf16_t* Z = WSP(bf16_t, WS_Z);
    const int n = (int)(WSP(unsigned, WS_CTL)[CW_QLEN + l * 1024 + li]);
    const bf16_t* QL = WSP(bf16_t, WS_QLIST) + (size_t)li * 8192;
    const size_t kr0 = (size_t)(b * SEQ + j * 256);
#pragma unroll
    for (int i = 0; i < 4; ++i) { const int id = tid + 512 * i, key = id >> 3, part = id & 7;
        const bf16_t* src = Z + (kr0 + key) * NZ + h * 64 + part * 8;
        *(LAS u32x4*)(Ks + key * 72 + part * 8) = *(const u32x4*)(src + ZAK);
        const u32x4 vv = *(const u32x4*)(src + ZAV);
        const unsigned w[4] = {vv.x, vv.y, vv.z, vv.w};
#pragma unroll
        for (int k = 0; k < 4; ++k) { VT[(part * 8 + 2 * k) * 264 + key] = (bf16_t)(w[k] & 0xffffu); VT[(part * 8 + 2 * k + 1) * 264 + key] = (bf16_t)(w[k] >> 16); } }
    __syncthreads();
    bf16_t* PO = WSP(bf16_t, WS_PARTO); float* PL = WSP(float, WS_PARTL);
    for (int tile = 0; tile < 4; ++tile) {
        const int rbase = ch * 512 + tile * 128;
        if (rbase >= n) break;
        const int ridx = rbase + wave * 16 + fr;
        const unsigned ent = (ridx < n) ? (unsigned)QL[ridx] : 0u;
        const int tA = (int)(ent >> 2);
        const bf16_t* qp = Z + (size_t)(b * SEQ + tA) * NZ + ZAQ + h * 64 + 8 * fq;
        bf16x8 qa[2]; qa[0] = *(const bf16x8*)qp; qa[1] = *(const bf16x8*)(qp + 32);
        int tq[4]; unsigned eq[4];
#pragma unroll
        for (int i = 0; i < 4; ++i) { eq[i] = (unsigned)__shfl((int)ent, 4 * fq + i); tq[i] = (int)(eq[i] >> 2); }
        f32x4 s[16];
        float mx[4] = {-INFINITY, -INFINITY, -INFINITY, -INFINITY};
#pragma unroll
        for (int ct = 0; ct < 16; ++ct) {
            f32x4 acc = (f32x4){0.f, 0.f, 0.f, 0.f};
#pragma unroll
            for (int kk = 0; kk < 2; ++kk) { const bf16x8 bk = *(const LAS bf16x8*)(Ks + (ct * 16 + fr) * 72 + kk * 32 + 8 * fq); acc = MFMA16(qa[kk], bk, acc); }
            const int kpos = j * 256 + ct * 16 + fr;
#pragma unroll
            for (int i = 0; i < 4; ++i) { const float v = (kpos <= tq[i]) ? acc[i] * 0.125f : -INFINITY; acc[i] = v; mx[i] = fmaxf(mx[i], v); }
            s[ct] = acc;
        }
        float ls[4];
#pragma unroll
        for (int i = 0; i < 4; ++i) { float m = mx[i]; m = fmaxf(m, __shfl_xor(m, 1)); m = fmaxf(m, __shfl_xor(m, 2)); m = fmaxf(m, __shfl_xor(m, 4)); m = fmaxf(m, __shfl_xor(m, 8)); mx[i] = m; ls[i] = 0.f; }
#pragma unroll
        for (int ct = 0; ct < 16; ++ct)
#pragma unroll
            for (int i = 0; i < 4; ++i) { const float pv = __expf(s[ct][i] - mx[i]); ls[i] += pv; Pw[(4 * fq + i) * 264 + ct * 16 + fr] = (bf16_t)f2bf(pv); }
#pragma unroll
        for (int i = 0; i < 4; ++i) { float r = ls[i]; r += __shfl_xor(r, 1); r += __shfl_xor(r, 2); r += __shfl_xor(r, 4); r += __shfl_xor(r, 8); ls[i] = r; }
        LDS_WAIT();
        f32x4 o[4];
#pragma unroll
        for (int dt = 0; dt < 4; ++dt) o[dt] = (f32x4){0.f, 0.f, 0.f, 0.f};
#pragma unroll
        for (int kk = 0; kk < 8; ++kk) { const bf16x8 a = *(const LAS bf16x8*)(Pw + fr * 264 + kk * 32 + 8 * fq);
#pragma unroll
            for (int dt = 0; dt < 4; ++dt) { const bf16x8 bv = *(const LAS bf16x8*)(VT + (dt * 16 + fr) * 264 + kk * 32 + 8 * fq); o[dt] = MFMA16(a, bv, o[dt]); } }
#pragma unroll
        for (int i = 0; i < 4; ++i) {
            const int rr = rbase + wave * 16 + 4 * fq + i;
            if (rr < n) {
                const size_t pi = ((size_t)(b * 8 + h) * SEQ + tq[i]) * 4 + (eq[i] & 3u);
                const float inv = 1.0f / ls[i];
#pragma unroll
                for (int dt = 0; dt < 4; ++dt) PO[pi * 64 + dt * 16 + fr] = (bf16_t)f2bf(o[dt][i] * inv);
                if (fr == 0) PL[pi] = mx[i] + __logf(ls[i]);
            }
        }
        LDS_WAIT();
    }
    __syncthreads();
}
__device__ __forceinline__ void moba_combine_phase(const Params& p) {
    const int tid = threadIdx.x, lane = tid & 63, wave = tid >> 6;
    const int gw = blockIdx.x * 8 + wave, NGW = gridDim.x * 8;
    const bf16_t* PO = WSP(bf16_t, WS_PARTO); const float* PL = WSP(float, WS_PARTL);
    bf16_t* CAT = WSP(bf16_t, WS_CAT);
    const int h = lane >> 3, part = lane & 7;
    for (int row = gw; row < T; row += NGW) {
        const int b = row >> 13, t = row & 8191, own = t >> 8, nsel = own < 3 ? own : 3;
        const size_t pi = ((size_t)(b * 8 + h) * SEQ + t) * 4;
        float lse[4]; float M = -INFINITY;
#pragma unroll
        for (int s = 0; s < 4; ++s) { const bool ok = (s == 3) || (s < nsel); lse[s] = ok ? PL[pi + s] : -INFINITY; M = fmaxf(M, lse[s]); }
        float acc[8]; float wsum = 0.f;
#pragma unroll
        for (int i = 0; i < 8; ++i) acc[i] = 0.f;
#pragma unroll
        for (int s = 0; s < 4; ++s) { const bool ok = (s == 3) || (s < nsel);
            if (ok) { const float w = __expf(lse[s] - M); wsum += w;
                const u32x4 v = *(const u32x4*)(PO + (pi + s) * 64 + part * 8);
                acc[0] += w * bflo(v.x); acc[1] += w * bfhi(v.x); acc[2] += w * bflo(v.y); acc[3] += w * bfhi(v.y);
                acc[4] += w * bflo(v.z); acc[5] += w * bfhi(v.z); acc[6] += w * bflo(v.w); acc[7] += w * bfhi(v.w); } }
        const float inv = 1.0f / wsum;
        u32x4 o; o.x = pk2(acc[0] * inv, acc[1] * inv); o.y = pk2(acc[2] * inv, acc[3] * inv); o.z = pk2(acc[4] * inv, acc[5] * inv); o.w = pk2(acc[6] * inv, acc[7] * inv);
        *(u32x4*)(CAT + (size_t)row * D + 512 + h * 64 + part * 8) = o;
    }
}

__device__ __forceinline__ void mix_a_phase(const Params& p, int l, LAS unsigned char* lds) {
    for (int u = blockIdx.x; u < 2048 + 512; u += gridDim.x) {
        if (u < 2048) mlstm_a_unit(p, l, u, lds); else moba_prep_unit(p, u - 2048, lds);
    }
}
__device__ __forceinline__ void mix_b_phase(const Params& p, int l, LAS unsigned char* lds) {
    for (int u = blockIdx.x; u < 256 + 512; u += gridDim.x) {
        if (u < 256) mlstm_b_unit(p, u); else moba_gate_unit(p, l, u - 256, lds);
    }
}
__device__ __forceinline__ void mix_c_phase(const Params& p, int l, LAS unsigned char* lds) {
    const int tid = threadIdx.x, lane = tid & 63, wave = tid >> 6;
    LAS int* pre = (LAS int*)(lds + 139264);
    LAS int* wt = pre + 1032;
    {
        const unsigned* QLEN = WSP(unsigned, WS_CTL) + CW_QLEN + l * 1024;
        const int a0 = ((int)QLEN[2 * tid] + 511) >> 9, a1 = ((int)QLEN[2 * tid + 1] + 511) >> 9;
        const int s = a0 + a1; int inc = s;
#pragma unroll
        for (int o = 1; o < 64; o <<= 1) { const int t = __shfl_up(inc, o); if (lane >= o) inc += t; }
        if (lane == 63) wt[wave] = inc;
        __syncthreads();
        int wp = 0;
        for (int w = 0; w < wave; ++w) wp += wt[w];
        const int ex = wp + inc - s;
        pre[2 * tid] = ex; pre[2 * tid + 1] = ex + a0;
        if (tid == 511) pre[1024] = ex + s;
        __syncthreads();
    }
    const int NU = pre[1024];
    for (int u = blockIdx.x; u < 2048 + NU; u += gridDim.x) {
        if (u < 2048) mlstm_c_unit(p, l, u, lds);
        else {
            const int a = u - 2048;
            int lo = 0, hi = 1024;
            while (hi - lo > 1) { const int mid = (lo + hi) >> 1; if (pre[mid] <= a) lo = mid; else hi = mid; }
            moba_attn_unit(p, l, lo, a - pre[lo], lds);
        }
    }
}

__device__ __forceinline__ void router_phase(const Params& p, int l, LAS unsigned char* lds) {
    const int tid = threadIdx.x, lane = tid & 63, wave = tid >> 6;
    LAS float* Wr = (LAS float*)lds;
    LAS int* lcnt = (LAS int*)(lds + 131072);
    LAS int* lbase = lcnt + 32;
    LAS unsigned* lsel = (LAS unsigned*)(lcnt + 64);
    const float* wr = p.w_router + (size_t)l * 1024 * 32;
    for (int i = tid; i < 32768; i += 512) Wr[i] = wr[i];
    if (tid < 32) lcnt[tid] = 0;
    __syncthreads();
    const int G = gridDim.x, rows_per = (T + G - 1) / G;
    const int r_lo = blockIdx.x * rows_per, r_hi = (r_lo + rows_per < T) ? r_lo + rows_per : T;
    const float* MOD = WSP(float, WS_MOD);
    const float* X = WSP(float, WS_X); bf16_t* H = WSP(bf16_t, WS_H);
    float* PROB = WSP(float, WS_PROB);
    for (int row = r_lo + wave; row < r_hi; row += 8) {
        const int b = row >> 13;
        f32x4 v[4]; float ss = 0.f;
#pragma unroll
        for (int j = 0; j < 4; ++j) { v[j] = *(const f32x4*)(X + (size_t)row * D + 4 * lane + 256 * j); ss += (v[j][0] * v[j][0] + v[j][1] * v[j][1]) + (v[j][2] * v[j][2] + v[j][3] * v[j][3]); }
        const float rstd = 1.0f / sqrtf(wave_sum(ss) * (1.0f / D) + EPS);
        const float* mb = MOD + (size_t)(l * 4 + b) * 6144;
        float lg[32];
#pragma unroll
        for (int e = 0; e < 32; ++e) lg[e] = 0.f;
#pragma unroll
        for (int j = 0; j < 4; ++j) {
            const int n = 4 * lane + 256 * j;
            const f32x4 g = *(const f32x4*)(p.norm2_g + l * D + n), sh = *(const f32x4*)(mb + 3072 + n), sc = *(const f32x4*)(mb + 4096 + n);
            const f32x4 h = v[j] * rstd * g * (sc + 1.0f) + sh;
            u32x2 w; w.x = pk2(h[0], h[1]); w.y = pk2(h[2], h[3]);
            *(u32x2*)(H + (size_t)row * D + n) = w;
#pragma unroll
            for (int i = 0; i < 4; ++i)
#pragma unroll
                for (int e4 = 0; e4 < 8; ++e4) { const f32x4 ww = *(const LAS f32x4*)(Wr + (n + i) * 32 + 4 * e4);
                    lg[4 * e4] += h[i] * ww[0]; lg[4 * e4 + 1] += h[i] * ww[1]; lg[4 * e4 + 2] += h[i] * ww[2]; lg[4 * e4 + 3] += h[i] * ww[3]; }
        }
#pragma unroll
        for (int i = 0; i < 16; ++i) { const bool hi = (lane & 32) != 0; const float send = hi ? lg[i] : lg[i + 16]; const float keep = hi ? lg[i + 16] : lg[i]; lg[i] = keep + __shfl_xor(send, 32); }
#pragma unroll
        for (int i = 0; i < 8; ++i) { const bool hi = (lane & 16) != 0; const float send = hi ? lg[i] : lg[i + 8]; const float keep = hi ? lg[i + 8] : lg[i]; lg[i] = keep + __shfl_xor(send, 16); }
#pragma unroll
        for (int i = 0; i < 4; ++i) { const bool hi = (lane & 8) != 0; const float send = hi ? lg[i] : lg[i + 4]; const float keep = hi ? lg[i + 4] : lg[i]; lg[i] = keep + __shfl_xor(send, 8); }
#pragma unroll
        for (int i = 0; i < 2; ++i) { const bool hi = (lane & 4) != 0; const float send = hi ? lg[i] : lg[i + 2]; const float keep = hi ? lg[i + 2] : lg[i]; lg[i] = keep + __shfl_xor(send, 4); }
        { const bool hi = (lane & 2) != 0; const float send = hi ? lg[0] : lg[1]; const float keep = hi ? lg[1] : lg[0]; lg[0] = keep + __shfl_xor(send, 2); }
        float mine = lg[0] + __shfl_xor(lg[0], 1);
        const int ex = ((lane >> 5) & 1) * 16 + ((lane >> 4) & 1) * 8 + ((lane >> 3) & 1) * 4 + ((lane >> 2) & 1) * 2 + ((lane >> 1) & 1);
        mine += p.b_router[l * 32 + ex];
        float tv[4]; int te[4];
        float cur = mine;
#pragma unroll
        for (int k = 0; k < 4; ++k) {
            float m = cur;
#pragma unroll
            for (int o = 1; o < 64; o <<= 1) m = fmaxf(m, __shfl_xor(m, o));
            const unsigned long long bal = __ballot(cur == m);
            int best = 64;
            { int cand = (cur == m) ? ex : 64;
#pragma unroll
              for (int o = 1; o < 64; o <<= 1) { const int t = __shfl_xor(cand, o); cand = t < cand ? t : cand; }
              best = cand; }
            (void)bal;
            tv[k] = m; te[k] = best;
            if (ex == best) cur = -INFINITY;
        }
        const float e1 = __expf(tv[1] - tv[0]), e2 = __expf(tv[2] - tv[0]), e3 = __expf(tv[3] - tv[0]);
        const float inv = 1.0f / (1.0f + e1 + e2 + e3);
        if (lane < 4) {
            const float pr = (lane == 0 ? 1.0f : lane == 1 ? e1 : lane == 2 ? e2 : e3) * inv;
            const int e = lane == 0 ? te[0] : lane == 1 ? te[1] : lane == 2 ? te[2] : te[3];
            PROB[row * 4 + lane] = pr;
            const int rl = atomicAdd((int*)&lcnt[e], 1);
            lsel[(row - r_lo) * 4 + lane] = (unsigned)e | ((unsigned)rl << 8);
        }
    }
    __syncthreads();
    unsigned* ECNT = WSP(unsigned, WS_CTL) + CW_ECNT + l * 64;
    if (tid < 32) lbase[tid] = (int)atomicAdd(&ECNT[tid], (unsigned)lcnt[tid]);
    __syncthreads();
    unsigned* PE = WSP(unsigned, WS_PE); int* EL = WSP(int, WS_ELIST);
    for (int i = tid; i < (r_hi - r_lo) * 4; i += 512) {
        const unsigned s = lsel[i]; const int e = s & 255u, rank = lbase[e] + (int)(s >> 8);
        const int row = r_lo + (i >> 2);
        PE[row * 4 + (i & 3)] = (unsigned)e | ((unsigned)rank << 8);
        EL[e * 32768 + rank] = row;
    }
    __syncthreads();
}

#define HAS(k) ((MASK >> (k)) & 1u)
template <unsigned MASK>
__global__ void __launch_bounds__(512, 2) fwd_kernel(Params p) {
    extern __shared__ __attribute__((aligned(16))) unsigned char lds_raw[];
    LAS unsigned char* lds = (LAS unsigned char*)lds_raw;
    volatile LAS unsigned* xbw = (volatile LAS unsigned*)(lds + LDS_BYTES - 16);
    const int lo = p.ph_lo, hi = p.ph_hi;
    const int G = gridDim.x;
    XcdBarrier bar; bar.bar = WSP(unsigned, WS_CTL) + CW_BAR; bar.x = 0; bar.st = xbw;
    if (MASK == 0xFFFu) {
        if (threadIdx.x == 0) { xbw[0] = 0u; xbw[1] = 0u; }
        __syncthreads();
        bar = xcd_barrier_post(WSP(unsigned, WS_CTL) + CW_BAR, xbw);
    }
#define IN(k) (lo <= (k) && (k) < hi)
#define SEAM(k) do { if (MASK == 0xFFFu) { if (IN(k) && IN((k) + 1)) xcd_barrier(bar); } } while (0)

    if constexpr (HAS(0)) { if (IN(0)) { prologue_phase(p, lds); __syncthreads(); } }
    SEAM(0);
    for (int l = 0; l < 2; ++l) {
        const int pb = 1 + 10 * l;
        if constexpr (HAS(1)) { if (IN(pb + 0)) {
            if (l == 0) norm_phase<0>(p, 0, lds);
            else { norm_phase<1>(p, 1, lds); __syncthreads(); convert_moe(p, 1, lds); }
            __syncthreads();
        } }
        SEAM(pb + 0);
        if constexpr (HAS(2)) { if (IN(pb + 1)) {
            pg8::StaticOrder S; S.init(T, NZ, G, (int)blockIdx.x);
            pg8::EpiZ E{WSP(bf16_t, WS_Z), NZ};
            pg8::gemm_phase(lds, WSP(bf16_t, WS_H), WSP(bf16_t, WS_WIN) + (size_t)l * NZ * 1024, 1024, S, E);
        } }
        SEAM(pb + 1);
        if constexpr (HAS(3)) { if (IN(pb + 2)) mix_a_phase(p, l, lds); }
        SEAM(pb + 2);
        if constexpr (HAS(4)) { if (IN(pb + 3)) mix_b_phase(p, l, lds); }
        SEAM(pb + 3);
        if constexpr (HAS(5)) { if (IN(pb + 4)) mix_c_phase(p, l, lds); }
        SEAM(pb + 4);
        if constexpr (HAS(6)) { if (IN(pb + 5)) moba_combine_phase(p); }
        SEAM(pb + 5);
        if constexpr (HAS(7)) { if (IN(pb + 6)) {
            pg8::StaticOrder S; S.init(T, D, G, (int)blockIdx.x);
            pg8::EpiRes E{l == 0 ? p.x : WSP(float, WS_X), WSP(float, WS_X), WSP(float, WS_MOD) + (size_t)l * 4 * 6144 + 2048};
            pg8::gemm_phase(lds, WSP(bf16_t, WS_CAT), WSP(bf16_t, WS_WOUT) + (size_t)l * 1024 * 1024, 1024, S, E);
        } }
        SEAM(pb + 6);
        if constexpr (HAS(8)) { if (IN(pb + 7)) router_phase(p, l, lds); }
        SEAM(pb + 7);
        if constexpr (HAS(9)) { if (IN(pb + 8)) {
            LAS int* tb = (LAS int*)(lds + 131072); LAS int* cnt = tb + 40;
            moe_tile_prefix(p, l, tb, cnt);
            __syncthreads();
            pg8::MoeOrder S{tb, cnt, WSP(int, WS_ELIST), 8, G, (int)blockIdx.x, 1};
            pg8::EpiSwiglu E{WSP(bf16_t, WS_ACT), p.b_gate + (size_t)l * 32 * 1024, p.b_up + (size_t)l * 32 * 1024};
            pg8::gemm_phase(lds, WSP(bf16_t, WS_H), WSP(bf16_t, WS_WGU), 1024, S, E);
            __syncthreads();
        } }
        SEAM(pb + 8);
        if constexpr (HAS(10)) { if (IN(pb + 9)) {
            LAS int* tb = (LAS int*)(lds + 131072); LAS int* cnt = tb + 40;
            moe_tile_prefix(p, l, tb, cnt);
            __syncthreads();
            pg8::MoeOrder S{tb, cnt, WSP(int, WS_ELIST), 4, G, (int)blockIdx.x, 0};
            pg8::EpiDown E{WSP(bf16_t, WS_YB), p.b_down + (size_t)l * 32 * 1024};
            pg8::gemm_phase(lds, WSP(bf16_t, WS_ACT), WSP(bf16_t, WS_WD), 1024, S, E);
            __syncthreads();
        } }
        SEAM(pb + 9);
    }
    if constexpr (HAS(11)) { if (IN(21)) norm_phase<2>(p, 1, lds); }
}

typedef void (*kern_t)(Params);
static kern_t kern_of_type(int ty) {
    switch (ty) {
        case 0: return fwd_kernel<1u << 0>; case 1: return fwd_kernel<1u << 1>; case 2: return fwd_kernel<1u << 2>; case 3: return fwd_kernel<1u << 3>;
        case 4: return fwd_kernel<1u << 4>; case 5: return fwd_kernel<1u << 5>; case 6: return fwd_kernel<1u << 6>; case 7: return fwd_kernel<1u << 7>;
        case 8: return fwd_kernel<1u << 8>; case 9: return fwd_kernel<1u << 9>; case 10: return fwd_kernel<1u << 10>; default: return fwd_kernel<1u << 11>;
    }
}
static int type_of_phase(int ph) { if (ph == 0) return 0; if (ph == 21) return 11; return 1 + (ph - 1) % 10; }

extern "C" void kernel_launch(void* const* d_in, const int* in_sizes, int n_in, void* d_out, int out_size, void* d_ws, size_t ws_size, hipStream_t stream) {
    static int grid = 0;
    if (grid == 0) {
        if (n_in != 23 || in_sizes[0] != T * D || out_size != T * D || ws_size < WS_END) {
            fprintf(stderr, "kernel_launch: unexpected shapes (n_in %d, in0 %d, out %d, ws %zu, need %zu)\n", n_in, n_in > 0 ? in_sizes[0] : -1, out_size, ws_size, (size_t)WS_END); grid = -1; return; }
        int dev = 0, cus = 0;
        if (hipGetDevice(&dev) != hipSuccess || hipDeviceGetAttribute(&cus, hipDeviceAttributeMultiprocessorCount, dev) != hipSuccess) { grid = -1; return; }
#if MK_ONE_LAUNCH
        if (hipFuncSetAttribute((const void*)fwd_kernel<0xFFFu>, hipFuncAttributeMaxDynamicSharedMemorySize, LDS_BYTES) != hipSuccess) { fprintf(stderr, "kernel_launch: hipFuncSetAttribute failed\n"); grid = -1; return; }
#else
        for (int ty = 0; ty < 12; ++ty)
            if (hipFuncSetAttribute((const void*)kern_of_type(ty), hipFuncAttributeMaxDynamicSharedMemorySize, LDS_BYTES) != hipSuccess) { fprintf(stderr, "kernel_launch: hipFuncSetAttribute failed\n"); grid = -1; return; }
#endif
        (void)hipGetLastError();
        grid = cus;
    }
    if (grid < 0) return;
    (void)hipMemsetAsync((char*)d_ws + WS_CTL, 0, CTL_BYTES, stream);
    Params p{};
    p.x = (const float*)d_in[0]; p.c = (const float*)d_in[1]; p.pos = (const int*)d_in[2];
    p.w_ada = (const float*)d_in[3]; p.b_ada = (const float*)d_in[4]; p.norm1_g = (const float*)d_in[5]; p.w_in = (const float*)d_in[6];
    p.conv_w = (const float*)d_in[7]; p.conv_b = (const float*)d_in[8]; p.b_ig = (const float*)d_in[9]; p.b_fg = (const float*)d_in[10];
    p.mnorm_g = (const float*)d_in[11]; p.w_out = (const float*)d_in[12]; p.norm2_g = (const float*)d_in[13]; p.w_router = (const float*)d_in[14];
    p.b_router = (const float*)d_in[15]; p.w_gate = (const float*)d_in[16]; p.b_gate = (const float*)d_in[17]; p.w_up = (const float*)d_in[18];
    p.b_up = (const float*)d_in[19]; p.w_down = (const float*)d_in[20]; p.b_down = (const float*)d_in[21]; p.fnorm_g = (const float*)d_in[22];
    p.out = (float*)d_out; p.ws = (unsigned char*)d_ws;
#if MK_ONE_LAUNCH
    p.ph_lo = 0; p.ph_hi = NPH;
    hipLaunchKernelGGL(fwd_kernel<0xFFFu>, dim3(grid), dim3(512), LDS_BYTES, stream, p);
#else
    for (int ph = 0; ph < NPH; ++ph) { p.ph_lo = ph; p.ph_hi = ph + 1; hipLaunchKernelGGL(kern_of_type(type_of_phase(ph)), dim3(grid), dim3(512), LDS_BYTES, stream, p); }
#endif
}
```

```cpp
#include <hip/hip_runtime.h>
#include <cstdio>
#include <cstdint>

#ifndef MK_ONE_LAUNCH
#define MK_ONE_LAUNCH 1
#endif

#define LAS __attribute__((address_space(3)))
typedef unsigned short bf16_t;
typedef short bf16x8 __attribute__((ext_vector_type(8)));
typedef float f32x4 __attribute__((ext_vector_type(4)));
typedef unsigned u32x4 __attribute__((ext_vector_type(4)));
typedef unsigned u32x2 __attribute__((ext_vector_type(2)));

constexpr int D = 1024, NB = 4, SEQ = 8192, T = NB * SEQ;
constexpr int NIN = 3592, NZ = 3584;
constexpr int ZQ = 0, ZK = 512, ZV = 1024, ZO = 1536, ZAQ = 2048, ZAK = 2560, ZAV = 3072;
constexpr int NE = 32;
constexpr int MAXT = 544;
constexpr float EPS = 1e-5f;
constexpr int NPH = 22;

constexpr size_t MiB = 1u << 20;
constexpr size_t WS_CTL = 0, CTL_BYTES = 1 * MiB;
constexpr size_t WS_MOD = 1 * MiB;
constexpr size_t WS_IG = 2 * MiB, WS_LF = 2 * MiB + 512 * 1024;
constexpr size_t WS_KPART = 3 * MiB;
constexpr size_t WS_G = 4 * MiB, WS_WMAX = 4 * MiB + 8192, WS_MPREV = 4 * MiB + 16384;
constexpr size_t WS_KS = 5 * MiB;
constexpr size_t WS_PE = 6 * MiB, WS_PROB = 6 * MiB + 512 * 1024;
constexpr size_t WS_ELIST = 7 * MiB;
constexpr size_t WS_PARTL = 11 * MiB;
constexpr size_t WS_WIN = 16 * MiB, WS_WOUT = 30 * MiB;
constexpr size_t WS_WGU = 36 * MiB, WS_WD = 164 * MiB;
constexpr size_t WS_X = 228 * MiB, WS_H = 356 * MiB, WS_POOL = 420 * MiB;
constexpr size_t WS_Z = WS_POOL, WS_CAT = WS_POOL + 224 * MiB, WS_PARTO = WS_POOL + 288 * MiB, WS_KVT = WS_POOL + 416 * MiB, WS_QLIST = WS_POOL + 480 * MiB;
constexpr size_t WS_ACT = WS_POOL, WS_YB = WS_POOL + 272 * MiB;
constexpr size_t WS_END = WS_POOL + 544 * MiB;
constexpr int CW_BAR = 1024;
constexpr int CW_ECNT = 8192;
constexpr int CW_QLEN = 16384;

constexpr int LDS_BYTES = 147456;

__device__ __forceinline__ unsigned f2bf(float f) { unsigned u = __builtin_bit_cast(unsigned, f); return (u + 0x7fffu + ((u >> 16) & 1u)) >> 16; }
__device__ __forceinline__ unsigned pk2(float lo, float hi) { return f2bf(lo) | (f2bf(hi) << 16); }
__device__ __forceinline__ float bf2f(unsigned b) { return __builtin_bit_cast(float, (b & 0xffffu) << 16); }
__device__ __forceinline__ float bflo(unsigned w) { return __builtin_bit_cast(float, w << 16); }
__device__ __forceinline__ float bfhi(unsigned w) { return __builtin_bit_cast(float, w & 0xffff0000u); }
__device__ __forceinline__ float wave_sum(float v) {
#pragma unroll
    for (int o = 1; o < 64; o <<= 1) v += __shfl_xor(v, o);
    return v;
}
__device__ __forceinline__ float sigmoidf_(float x) { return 1.0f / (1.0f + __expf(-x)); }
#define LDS_WAIT() asm volatile("s_waitcnt lgkmcnt(0)" ::: "memory")
__device__ __forceinline__ int otid() { int t = threadIdx.x; asm volatile("" : "+v"(t)); return t; }

#define XB_TMO      128
#define XB_XCNT(j)  (256  + 64 * (j))
#define XB_XSUB(j)  (1280 + 64 * (j))
#define XB_XGEN(j)  (2304 + 64 * (j))
#define XB_TOP      3328
#define XB_TOPGEN   3392
#define XCD_BAR_WORDS 3456
#define XB_SPIN_CAP (1u << 18)
__device__ __forceinline__ unsigned xb_ld(unsigned* p)              { return __hip_atomic_load(p, __ATOMIC_RELAXED, __HIP_MEMORY_SCOPE_AGENT); }
__device__ __forceinline__ unsigned xb_add(unsigned* p, unsigned v) { return __hip_atomic_fetch_add(p, v, __ATOMIC_RELAXED, __HIP_MEMORY_SCOPE_AGENT); }
__device__ __forceinline__ unsigned xb_xcc_id() { return (unsigned)__builtin_amdgcn_s_getreg((3 << 11) | 20) & 0xFu; }
#define XB_SPIN(cond, bar) do { unsigned _sp = 0; while (cond) { __builtin_amdgcn_s_sleep(1); \
    if ((++_sp & 255u) == 0u) { if (xb_ld(&(bar)[XB_TMO])) break; if (_sp > XB_SPIN_CAP) { atomicAdd(&(bar)[XB_TMO], 1u); break; } } } } while (0)
struct XcdBarrier { unsigned* bar; unsigned x; volatile LAS unsigned* st; };
__device__ __forceinline__ XcdBarrier xcd_barrier_post(unsigned* bar, volatile LAS unsigned* st) {
    XcdBarrier b; b.bar = bar; b.x = xb_xcc_id(); b.st = st;
    if (threadIdx.x == 0) (void)xb_add(&bar[XB_XCNT(b.x)], 1u);
    return b;
}
__device__ __forceinline__ void xcd_barrier_complete(unsigned* bar, unsigned x, unsigned& nloc, unsigned& nx) {
    const unsigned G = gridDim.x * gridDim.y * gridDim.z;
    unsigned sum, cnt, mine, sp = 0u;
    for (;;) {
        sum = 0u; cnt = 0u; mine = 0u;
#pragma unroll
        for (unsigned j = 0; j < 16; ++j) { const unsigned c = xb_ld(&bar[XB_XCNT(j)]); sum += c; cnt += (c > 0u) ? 1u : 0u; mine = (j == x) ? c : mine; }
        if (sum == G) break;
        __builtin_amdgcn_s_sleep(1);
        if ((++sp & 255u) == 0u) { if (xb_ld(&bar[XB_TMO])) break; if (sp > XB_SPIN_CAP) { atomicAdd(&bar[XB_TMO], 1u); break; } }
    }
    nloc = mine > 0u ? mine : 1u; nx = cnt > 0u ? cnt : 1u;
}
__device__ __forceinline__ void xcd_barrier(const XcdBarrier& b) {
    asm volatile("s_waitcnt vmcnt(0)" ::: "memory");
    __syncthreads();
    if (threadIdx.x == 0) {
        unsigned* bar = b.bar;
        __builtin_amdgcn_s_waitcnt(0);
        unsigned nloc = b.st[0], nx = b.st[1];
        if (nloc == 0u) { xcd_barrier_complete(bar, b.x, nloc, nx); b.st[0] = nloc; b.st[1] = nx; }
        const unsigned old = xb_add(&bar[XB_XSUB(b.x)], 1u);
        const unsigned gen = old / nloc;
        if (old + 1u == (gen + 1u) * nloc) {
            __builtin_amdgcn_fence(__ATOMIC_RELEASE, "agent");
            asm volatile("s_waitcnt vmcnt(0)" ::: "memory");
            const unsigned og = xb_add(&bar[XB_TOP], 1u);
            const unsigned tg = og / nx;
            if (og + 1u == (tg + 1u) * nx) xb_add(&bar[XB_TOPGEN], 1u);
            else XB_SPIN(xb_ld(&bar[XB_TOPGEN]) == tg, bar);
            __builtin_amdgcn_fence(__ATOMIC_ACQUIRE, "agent");
            xb_add(&bar[XB_XGEN(b.x)], 1u);
            asm volatile("s_waitcnt vmcnt(0)" ::: "memory");
        } else {
            XB_SPIN(xb_ld(&bar[XB_XGEN(b.x)]) == gen, bar);
            __builtin_amdgcn_fence(__ATOMIC_ACQUIRE, "agent");
            asm volatile("s_waitcnt vmcnt(0)" ::: "memory");
        }
    }
    __syncthreads();
}

namespace pg8 {
constexpr int BM = 256, BK = 64, HALF = 128, HTB = HALF * BK * 2, STAGE_BYTES = 8 * HTB, NXCD = 8, WGM = 8;
__device__ __forceinline__ int lds_byte(int r, int c) { const int st = (r >> 4) * 2 + (c >> 5), rr = r & 15, cc = c & 31, ob = rr * 64 + cc * 2; return st * 1024 + (ob ^ (((ob >> 9) & 1) << 5)); }
__device__ __forceinline__ void stage_rc(int b, int& R, int& C) { const int st = b / 1024, sb = b % 1024, swz = sb ^ (((sb >> 9) & 1) << 5); R = (st >> 1) * 16 + swz / 64; C = (st & 1) * 32 + (swz % 64) / 2; }
__device__ __forceinline__ int perm32(int rho) { const int n = rho >> 4, i = rho & 15; return 8 * (i >> 2) + 4 * n + (i & 3); }

struct Unit { int pm, pn, pb, e; };

struct StaticOrder {
    int nM, nN, nwg, G, c;
    __device__ __forceinline__ void init(int M, int N, int G_, int c_) { nM = M / BM; nN = N / BM; nwg = nM * nN; G = G_; c = c_; }
    __device__ __forceinline__ bool next(int i, Unit& u) const {
        const long L = (long)i * G + c; if (L >= nwg) return false;
        int wgid = (int)L; { const int q = nwg / NXCD, r = nwg % NXCD, xcd = wgid % NXCD, off = wgid / NXCD; wgid = (xcd < r ? xcd * (q + 1) : r * (q + 1) + (xcd - r) * q) + off; }
        const int nig = WGM * nN, gid = wgid / nig, fm = gid * WGM, gsz = (nM - fm) < WGM ? (nM - fm) : WGM;
        u.pm = fm + ((wgid % nig) % gsz); u.pn = (wgid % nig) / gsz; u.pb = u.pn; u.e = 0; return true;
    }
    __device__ __forceinline__ int arow(const Unit& u, int r) const { return u.pm * BM + r; }
};
struct MoeOrder {
    const LAS int* tb; const LAS int* cnt; const int* elist; int npn, G, c, gather;
    __device__ __forceinline__ bool next(int i, Unit& u) const {
        const int L = i * G + c; const int NT = tb[32];
        if (L >= NT * npn) return false;
        const int mt = L / npn; u.pn = L - mt * npn; u.pm = mt;
        int e = 0;
        for (int j = 1; j < 32; ++j) e += (tb[j] <= mt) ? 1 : 0;
        u.e = e; u.pb = e * npn + u.pn; return true;
    }
    __device__ __forceinline__ int arow(const Unit& u, int r) const {
        if (!gather) return u.pm * BM + r;
        const int rank = (u.pm - tb[u.e]) * BM + r;
        int row = 0;
        if (rank < cnt[u.e]) row = elist[u.e * 32768 + rank];
        return row;
    }
};

__device__ __forceinline__ unsigned cvt_pk_bf16(float lo, float hi) { unsigned r; asm volatile("v_cvt_pk_bf16_f32 %0, %1, %2" : "=v"(r) : "v"(lo), "v"(hi)); return r; }

struct EpiZ {
    static constexpr bool PERM = true;
    bf16_t* O; int ldc;
    __device__ __forceinline__ void operator()(const f32x4 (&acc)[2][2][4][2], const Unit& u, int wr, int wc, int fr, int fq) const {
        const int row0 = u.pm * BM + wr * 64 + fr, col0 = u.pn * BM + wc * 32 + 8 * fq;
#pragma unroll
        for (int ai = 0; ai < 2; ++ai)
#pragma unroll
            for (int m = 0; m < 4; ++m) { bf16_t* rowp = O + (size_t)(row0 + ai * HALF + m * 16) * ldc + col0;
#pragma unroll
                for (int bj = 0; bj < 2; ++bj) { const f32x4 v0 = acc[ai][bj][m][0], v1 = acc[ai][bj][m][1];
                    u32x4 w; w.x = cvt_pk_bf16(v0[0], v0[1]); w.y = cvt_pk_bf16(v0[2], v0[3]); w.z = cvt_pk_bf16(v1[0], v1[1]); w.w = cvt_pk_bf16(v1[2], v1[3]);
                    *(u32x4*)(rowp + bj * HALF) = w; } }
    }
};
struct EpiRes {
    static constexpr bool PERM = false;
    const float* Xin; float* Xout; const float* gate;
    __device__ __forceinline__ void operator()(const f32x4 (&acc)[2][2][4][2], const Unit& u, int wr, int wc, int fr, int fq) const {
        const int row0 = u.pm * BM + wr * 64 + fr, col0 = u.pn * BM + wc * 32 + 4 * fq;
        const int b = (u.pm * BM) >> 13;
        f32x4 gv[2][2];
#pragma unroll
        for (int bj = 0; bj < 2; ++bj)
#pragma unroll
            for (int n = 0; n < 2; ++n) gv[bj][n] = *(const f32x4*)(gate + b * 6144 + col0 + bj * HALF + n * 16);
#pragma unroll
        for (int ai = 0; ai < 2; ++ai)
#pragma unroll
            for (int m = 0; m < 4; ++m) { const size_t off = (size_t)(row0 + ai * HALF + m * 16) * D + col0;
#pragma unroll
                for (int bj = 0; bj < 2; ++bj)
#pragma unroll
                    for (int n = 0; n < 2; ++n) { const f32x4 xi = *(const f32x4*)(Xin + off + bj * HALF + n * 16);
                        *(f32x4*)(Xout + off + bj * HALF + n * 16) = xi + gv[bj][n] * acc[ai][bj][m][n]; } }
    }
};
struct EpiSwiglu {
    static constexpr bool PERM = true;
    bf16_t* O; const float* bg; const float* bu;
    __device__ __forceinline__ void operator()(const f32x4 (&acc)[2][2][4][2], const Unit& u, int wr, int wc, int fr, int fq) const {
        const int row0 = u.pm * BM + wr * 64 + fr, j0 = u.pn * HALF + wc * 32 + 8 * fq;
        f32x4 g0 = *(const f32x4*)(bg + u.e * 1024 + j0), g1 = *(const f32x4*)(bg + u.e * 1024 + j0 + 4);
        f32x4 u0 = *(const f32x4*)(bu + u.e * 1024 + j0), u1 = *(const f32x4*)(bu + u.e * 1024 + j0 + 4);
#pragma unroll
        for (int ai = 0; ai < 2; ++ai)
#pragma unroll
            for (int m = 0; m < 4; ++m) { bf16_t* rowp = O + (size_t)(row0 + ai * HALF + m * 16) * D + j0;
                float r[8];
#pragma unroll
                for (int n = 0; n < 2; ++n)
#pragma unroll
                    for (int j = 0; j < 4; ++j) {
                        float gt = acc[ai][0][m][n][j] + (n ? g1[j] : g0[j]); float up = acc[ai][1][m][n][j] + (n ? u1[j] : u0[j]);
                        gt = fminf(gt, 7.0f); up = fminf(fmaxf(up, -7.0f), 7.0f);
                        r[n * 4 + j] = (up + 1.0f) * (gt / (1.0f + __expf(-1.702f * gt))); }
                u32x4 w; w.x = cvt_pk_bf16(r[0], r[1]); w.y = cvt_pk_bf16(r[2], r[3]); w.z = cvt_pk_bf16(r[4], r[5]); w.w = cvt_pk_bf16(r[6], r[7]);
                *(u32x4*)rowp = w; }
    }
};
struct EpiDown {
    static constexpr bool PERM = true;
    bf16_t* O; const float* bd;
    __device__ __forceinline__ void operator()(const f32x4 (&acc)[2][2][4][2], const Unit& u, int wr, int wc, int fr, int fq) const {
        const int row0 = u.pm * BM + wr * 64 + fr, col0 = u.pn * BM + wc * 32 + 8 * fq;
#pragma unroll
        for (int bj = 0; bj < 2; ++bj) {
            const f32x4 b0 = *(const f32x4*)(bd + u.e * 1024 + col0 + bj * HALF), b1 = *(const f32x4*)(bd + u.e * 1024 + col0 + bj * HALF + 4);
#pragma unroll
            for (int ai = 0; ai < 2; ++ai)
#pragma unroll
                for (int m = 0; m < 4; ++m) { bf16_t* rowp = O + (size_t)(row0 + ai * HALF + m * 16) * D + col0 + bj * HALF;
                    const f32x4 v0 = acc[ai][bj][m][0] + b0, v1 = acc[ai][bj][m][1] + b1;
                    u32x4 w; w.x = cvt_pk_bf16(v0[0], v0[1]); w.y = cvt_pk_bf16(v0[2], v0[3]); w.z = cvt_pk_bf16(v1[0], v1[1]); w.w = cvt_pk_bf16(v1[2], v1[3]);
                    *(u32x4*)rowp = w; }
            asm volatile("" ::: "memory");
        }
    }
};

template <class Epi, class Sched>
__device__ __forceinline__ void gemm_phase(LAS unsigned char* lds, const bf16_t* A, const bf16_t* Bt, const int K, const Sched& S, const Epi& E) {
    const int tid = otid(), wid = __builtin_amdgcn_readfirstlane(tid >> 6), lane = tid & 63, wr = wid >> 2, wc = wid & 3, fr = lane & 15, fq = lane >> 4;
    const int nt = K / BK;
    unsigned voffB[2];
#pragma unroll
    for (int i = 0; i < 2; ++i) { int R, C; stage_rc(tid * 16 + i * 8192, R, C); const int Rb = Epi::PERM ? ((R & ~31) + perm32(R & 31)) : R;
        voffB[i] = (unsigned)(Rb * K + C) * 2u; }
    const size_t kstep = (size_t)(BK * 2);
    const size_t hstep = (size_t)HALF * K * 2;
    const size_t tstep = 2 * hstep;
    const unsigned ldsw = (unsigned)wid * 1024u;
    const int aoff = lds_byte(wr * 64 + fr, fq * 8), boff = lds_byte(wc * 32 + fr, fq * 8);
#define PG8_SA(b, h) (((b) * 2 + (h)) * HTB)
#define PG8_SB(b, h) ((4 + (b) * 2 + (h)) * HTB)
#define PG8_STAGE(bufoff, gbase, voff) do { _Pragma("unroll") for (int _i = 0; _i < 2; ++_i) \
        __builtin_amdgcn_global_load_lds((const unsigned*)((const char*)(gbase) + (voff)[_i]), (LAS unsigned*)(lds + (bufoff) + ldsw + _i * 8192), 16, 0, 0); } while (0)
#define PG8_LDA(dst, b, h) do { _Pragma("unroll") for (int m = 0; m < 4; ++m) _Pragma("unroll") for (int k = 0; k < 2; ++k) dst[m][k] = *(const LAS bf16x8*)(lds + PG8_SA(b, h) + aoff + m * 2048 + k * 1024); } while (0)
#define PG8_LDB(dst, b, h) do { _Pragma("unroll") for (int n = 0; n < 2; ++n) _Pragma("unroll") for (int k = 0; k < 2; ++k) dst[n][k] = *(const LAS bf16x8*)(lds + PG8_SB(b, h) + boff + n * 2048 + k * 1024); } while (0)
#define PG8_MMA(ai, bj, At, Bt_) do { __builtin_amdgcn_s_setprio(1); _Pragma("unroll") for (int m = 0; m < 4; ++m) _Pragma("unroll") for (int n = 0; n < 2; ++n) _Pragma("unroll") for (int k = 0; k < 2; ++k) \
        acc[ai][bj][m][n] = __builtin_amdgcn_mfma_f32_16x16x32_bf16(Bt_[n][k], At[m][k], acc[ai][bj][m][n], 0, 0, 0); __builtin_amdgcn_s_setprio(0); } while (0)
#define PG8_WAIT_V(n) asm volatile("s_waitcnt vmcnt(" #n ")" ::: "memory")
#define PG8_WAIT_L(n) asm volatile("s_waitcnt lgkmcnt(" #n ")" ::: "memory")
#define PG8_BAR __builtin_amdgcn_s_barrier()
#define PG8_SCHED __builtin_amdgcn_sched_barrier(0)
#define PG8_OFFS(u, o) do { _Pragma("unroll") for (int _i = 0; _i < 2; ++_i) { int _R, _C; stage_rc(tid * 16 + _i * 8192, _R, _C); \
        _Pragma("unroll") for (int _h = 0; _h < 2; ++_h) { unsigned _o = (unsigned)(S.arow(u, _h * HALF + _R) * K + _C) * 2u; asm volatile("" : "+v"(_o)); o[_h][_i] = _o; } } } while (0)
    Unit cur, nxt; int ui = 0;
    if (!S.next(0, cur)) return;
    f32x4 acc[2][2][4][2];
#pragma unroll
    for (int a = 0; a < 2; ++a)
#pragma unroll
        for (int b = 0; b < 2; ++b)
#pragma unroll
            for (int m = 0; m < 4; ++m)
#pragma unroll
                for (int n = 0; n < 2; ++n) acc[a][b][m][n] = (f32x4){0.f, 0.f, 0.f, 0.f};
    bf16x8 At[4][2], B0[2][2], B1[2][2];
    unsigned oC[2][2];
    PG8_OFFS(cur, oC);
    const char* Ab = (const char*)A;
    const char* cB = (const char*)Bt + (size_t)cur.pb * tstep;
    PG8_STAGE(PG8_SB(0, 0), cB, voffB); PG8_STAGE(PG8_SA(0, 0), Ab, oC[0]); PG8_STAGE(PG8_SB(0, 1), cB + hstep, voffB); PG8_STAGE(PG8_SA(0, 1), Ab, oC[1]);
    if (wr == 1) PG8_BAR;
    PG8_WAIT_V(4); PG8_BAR;
    PG8_STAGE(PG8_SB(1, 0), cB + kstep, voffB); PG8_STAGE(PG8_SA(1, 0), Ab + kstep, oC[0]); PG8_STAGE(PG8_SB(1, 1), cB + hstep + kstep, voffB);
    PG8_WAIT_V(6); PG8_BAR;
    for (;;) {
        const bool has_next = S.next(ui + 1, nxt);
        const char* nB = has_next ? (const char*)Bt + (size_t)nxt.pb * tstep : cB;
        for (int t = 0; t < nt; t += 2) {
            const bool last = (t == nt - 2);
            const char* a1 = Ab + (size_t)(t + 1) * kstep;
            const char* a2 = last ? Ab : Ab + (size_t)(t + 2) * kstep; const char* b2 = last ? nB : cB + (size_t)(t + 2) * kstep;
            const char* a3 = a2 + kstep; const char* b3 = b2 + kstep;
            PG8_LDB(B0, 0, 0); PG8_SCHED; PG8_LDA(At, 0, 0); PG8_STAGE(PG8_SA(1, 1), a1, oC[1]);
            PG8_WAIT_L(8); PG8_BAR; PG8_WAIT_L(0); PG8_MMA(0, 0, At, B0); PG8_BAR; PG8_SCHED;
            if (last && has_next) { PG8_OFFS(nxt, oC); }
            PG8_LDB(B1, 0, 1); PG8_STAGE(PG8_SB(0, 0), b2, voffB);
            PG8_BAR; PG8_WAIT_L(0); PG8_MMA(0, 1, At, B1); PG8_BAR;
            PG8_LDA(At, 0, 1); PG8_STAGE(PG8_SA(0, 0), a2, oC[0]);
            PG8_BAR; PG8_WAIT_L(0); PG8_MMA(1, 0, At, B0); PG8_BAR; PG8_SCHED;
            PG8_STAGE(PG8_SB(0, 1), b2 + hstep, voffB);
            PG8_WAIT_V(6); PG8_BAR; PG8_MMA(1, 1, At, B1); PG8_BAR;
            PG8_LDB(B0, 1, 0); PG8_SCHED; PG8_LDA(At, 1, 0); PG8_STAGE(PG8_SA(0, 1), a2, oC[1]);
            PG8_WAIT_L(8); PG8_BAR; PG8_WAIT_L(0); PG8_MMA(0, 0, At, B0); PG8_BAR; PG8_SCHED;
            PG8_LDB(B1, 1, 1); PG8_STAGE(PG8_SB(1, 0), b3, voffB);
            PG8_BAR; PG8_WAIT_L(0); PG8_MMA(0, 1, At, B1); PG8_BAR;
            PG8_LDA(At, 1, 1); PG8_STAGE(PG8_SA(1, 0), a3, oC[0]);
            PG8_BAR; PG8_WAIT_L(0); PG8_MMA(1, 0, At, B0); PG8_BAR; PG8_SCHED;
            PG8_STAGE(PG8_SB(1, 1), b3 + hstep, voffB);
            PG8_WAIT_V(6); PG8_BAR; PG8_MMA(1, 1, At, B1); PG8_BAR;
        }
        E(acc, cur, wr, wc, fr, fq);
        if (!has_next) break;
#pragma unroll
        for (int a = 0; a < 2; ++a)
#pragma unroll
            for (int b = 0; b < 2; ++b)
#pragma unroll
                for (int m = 0; m < 4; ++m)
#pragma unroll
                    for (int n = 0; n < 2; ++n) acc[a][b][m][n] = (f32x4){0.f, 0.f, 0.f, 0.f};
        cur = nxt; cB = nB; ++ui;
    }
    PG8_WAIT_V(0);
    if (wr == 0) PG8_BAR;
    PG8_BAR;
#undef PG8_SA
#undef PG8_SB
#undef PG8_STAGE
#undef PG8_LDA
#undef PG8_LDB
#undef PG8_MMA
#undef PG8_WAIT_V
#undef PG8_WAIT_L
#undef PG8_BAR
#undef PG8_SCHED
#undef PG8_OFFS
}
}

struct Params {
    const float *x, *c; const int* pos;
    const float *w_ada, *b_ada, *norm1_g, *w_in, *conv_w, *conv_b, *b_ig, *b_fg, *mnorm_g, *w_out, *norm2_g, *w_router, *b_router,
                *w_gate, *b_gate, *w_up, *b_up, *w_down, *b_down, *fnorm_g;
    float* out; unsigned char* ws; int ph_lo, ph_hi;
};
#define WSP(type, off) ((type*)(p.ws + (off)))
typedef const __attribute__((address_space(4))) Params* ParamsK;
#if defined(__HIP_DEVICE_COMPILE__)
__device__ __forceinline__ ParamsK kparams() { ParamsK k = (ParamsK)__builtin_amdgcn_kernarg_segment_ptr(); asm volatile("" : "+s"(k)); return k; }
#define LOADP() (*kparams())
#else
#define LOADP() (Params{})
#endif
#define MFMA16(a, b, c) __builtin_amdgcn_mfma_f32_16x16x32_bf16((a), (b), (c), 0, 0, 0)

__device__ __forceinline__ void tr_item(const float* __restrict__ W, int ldw, int k0, int nsrc0, bf16_t* __restrict__ WT, int K, int drow0, LAS float* scr, int lane) {
#pragma unroll
    for (int i = 0; i < 32; ++i) { const int kk = 2 * i + (lane >> 5); scr[kk * 33 + (lane & 31)] = W[(size_t)(k0 + kk) * ldw + nsrc0 + (lane & 31)]; }
    LDS_WAIT();
    const int c = lane & 7;
#pragma unroll
    for (int j = 0; j < 4; ++j) { const int n = (lane >> 3) + 8 * j; const LAS float* s = scr + (8 * c) * 33 + n;
        u32x4 o; o.x = pk2(s[0 * 33], s[1 * 33]); o.y = pk2(s[2 * 33], s[3 * 33]); o.z = pk2(s[4 * 33], s[5 * 33]); o.w = pk2(s[6 * 33], s[7 * 33]);
        *(u32x4*)(WT + (size_t)(drow0 + n) * K + k0 + 8 * c) = o; }
    LDS_WAIT();
}
__device__ __forceinline__ void convert_moe(const Params& p, int l, LAS unsigned char* lds) {
    const int tid = otid(), lane = tid & 63, wave = tid >> 6;
    LAS float* scr = (LAS float*)(lds + wave * 8448);
    const int gw = blockIdx.x * 8 + wave, NGW = gridDim.x * 8;
    bf16_t* WGU = WSP(bf16_t, WS_WGU); bf16_t* WD = WSP(bf16_t, WS_WD);
    for (int it = gw; it < NE * 1536; it += NGW) {
        const int e = it / 1536, r = it % 1536, mat = r / 512, q = r % 512, kb = q / 32, nb = q % 32, k0 = kb * 64, n0 = nb * 32;
        const size_t eo = (size_t)(l * NE + e) * 1024 * 1024;
        if (mat == 0) tr_item(p.w_gate + eo, 1024, k0, n0, WGU + (size_t)e * 2048 * 1024, 1024, (n0 >> 7) * 256 + (n0 & 127), scr, lane);
        else if (mat == 1) tr_item(p.w_up + eo, 1024, k0, n0, WGU + (size_t)e * 2048 * 1024, 1024, (n0 >> 7) * 256 + 128 + (n0 & 127), scr, lane);
        else tr_item(p.w_down + eo, 1024, k0, n0, WD + (size_t)e * 1024 * 1024, 1024, n0, scr, lane);
    }
}
__device__ __forceinline__ void prologue_phase(const Params& p, LAS unsigned char* lds) {
    const int tid = otid(), lane = tid & 63, wave = tid >> 6;
    const int G = gridDim.x;
    {
        LAS float* condl = (LAS float*)(lds + 70000);
        LAS float* red = (LAS float*)(lds + 70000 + 16384);
        for (int i = tid; i < 4096; i += 512) { const float cv = p.c[i]; condl[i] = cv / (1.0f + __expf(-cv)); }
        __syncthreads();
        float* MOD = WSP(float, WS_MOD);
        for (int u = blockIdx.x; u < 192; u += G) {
            const int l = u / 96, n0 = (u % 96) * 64;
            const float* w = p.w_ada + (size_t)l * 1024 * 6144 + n0 + lane;
            float a0 = 0.f, a1 = 0.f, a2 = 0.f, a3 = 0.f;
#pragma unroll 16
            for (int kk = 0; kk < 128; ++kk) { const int k = wave * 128 + kk; const float wv = w[(size_t)k * 6144];
                a0 += condl[k] * wv; a1 += condl[1024 + k] * wv; a2 += condl[2048 + k] * wv; a3 += condl[3072 + k] * wv; }
            red[(wave * 4 + 0) * 64 + lane] = a0; red[(wave * 4 + 1) * 64 + lane] = a1; red[(wave * 4 + 2) * 64 + lane] = a2; red[(wave * 4 + 3) * 64 + lane] = a3;
            __syncthreads();
            if (tid < 256) { const int b = tid >> 6, ln = tid & 63; float s = p.b_ada[l * 6144 + n0 + ln];
#pragma unroll
                for (int w8 = 0; w8 < 8; ++w8) s += red[(w8 * 4 + b) * 64 + ln];
                MOD[(size_t)(l * 4 + b) * 6144 + n0 + ln] = s; }
            __syncthreads();
        }
    }
    {
        LAS float* scr = (LAS float*)(lds + wave * 8448);
        const int gw = blockIdx.x * 8 + wave, NGW = G * 8;
        bf16_t* WIN = WSP(bf16_t, WS_WIN); bf16_t* WOUT = WSP(bf16_t, WS_WOUT);
        constexpr int I_IN = 16 * 112, I_OUT = 16 * 32;
        for (int it = gw; it < 2 * I_IN + 2 * I_OUT; it += NGW) {
            if (it < 2 * I_IN) { const int l = it / I_IN, r = it % I_IN, kb = r / 112, nb = r % 112, n0 = nb * 32;
                tr_item(p.w_in + (size_t)l * 1024 * NIN, NIN, kb * 64, n0 < 2048 ? n0 : n0 + 8, WIN + (size_t)l * NZ * 1024, 1024, n0, scr, lane); }
            else { const int r2 = it - 2 * I_IN, l = r2 / I_OUT, r = r2 % I_OUT, kb = r / 32, nb = r % 32;
                tr_item(p.w_out + (size_t)l * 1024 * 1024, 1024, kb * 64, nb * 32, WOUT + (size_t)l * 1024 * 1024, 1024, nb * 32, scr, lane); }
        }
    }
    convert_moe(p, 0, lds);
}

__device__ __forceinline__ void moe_tile_prefix(const Params& p, int lm, LAS int* tb, LAS int* cnt) {
    if (threadIdx.x == 0) { const unsigned* ec = WSP(unsigned, WS_CTL) + CW_ECNT + lm * 64; int s = 0;
        for (int j = 0; j < 32; ++j) { const int c = (int)ec[j]; cnt[j] = c; tb[j] = s; s += (c + 255) >> 8; } tb[32] = s; }
}
template <int MODE>
__device__ __forceinline__ void norm_phase(const Params& p, int l, LAS unsigned char* lds) {
    const int tid = otid(), lane = tid & 63, wave = tid >> 6;
    LAS float* Wg = (LAS float*)lds;
    LAS int* tb = (LAS int*)(lds + 32768); LAS int* cnt = tb + 40;
    if (MODE != 2) { const float* wi = p.w_in + (size_t)l * 1024 * NIN + 2048;
        for (int i = tid; i < 8192; i += 512) Wg[i] = wi[(size_t)(i >> 3) * NIN + (i & 7)]; }
    if (MODE >= 1) moe_tile_prefix(p, MODE == 1 ? l - 1 : 1, tb, cnt);
    __syncthreads();
    const int lm = (MODE == 1) ? l - 1 : 1;
    const float* MOD = WSP(float, WS_MOD);
    float* X = WSP(float, WS_X); bf16_t* H = WSP(bf16_t, WS_H);
    const bf16_t* YB = WSP(bf16_t, WS_YB);
    const unsigned* PE = WSP(unsigned, WS_PE); const float* PROB = WSP(float, WS_PROB);
    float* IG = WSP(float, WS_IG); float* LF = WSP(float, WS_LF);
    const int gw = blockIdx.x * 8 + wave, NGW = gridDim.x * 8;
    for (int row = gw; row < T; row += NGW) {
        const int b = row >> 13;
        const float* xr = (MODE == 0 ? p.x : X) + (size_t)row * D;
        f32x4 v[4];
#pragma unroll
        for (int j = 0; j < 4; ++j) v[j] = *(const f32x4*)(xr + 4 * lane + 256 * j);
        if (MODE >= 1) {
            f32x4 y[4];
#pragma unroll
            for (int j = 0; j < 4; ++j) y[j] = (f32x4){0.f, 0.f, 0.f, 0.f};
#pragma unroll
            for (int k = 0; k < 4; ++k) {
                const unsigned pe = PE[row * 4 + k]; const float pr = PROB[row * 4 + k];
                const int e = pe & 255u, rank = pe >> 8; const size_t srow = (size_t)tb[e] * 256 + rank;
                const bf16_t* yb = YB + srow * D;
#pragma unroll
                for (int j = 0; j < 4; ++j) { const u32x2 w = *(const u32x2*)(yb + 4 * lane + 256 * j);
                    y[j][0] += pr * bflo(w.x); y[j][1] += pr * bfhi(w.x); y[j][2] += pr * bflo(w.y); y[j][3] += pr * bfhi(w.y); }
            }
            const float* g2 = MOD + (size_t)(lm * 4 + b) * 6144 + 5120;
#pragma unroll
            for (int j = 0; j < 4; ++j) { const f32x4 gg = *(const f32x4*)(g2 + 4 * lane + 256 * j); v[j] += gg * y[j]; }
            if (MODE == 1) {
#pragma unroll
                for (int j = 0; j < 4; ++j) *(f32x4*)(X + (size_t)row * D + 4 * lane + 256 * j) = v[j];
            }
        }
        float ss = 0.f;
#pragma unroll
        for (int j = 0; j < 4; ++j) ss += (v[j][0] * v[j][0] + v[j][1] * v[j][1]) + (v[j][2] * v[j][2] + v[j][3] * v[j][3]);
        const float rstd = 1.0f / sqrtf(wave_sum(ss) * (1.0f / D) + EPS);
        if (MODE == 2) {
#pragma unroll
            for (int j = 0; j < 4; ++j) { const f32x4 g = *(const f32x4*)(p.fnorm_g + 4 * lane + 256 * j);
                *(f32x4*)(p.out + (size_t)row * D + 4 * lane + 256 * j) = v[j] * rstd * g; }
        } else {
            const float* mb = MOD + (size_t)(l * 4 + b) * 6144;
            float ga[8];
#pragma unroll
            for (int c = 0; c < 8; ++c) ga[c] = 0.f;
#pragma unroll
            for (int j = 0; j < 4; ++j) {
                const int n = 4 * lane + 256 * j;
                const f32x4 g = *(const f32x4*)(p.norm1_g + l * D + n), sh = *(const f32x4*)(mb + n), sc = *(const f32x4*)(mb + 1024 + n);
                const f32x4 h = v[j] * rstd * g * (sc + 1.0f) + sh;
                u32x2 w; w.x = pk2(h[0], h[1]); w.y = pk2(h[2], h[3]);
                *(u32x2*)(H + (size_t)row * D + n) = w;
#pragma unroll
                for (int i = 0; i < 4; ++i) { const f32x4 w0 = *(const LAS f32x4*)(Wg + (n + i) * 8), w1 = *(const LAS f32x4*)(Wg + (n + i) * 8 + 4);
                    ga[0] += h[i] * w0[0]; ga[1] += h[i] * w0[1]; ga[2] += h[i] * w0[2]; ga[3] += h[i] * w0[3];
                    ga[4] += h[i] * w1[0]; ga[5] += h[i] * w1[1]; ga[6] += h[i] * w1[2]; ga[7] += h[i] * w1[3]; }
                asm volatile("" ::: "memory");
            }
#pragma unroll
            for (int c = 0; c < 8; ++c) ga[c] = wave_sum(ga[c]);
            if (lane < 8) {
                float gsel = ga[0];
#pragma unroll
                for (int c = 1; c < 8; ++c) gsel = (lane == c) ? ga[c] : gsel;
                if (lane < 4) { const float t = gsel + p.b_ig[l * 4 + lane]; IG[row * 4 + lane] = 15.0f * tanhf(t * (1.0f / 15.0f)); }
                else { const float t = gsel + p.b_fg[l * 4 + lane - 4]; const float f = 15.0f * tanhf(t * (1.0f / 15.0f));
                    LF[row * 4 + lane - 4] = fminf(f, 0.f) - log1pf(__expf(-fabsf(f))); }
            }
        }
    }
}

__device__ __forceinline__ void conv16(const bf16_t* Zb, int tpos, int zcol, const float* cw, const float* cb, int ch0, float (&o)[16]) {
#pragma unroll
    for (int i = 0; i < 16; ++i) o[i] = cb[ch0 + i];
#pragma unroll
    for (int j = 0; j < 4; ++j) {
        const int tp = tpos - 3 + j;
        if (tp >= 0) {
            const u32x4 a = *(const u32x4*)(Zb + (size_t)tp * NZ + zcol), b = *(const u32x4*)(Zb + (size_t)tp * NZ + zcol + 8);
            const unsigned w[8] = {a.x, a.y, a.z, a.w, b.x, b.y, b.z, b.w};
#pragma unroll
            for (int i = 0; i < 8; ++i) { o[2 * i] += cw[j * 1024 + ch0 + 2 * i] * bflo(w[i]); o[2 * i + 1] += cw[j * 1024 + ch0 + 2 * i + 1] * bfhi(w[i]); }
        }
    }
#pragma unroll
    for (int i = 0; i < 16; ++i) o[i] = o[i] / (1.0f + __expf(-o[i]));
}
__device__ __forceinline__ void mlstm_a_unit(const Params& p, int l, int u, LAS unsigned char* lds) {
    const int tid = otid(), lane = tid & 63, wave = tid >> 6, fr = lane & 15, fq = lane >> 4;
    const int c = u & 127, hd = (u >> 7) & 3, b = u >> 9;
    LAS bf16_t* kwT = (LAS bf16_t*)lds;
    LAS bf16_t* vT = (LAS bf16_t*)(lds + 18432);
    LAS float* ewl = (LAS float*)(lds + 36864);
    const bf16_t* Zb = WSP(bf16_t, WS_Z) + (size_t)b * SEQ * NZ;
    const int t0 = c * 64;
    if (tid < 64) {
        const int row = b * SEQ + t0 + tid;
        const float lf = WSP(float, WS_LF)[row * 4 + hd], ig = WSP(float, WS_IG)[row * 4 + hd];
        float bc = lf;
#pragma unroll
        for (int o = 1; o < 64; o <<= 1) { const float t = __shfl_up(bc, o); if (lane >= o) bc += t; }
        const float g = __shfl(bc, 63);
        const float w = g - bc + ig;
        float wm = w;
#pragma unroll
        for (int o = 1; o < 64; o <<= 1) wm = fmaxf(wm, __shfl_xor(wm, o));
        ewl[tid] = __expf(w - wm);
        if (tid == 0) { WSP(float, WS_G)[u] = g; WSP(float, WS_WMAX)[u] = wm; }
    }
    __syncthreads();
    {
        const int t = tid >> 3, d0 = (tid & 7) * 16;
        float kc[16];
        conv16(Zb, t0 + t, ZK + hd * 128 + d0, p.conv_w + l * 4096, p.conv_b + l * 1024, 512 + hd * 128 + d0, kc);
        const float sc = 0.08838834764831845f * ewl[t];
#pragma unroll
        for (int i = 0; i < 16; ++i) kwT[(d0 + i) * 72 + t] = (bf16_t)f2bf(kc[i] * sc);
        const bf16_t* vr = Zb + (size_t)(t0 + t) * NZ + ZV + hd * 128 + d0;
        const u32x4 a = *(const u32x4*)vr, bb = *(const u32x4*)(vr + 8);
        const unsigned w[8] = {a.x, a.y, a.z, a.w, bb.x, bb.y, bb.z, bb.w};
#pragma unroll
        for (int i = 0; i < 8; ++i) { vT[(d0 + 2 * i) * 72 + t] = (bf16_t)(w[i] & 0xffffu); vT[(d0 + 2 * i + 1) * 72 + t] = (bf16_t)(w[i] >> 16); }
    }
    __syncthreads();
    if (tid < 128) { float s = 0.f;
        for (int k = 0; k < 64; ++k) s += bf2f(kwT[tid * 72 + k]);
        WSP(float, WS_KS)[u * 128 + tid] = s; }
    {
        const int e0 = wave * 16;
        bf16x8 a[2];
#pragma unroll
        for (int kk = 0; kk < 2; ++kk) a[kk] = *(const LAS bf16x8*)(vT + (e0 + fr) * 72 + kk * 32 + 8 * fq);
        bf16_t* KVT = WSP(bf16_t, WS_KVT) + (size_t)u * 16384;
#pragma unroll
        for (int dt = 0; dt < 8; ++dt) {
            f32x4 acc = (f32x4){0.f, 0.f, 0.f, 0.f};
#pragma unroll
            for (int kk = 0; kk < 2; ++kk) { const bf16x8 bq = *(const LAS bf16x8*)(kwT + (dt * 16 + fr) * 72 + kk * 32 + 8 * fq); acc = MFMA16(a[kk], bq, acc); }
#pragma unroll
            for (int i = 0; i < 4; ++i) KVT[(e0 + 4 * fq + i) * 128 + dt * 16 + fr] = (bf16_t)f2bf(acc[i]);
        }
    }
    __syncthreads();
}
__device__ __forceinline__ void mlstm_b_unit(const Params& p, int u) {
    const int tid = otid();
    const int slice = u & 15, bh = u >> 4;
    bf16_t* base = WSP(bf16_t, WS_KVT) + (size_t)bh * 128 * 16384 + slice * 1024 + tid * 2;
    const float* Gs = WSP(float, WS_G) + bh * 128; const float* Wm = WSP(float, WS_WMAX) + bh * 128;
    float* MP = WSP(float, WS_MPREV) + bh * 128; float* KS = WSP(float, WS_KS) + (size_t)bh * 128 * 128;
    const bool don = (slice == 0) && (tid < 128);
    float m = -INFINITY, c0 = 0.f, c1 = 0.f, nst = 0.f;
    for (int cb = 0; cb < 128; cb += 16) {
        unsigned kv[16]; float ksv[16];
#pragma unroll
        for (int i = 0; i < 16; ++i) { kv[i] = *(const unsigned*)(base + (size_t)(cb + i) * 16384); ksv[i] = don ? KS[(cb + i) * 128 + tid] : 0.f; }
#pragma unroll
        for (int i = 0; i < 16; ++i) {
            const int c = cb + i;
            *(unsigned*)(base + (size_t)c * 16384) = pk2(c0, c1);
            if (don) KS[c * 128 + tid] = nst;
            if (slice == 0 && tid == 0) MP[c] = m;
            const float g = Gs[c], wm = Wm[c];
            const float mn = fmaxf(g + m, wm);
            const float dec = __expf(g + m - mn), inj = __expf(wm - mn);
            c0 = dec * c0 + inj * bflo(kv[i]); c1 = dec * c1 + inj * bfhi(kv[i]); nst = dec * nst + inj * ksv[i];
            m = mn;
        }
    }
}
__device__ __forceinline__ void mlstm_c_unit(const Params& p, int l, int u, LAS unsigned char* lds) {
    const int tid = otid(), lane = tid & 63, wave = tid >> 6, fr = lane & 15, fq = lane >> 4;
    const int c = u & 127, hd = (u >> 7) & 3, b = u >> 9;
    LAS bf16_t* qs = (LAS bf16_t*)lds;
    LAS bf16_t* ks = (LAS bf16_t*)(lds + 17408);
    LAS bf16_t* vT = (LAS bf16_t*)(lds + 34816);
    LAS bf16_t* CT = (LAS bf16_t*)(lds + 53248);
    LAS bf16_t* Ps = (LAS bf16_t*)(lds + 88064);
    LAS float* hb = (LAS float*)(lds + 97280);
    LAS float* sm = (LAS float*)(lds + 131072);
    LAS float* bcum = sm, *igb = sm + 64, *mtv = sm + 128, *inter = sm + 192, *emt = sm + 256, *den0 = sm + 320, *dpart = sm + 384  , *nprev = sm + 512  ;
    const bf16_t* Zb = WSP(bf16_t, WS_Z) + (size_t)b * SEQ * NZ;
    const int t0 = c * 64;
    if (tid < 64) {
        const int row = b * SEQ + t0 + tid;
        const float lf = WSP(float, WS_LF)[row * 4 + hd], ig = WSP(float, WS_IG)[row * 4 + hd];
        float bc = lf;
#pragma unroll
        for (int o = 1; o < 64; o <<= 1) { const float t = __shfl_up(bc, o); if (lane >= o) bc += t; }
        const float a = ig - bc;
        float cm = a;
#pragma unroll
        for (int o = 1; o < 64; o <<= 1) { const float t = __shfl_up(cm, o); if (lane >= o) cm = fmaxf(cm, t); }
        const float mp = WSP(float, WS_MPREV)[u];
        const float mt = bc + fmaxf(mp, cm);
        bcum[tid] = bc; igb[tid] = a; mtv[tid] = mt; inter[tid] = __expf(bc + mp - mt); emt[tid] = __expf(-mt);
    } else if (tid < 192) nprev[tid - 64] = WSP(float, WS_KS)[u * 128 + tid - 64];
    __syncthreads();
    {
        const int t = tid >> 3, d0 = (tid & 7) * 16;
        float qc[16], kc[16];
        conv16(Zb, t0 + t, ZQ + hd * 128 + d0, p.conv_w + l * 4096, p.conv_b + l * 1024, hd * 128 + d0, qc);
        conv16(Zb, t0 + t, ZK + hd * 128 + d0, p.conv_w + l * 4096, p.conv_b + l * 1024, 512 + hd * 128 + d0, kc);
        float dn = 0.f;
#pragma unroll
        for (int i = 0; i < 16; ++i) dn += qc[i] * nprev[d0 + i];
        dn += __shfl_xor(dn, 1); dn += __shfl_xor(dn, 2); dn += __shfl_xor(dn, 4);
        if ((tid & 7) == 0) den0[t] = inter[t] * dn;
        u32x4 w0, w1;
        w0.x = pk2(qc[0], qc[1]); w0.y = pk2(qc[2], qc[3]); w0.z = pk2(qc[4], qc[5]); w0.w = pk2(qc[6], qc[7]);
        w1.x = pk2(qc[8], qc[9]); w1.y = pk2(qc[10], qc[11]); w1.z = pk2(qc[12], qc[13]); w1.w = pk2(qc[14], qc[15]);
        *(LAS u32x4*)(qs + t * 136 + d0) = w0; *(LAS u32x4*)(qs + t * 136 + d0 + 8) = w1;
        const float sc = 0.08838834764831845f;
        w0.x = pk2(kc[0] * sc, kc[1] * sc); w0.y = pk2(kc[2] * sc, kc[3] * sc); w0.z = pk2(kc[4] * sc, kc[5] * sc); w0.w = pk2(kc[6] * sc, kc[7] * sc);
        w1.x = pk2(kc[8] * sc, kc[9] * sc); w1.y = pk2(kc[10] * sc, kc[11] * sc); w1.z = pk2(kc[12] * sc, kc[13] * sc); w1.w = pk2(kc[14] * sc, kc[15] * sc);
        *(LAS u32x4*)(ks + t * 136 + d0) = w0; *(LAS u32x4*)(ks + t * 136 + d0 + 8) = w1;
        const bf16_t* vr = Zb + (size_t)(t0 + t) * NZ + ZV + hd * 128 + d0;
        const u32x4 a = *(const u32x4*)vr, bb = *(const u32x4*)(vr + 8);
        const unsigned w[8] = {a.x, a.y, a.z, a.w, bb.x, bb.y, bb.z, bb.w};
#pragma unroll
        for (int i = 0; i < 8; ++i) { vT[(d0 + 2 * i) * 72 + t] = (bf16_t)(w[i] & 0xffffu); vT[(d0 + 2 * i + 1) * 72 + t] = (bf16_t)(w[i] >> 16); }
        const bf16_t* KVT = WSP(bf16_t, WS_KVT) + (size_t)u * 16384;
#pragma unroll
        for (int k = 0; k < 4; ++k) { const int id = tid + 512 * k, e = id >> 4, dc = id & 15;
            *(LAS u32x4*)(CT + e * 136 + dc * 8) = *(const u32x4*)(KVT + e * 128 + dc * 8); }
    }
    __syncthreads();
    {
        const int tt = wave >> 1;
        float rs[4] = {0.f, 0.f, 0.f, 0.f};
#pragma unroll
        for (int si = 0; si < 2; ++si) {
            const int ss = (wave & 1) * 2 + si;
            f32x4 acc = (f32x4){0.f, 0.f, 0.f, 0.f};
#pragma unroll
            for (int kk = 0; kk < 4; ++kk) { const bf16x8 a = *(const LAS bf16x8*)(qs + (tt * 16 + fr) * 136 + kk * 32 + 8 * fq);
                const bf16x8 bq = *(const LAS bf16x8*)(ks + (ss * 16 + fr) * 136 + kk * 32 + 8 * fq); acc = MFMA16(a, bq, acc); }
            const int s = ss * 16 + fr; const float ib = igb[s];
#pragma unroll
            for (int i = 0; i < 4; ++i) { const int t = tt * 16 + 4 * fq + i;
                const float val = (s <= t) ? acc[i] * __expf(bcum[t] + ib - mtv[t]) : 0.f;
                rs[i] += val; Ps[t * 72 + s] = (bf16_t)f2bf(val); }
        }
#pragma unroll
        for (int i = 0; i < 4; ++i) { float r = rs[i]; r += __shfl_xor(r, 1); r += __shfl_xor(r, 2); r += __shfl_xor(r, 4); r += __shfl_xor(r, 8);
            if (fr == 0) dpart[(wave & 1) * 64 + tt * 16 + 4 * fq + i] = r; }
    }
    __syncthreads();
    {
        const int tt = wave >> 1;
        bf16x8 ap[2], aq[4];
#pragma unroll
        for (int kk = 0; kk < 2; ++kk) ap[kk] = *(const LAS bf16x8*)(Ps + (tt * 16 + fr) * 72 + kk * 32 + 8 * fq);
#pragma unroll
        for (int kk = 0; kk < 4; ++kk) aq[kk] = *(const LAS bf16x8*)(qs + (tt * 16 + fr) * 136 + kk * 32 + 8 * fq);
#pragma unroll
        for (int ei = 0; ei < 4; ++ei) {
            const int et = (wave & 1) * 4 + ei;
            f32x4 a1 = (f32x4){0.f, 0.f, 0.f, 0.f}, a2 = (f32x4){0.f, 0.f, 0.f, 0.f};
#pragma unroll
            for (int kk = 0; kk < 2; ++kk) { const bf16x8 bv = *(const LAS bf16x8*)(vT + (et * 16 + fr) * 72 + kk * 32 + 8 * fq); a1 = MFMA16(ap[kk], bv, a1); }
#pragma unroll
            for (int kk = 0; kk < 4; ++kk) { const bf16x8 bc = *(const LAS bf16x8*)(CT + (et * 16 + fr) * 136 + kk * 32 + 8 * fq); a2 = MFMA16(aq[kk], bc, a2); }
            const int e = et * 16 + fr;
#pragma unroll
            for (int i = 0; i < 4; ++i) { const int t = tt * 16 + 4 * fq + i;
                const float num = a1[i] + inter[t] * a2[i];
                const float den = den0[t] + dpart[t] + dpart[64 + t];
                const float hv = num / fmaxf(fabsf(den), emt[t]);
                const float og = bf2f(Zb[(size_t)(t0 + t) * NZ + ZO + hd * 128 + e]);
                hb[t * 132 + e] = hv * sigmoidf_(og); }
        }
    }
    __syncthreads();
    {
        const int t = tid >> 3, e0 = (tid & 7) * 16;
        float hv[16]; float ssq = 0.f;
#pragma unroll
        for (int i = 0; i < 4; ++i) { const f32x4 x4 = *(const LAS f32x4*)(hb + t * 132 + e0 + 4 * i); hv[4 * i] = x4[0]; hv[4 * i + 1] = x4[1]; hv[4 * i + 2] = x4[2]; hv[4 * i + 3] = x4[3]; }
#pragma unroll
        for (int i = 0; i < 16; ++i) ssq += hv[i] * hv[i];
        ssq += __shfl_xor(ssq, 1); ssq += __shfl_xor(ssq, 2); ssq += __shfl_xor(ssq, 4);
        const float r = 1.0f / sqrtf(ssq * (1.0f / 128.0f) + EPS);
        const float* g = p.mnorm_g + l * 512 + hd * 128 + e0;
        u32x4 w0, w1;
        w0.x = pk2(hv[0] * r * g[0], hv[1] * r * g[1]); w0.y = pk2(hv[2] * r * g[2], hv[3] * r * g[3]); w0.z = pk2(hv[4] * r * g[4], hv[5] * r * g[5]); w0.w = pk2(hv[6] * r * g[6], hv[7] * r * g[7]);
        w1.x = pk2(hv[8] * r * g[8], hv[9] * r * g[9]); w1.y = pk2(hv[10] * r * g[10], hv[11] * r * g[11]); w1.z = pk2(hv[12] * r * g[12], hv[13] * r * g[13]); w1.w = pk2(hv[14] * r * g[14], hv[15] * r * g[15]);
        bf16_t* o = WSP(bf16_t, WS_CAT) + (size_t)(b * SEQ + t0 + t) * D + hd * 128 + e0;
        *(u32x4*)o = w0; *(u32x4*)(o + 8) = w1;
    }
    __syncthreads();
}

__device__ __forceinline__ void moba_prep_unit(const Params& p, int u, LAS unsigned char* lds) {
    const int tid = otid(), lane = tid & 63, wave = tid >> 6;
    const int qtr = u & 3, blk = (u >> 2) & 31, b = u >> 7;
    LAS float* cs = (LAS float*)lds; LAS float* sn = cs + 512;
    const int r0 = b * SEQ + blk * 256 + qtr * 64;
    { const int t = tid >> 3, i = tid & 7;
      const float inv = powf(500000.0f, -(float)(2 * i) / 16.0f);
      const float ang = (float)p.pos[r0 + t] * inv; float s, c; sincosf(ang, &s, &c); cs[tid] = c; sn[tid] = s; }
    __syncthreads();
    bf16_t* Z = WSP(bf16_t, WS_Z);
    const int h = wave, d = lane;
    float ksum = 0.f;
    for (int tb = 0; tb < 64; tb += 32) {
        unsigned short qv[32], kv[32];
#pragma unroll
        for (int i = 0; i < 32; ++i) { const size_t ro = (size_t)(r0 + tb + i) * NZ + h * 64 + d; qv[i] = Z[ro + ZAQ]; kv[i] = Z[ro + ZAK]; }
#pragma unroll
        for (int i = 0; i < 32; ++i) {
            float q = bf2f(qv[i]), k = bf2f(kv[i]);
            const float qp = __shfl_xor(q, 8), kp = __shfl_xor(k, 8);
            if (d < 16) {
                const float c = cs[(tb + i) * 8 + (d & 7)], s = sn[(tb + i) * 8 + (d & 7)];
                q = (d < 8) ? (q * c - qp * s) : (q * c + qp * s);
                k = (d < 8) ? (k * c - kp * s) : (k * c + kp * s);
                const unsigned qb = f2bf(q), kb = f2bf(k);
                const size_t ro = (size_t)(r0 + tb + i) * NZ + h * 64 + d;
                Z[ro + ZAQ] = (bf16_t)qb; Z[ro + ZAK] = (bf16_t)kb;
                k = bf2f(kb);
            }
            ksum += k;
        }
    }
    WSP(float, WS_KPART)[((((size_t)(b * 8 + h) * 32 + blk) * 4 + qtr) * 64) + d] = ksum;
    __syncthreads();
}
__device__ __forceinline__ void moba_gate_unit(const Params& p, int l, int u, LAS unsigned char* lds) {
    const int tid = otid();
    const int tq = u & 15, h = (u >> 4) & 7, b = u >> 7;
    LAS float* km = (LAS float*)lds;
    const float* KP = WSP(float, WS_KPART) + (size_t)(b * 8 + h) * 32 * 4 * 64;
    for (int i = tid; i < 2048; i += 512) { const int j = i >> 6, d = i & 63; const float* s = KP + (size_t)j * 256 + d;
        km[i] = (s[0] + s[64] + s[128] + s[192]) * (1.0f / 256.0f); }
    __syncthreads();
    const int t = tq * 512 + tid, own = t >> 8;
    const bf16_t* qr = WSP(bf16_t, WS_Z) + (size_t)(b * SEQ + t) * NZ + ZAQ + h * 64;
    float q[64];
#pragma unroll
    for (int k = 0; k < 8; ++k) { const u32x4 w = *(const u32x4*)(qr + 8 * k);
        q[8 * k] = bflo(w.x); q[8 * k + 1] = bfhi(w.x); q[8 * k + 2] = bflo(w.y); q[8 * k + 3] = bfhi(w.y); q[8 * k + 4] = bflo(w.z); q[8 * k + 5] = bfhi(w.z); q[8 * k + 6] = bflo(w.w); q[8 * k + 7] = bfhi(w.w); }
    float v0 = -INFINITY, v1 = -INFINITY, v2 = -INFINITY; int i0 = -1, i1 = -1, i2 = -1;
    for (int j = 0; j < own; ++j) {
        float s = 0.f;
#pragma unroll
        for (int d4 = 0; d4 < 16; ++d4) { const f32x4 kk = *(const LAS f32x4*)(km + j * 64 + 4 * d4); s += q[4 * d4] * kk[0] + q[4 * d4 + 1] * kk[1] + q[4 * d4 + 2] * kk[2] + q[4 * d4 + 3] * kk[3]; }
        if (s > v0) { v2 = v1; i2 = i1; v1 = v0; i1 = i0; v0 = s; i0 = j; }
        else if (s > v1) { v2 = v1; i2 = i1; v1 = s; i1 = j; }
        else if (s > v2) { v2 = s; i2 = j; }
    }
    unsigned* QLEN = WSP(unsigned, WS_CTL) + CW_QLEN + l * 1024 + (b * 8 + h) * 32;
    bf16_t* QL = WSP(bf16_t, WS_QLIST) + (size_t)(b * 8 + h) * 32 * 8192;
    const int sel[4] = {i0, i1, i2, own};
#pragma unroll
    for (int s = 0; s < 4; ++s) { const int j = sel[s];
        if (j >= 0) { const unsigned pos = atomicAdd(&QLEN[j], 1u); QL[(size_t)j * 8192 + pos] = (bf16_t)((t << 2) | s); } }
    __syncthreads();
}
__device__ __forceinline__ void moba_attn_unit(const Params& p, int l, int li, int ch, LAS unsigned char* lds) {
    const int tid = otid(), lane = tid & 63, wave = tid >> 6, fr = lane & 15, fq = lane >> 4;
    const int j = li & 31, h = (li >> 5) & 7, b = li >> 8;
    LAS bf16_t* Ks = (LAS bf16_t*)lds;
    LAS bf16_t* VT = (LAS bf16_t*)(lds + 36864);
    LAS bf16_t* Pw = (LAS bf16_t*)(lds + 36864 + 33792 + wave * 8448);
    const bf16_t* Z = WSP(bf16_t, WS_Z);
    const int n = (int)(WSP(unsigned, WS_CTL)[CW_QLEN + l * 1024 + li]);
    const bf16_t* QL = WSP(bf16_t, WS_QLIST) + (size_t)li * 8192;
    const size_t kr0 = (size_t)(b * SEQ + j * 256);
#pragma unroll
    for (int i = 0; i < 4; ++i) { const int id = tid + 512 * i, key = id >> 3, part = id & 7;
        const bf16_t* src = Z + (kr0 + key) * NZ + h * 64 + part * 8;
        *(LAS u32x4*)(Ks + key * 72 + part * 8) = *(const u32x4*)(src + ZAK);
        const u32x4 vv = *(const u32x4*)(src + ZAV);
        const unsigned w[4] = {vv.x, vv.y, vv.z, vv.w};
#pragma unroll
        for (int k = 0; k < 4; ++k) { VT[(part * 8 + 2 * k) * 264 + key] = (bf16_t)(w[k] & 0xffffu); VT[(part * 8 + 2 * k + 1) * 264 + key] = (bf16_t)(w[k] >> 16); } }
    __syncthreads();
    bf16_t* PO = WSP(bf16_t, WS_PARTO); float* PL = WSP(float, WS_PARTL);
    for (int tile = 0; tile < 4; ++tile) {
        const int rbase = ch * 512 + tile * 128;
        if (rbase >= n) break;
        const int ridx = rbase + wave * 16 + fr;
        const unsigned ent = (ridx < n) ? (unsigned)QL[ridx] : 0u;
        const int tA = (int)(ent >> 2);
        const bf16_t* qp = Z + (size_t)(b * SEQ + tA) * NZ + ZAQ + h * 64 + 8 * fq;
        bf16x8 qa[2]; qa[0] = *(const bf16x8*)qp; qa[1] = *(const bf16x8*)(qp + 32);
        int tq[4]; unsigned eq[4];
#pragma unroll
        for (int i = 0; i < 4; ++i) { eq[i] = (unsigned)__shfl((int)ent, 4 * fq + i); tq[i] = (int)(eq[i] >> 2); }
        f32x4 s[16];
        float mx[4] = {-INFINITY, -INFINITY, -INFINITY, -INFINITY};
#pragma unroll
        for (int ct = 0; ct < 16; ++ct) {
            f32x4 acc = (f32x4){0.f, 0.f, 0.f, 0.f};
#pragma unroll
            for (int kk = 0; kk < 2; ++kk) { const bf16x8 bk = *(const LAS bf16x8*)(Ks + (ct * 16 + fr) * 72 + kk * 32 + 8 * fq); acc = MFMA16(qa[kk], bk, acc); }
            const int kpos = j * 256 + ct * 16 + fr;
#pragma unroll
            for (int i = 0; i < 4; ++i) { const float v = (kpos <= tq[i]) ? acc[i] * 0.125f : -INFINITY; acc[i] = v; mx[i] = fmaxf(mx[i], v); }
            s[ct] = acc;
        }
        float ls[4];
#pragma unroll
        for (int i = 0; i < 4; ++i) { float m = mx[i]; m = fmaxf(m, __shfl_xor(m, 1)); m = fmaxf(m, __shfl_xor(m, 2)); m = fmaxf(m, __shfl_xor(m, 4)); m = fmaxf(m, __shfl_xor(m, 8)); mx[i] = m; ls[i] = 0.f; }
#pragma unroll
        for (int ct = 0; ct < 16; ++ct)
#pragma unroll
            for (int i = 0; i < 4; ++i) { const float pv = __expf(s[ct][i] - mx[i]); ls[i] += pv; Pw[(4 * fq + i) * 264 + ct * 16 + fr] = (bf16_t)f2bf(pv); }
#pragma unroll
        for (int i = 0; i < 4; ++i) { float r = ls[i]; r += __shfl_xor(r, 1); r += __shfl_xor(r, 2); r += __shfl_xor(r, 4); r += __shfl_xor(r, 8); ls[i] = r; }
        LDS_WAIT();
        f32x4 o[4];
#pragma unroll
        for (int dt = 0; dt < 4; ++dt) o[dt] = (f32x4){0.f, 0.f, 0.f, 0.f};
#pragma unroll
        for (int kk = 0; kk < 8; ++kk) { const bf16x8 a = *(const LAS bf16x8*)(Pw + fr * 264 + kk * 32 + 8 * fq);
#pragma unroll
            for (int dt = 0; dt < 4; ++dt) { const bf16x8 bv = *(const LAS bf16x8*)(VT + (dt * 16 + fr) * 264 + kk * 32 + 8 * fq); o[dt] = MFMA16(a, bv, o[dt]); } }
#pragma unroll
        for (int i = 0; i < 4; ++i) {
            const int rr = rbase + wave * 16 + 4 * fq + i;
            if (rr < n) {
                const size_t pi = ((size_t)(b * 8 + h) * SEQ + tq[i]) * 4 + (eq[i] & 3u);
                const float inv = 1.0f / ls[i];
#pragma unroll
                for (int dt = 0; dt < 4; ++dt) PO[pi * 64 + dt * 16 + fr] = (bf16_t)f2bf(o[dt][i] * inv);
                if (fr == 0) PL[pi] = mx[i] + __logf(ls[i]);
            }
        }
        LDS_WAIT();
    }
    __syncthreads();
}
__device__ __forceinline__ void moba_combine_phase(const Params& p) {
    const int tid = otid(), lane = tid & 63, wave = tid >> 6;
    const int gw = blockIdx.x * 8 + wave, NGW = gridDim.x * 8;
    const bf16_t* PO = WSP(bf16_t, WS_PARTO); const float* PL = WSP(float, WS_PARTL);
    bf16_t* CAT = WSP(bf16_t, WS_CAT);
    const int h = lane >> 3, part = lane & 7;
    for (int row = gw; row < T; row += NGW) {
        const int b = row >> 13, t = row & 8191, own = t >> 8, nsel = own < 3 ? own : 3;
        const size_t pi = ((size_t)(b * 8 + h) * SEQ + t) * 4;
        float lse[4]; float M = -INFINITY;
#pragma unroll
        for (int s = 0; s < 4; ++s) { const bool ok = (s == 3) || (s < nsel); lse[s] = ok ? PL[pi + s] : -INFINITY; M = fmaxf(M, lse[s]); }
        float acc[8]; float wsum = 0.f;
#pragma unroll
        for (int i = 0; i < 8; ++i) acc[i] = 0.f;
#pragma unroll
        for (int s = 0; s < 4; ++s) { const bool ok = (s == 3) || (s < nsel);
            if (ok) { const float w = __expf(lse[s] - M); wsum += w;
                const u32x4 v = *(const u32x4*)(PO + (pi + s) * 64 + part * 8);
                acc[0] += w * bflo(v.x); acc[1] += w * bfhi(v.x); acc[2] += w * bflo(v.y); acc[3] += w * bfhi(v.y);
                acc[4] += w * bflo(v.z); acc[5] += w * bfhi(v.z); acc[6] += w * bflo(v.w); acc[7] += w * bfhi(v.w); } }
        const float inv = 1.0f / wsum;
        u32x4 o; o.x = pk2(acc[0] * inv, acc[1] * inv); o.y = pk2(acc[2] * inv, acc[3] * inv); o.z = pk2(acc[4] * inv, acc[5] * inv); o.w = pk2(acc[6] * inv, acc[7] * inv);
        *(u32x4*)(CAT + (size_t)row * D + 512 + h * 64 + part * 8) = o;
    }
}

__device__ __forceinline__ void mix_a_phase(const Params& p, int l, LAS unsigned char* lds) {
    for (int u = blockIdx.x; u < 2048 + 512; u += gridDim.x) {
        if (u < 2048) mlstm_a_unit(p, l, u, lds); else moba_prep_unit(p, u - 2048, lds);
    }
}
__device__ __forceinline__ void mix_b_phase(const Params& p, int l, LAS unsigned char* lds) {
    for (int u = blockIdx.x; u < 256 + 512; u += gridDim.x) {
        if (u < 256) mlstm_b_unit(p, u); else moba_gate_unit(p, l, u - 256, lds);
    }
}
__device__ __forceinline__ void mix_c_phase(const Params& p, int l, LAS unsigned char* lds) {
    const int tid = otid(), lane = tid & 63, wave = tid >> 6;
    LAS int* pre = (LAS int*)(lds + 139264);
    LAS int* wt = pre + 1032;
    {
        const unsigned* QLEN = WSP(unsigned, WS_CTL) + CW_QLEN + l * 1024;
        const int a0 = ((int)QLEN[2 * tid] + 511) >> 9, a1 = ((int)QLEN[2 * tid + 1] + 511) >> 9;
        const int s = a0 + a1; int inc = s;
#pragma unroll
        for (int o = 1; o < 64; o <<= 1) { const int t = __shfl_up(inc, o); if (lane >= o) inc += t; }
        if (lane == 63) wt[wave] = inc;
        __syncthreads();
        int wp = 0;
        for (int w = 0; w < wave; ++w) wp += wt[w];
        const int ex = wp + inc - s;
        pre[2 * tid] = ex; pre[2 * tid + 1] = ex + a0;
        if (tid == 511) pre[1024] = ex + s;
        __syncthreads();
    }
    const int NU = pre[1024];
    for (int u = blockIdx.x; u < 2048 + NU; u += gridDim.x) {
        if (u < 2048) mlstm_c_unit(p, l, u, lds);
        else {
            const int a = u - 2048;
            int lo = 0, hi = 1024;
            while (hi - lo > 1) { const int mid = (lo + hi) >> 1; if (pre[mid] <= a) lo = mid; else hi = mid; }
            moba_attn_unit(p, l, lo, a - pre[lo], lds);
        }
    }
}

__device__ __forceinline__ void router_phase(const Params& p, int l, LAS unsigned char* lds) {
    const int tid = otid(), lane = tid & 63, wave = tid >> 6;
    LAS float* Wr = (LAS float*)lds;
    LAS int* lcnt = (LAS int*)(lds + 131072);
    LAS int* lbase = lcnt + 32;
    LAS unsigned* lsel = (LAS unsigned*)(lcnt + 64);
    const float* wr = p.w_router + (size_t)l * 1024 * 32;
    for (int i = tid; i < 32768; i += 512) Wr[i] = wr[i];
    if (tid < 32) lcnt[tid] = 0;
    __syncthreads();
    const int G = gridDim.x, rows_per = (T + G - 1) / G;
    const int r_lo = blockIdx.x * rows_per, r_hi = (r_lo + rows_per < T) ? r_lo + rows_per : T;
    const float* MOD = WSP(float, WS_MOD);
    const float* X = WSP(float, WS_X); bf16_t* H = WSP(bf16_t, WS_H);
    float* PROB = WSP(float, WS_PROB);
    for (int row = r_lo + wave; row < r_hi; row += 8) {
        const int b = row >> 13;
        f32x4 v[4]; float ss = 0.f;
#pragma unroll
        for (int j = 0; j < 4; ++j) { v[j] = *(const f32x4*)(X + (size_t)row * D + 4 * lane + 256 * j); ss += (v[j][0] * v[j][0] + v[j][1] * v[j][1]) + (v[j][2] * v[j][2] + v[j][3] * v[j][3]); }
        const float rstd = 1.0f / sqrtf(wave_sum(ss) * (1.0f / D) + EPS);
        const float* mb = MOD + (size_t)(l * 4 + b) * 6144;
        float lg[32];
#pragma unroll
        for (int e = 0; e < 32; ++e) lg[e] = 0.f;
#pragma unroll
        for (int j = 0; j < 4; ++j) {
            const int n = 4 * lane + 256 * j;
            const f32x4 g = *(const f32x4*)(p.norm2_g + l * D + n), sh = *(const f32x4*)(mb + 3072 + n), sc = *(const f32x4*)(mb + 4096 + n);
            const f32x4 h = v[j] * rstd * g * (sc + 1.0f) + sh;
            u32x2 w; w.x = pk2(h[0], h[1]); w.y = pk2(h[2], h[3]);
            *(u32x2*)(H + (size_t)row * D + n) = w;
#pragma unroll
            for (int i = 0; i < 4; ++i)
#pragma unroll
                for (int e4 = 0; e4 < 8; ++e4) { const f32x4 ww = *(const LAS f32x4*)(Wr + (n + i) * 32 + 4 * e4);
                    lg[4 * e4] += h[i] * ww[0]; lg[4 * e4 + 1] += h[i] * ww[1]; lg[4 * e4 + 2] += h[i] * ww[2]; lg[4 * e4 + 3] += h[i] * ww[3]; }
        }
#pragma unroll
        for (int i = 0; i < 16; ++i) { const bool hi = (lane & 32) != 0; const float send = hi ? lg[i] : lg[i + 16]; const float keep = hi ? lg[i + 16] : lg[i]; lg[i] = keep + __shfl_xor(send, 32); }
#pragma unroll
        for (int i = 0; i < 8; ++i) { const bool hi = (lane & 16) != 0; const float send = hi ? lg[i] : lg[i + 8]; const float keep = hi ? lg[i + 8] : lg[i]; lg[i] = keep + __shfl_xor(send, 16); }
#pragma unroll
        for (int i = 0; i < 4; ++i) { const bool hi = (lane & 8) != 0; const float send = hi ? lg[i] : lg[i + 4]; const float keep = hi ? lg[i + 4] : lg[i]; lg[i] = keep + __shfl_xor(send, 8); }
#pragma unroll
        for (int i = 0; i < 2; ++i) { const bool hi = (lane & 4) != 0; const float send = hi ? lg[i] : lg[i + 2]; const float keep = hi ? lg[i + 2] : lg[i]; lg[i] = keep + __shfl_xor(send, 4); }
        { const bool hi = (lane & 2) != 0; const float send = hi ? lg[0] : lg[1]; const float keep = hi ? lg[1] : lg[0]; lg[0] = keep + __shfl_xor(send, 2); }
        float mine = lg[0] + __shfl_xor(lg[0], 1);
        const int ex = ((lane >> 5) & 1) * 16 + ((lane >> 4) & 1) * 8 + ((lane >> 3) & 1) * 4 + ((lane >> 2) & 1) * 2 + ((lane >> 1) & 1);
        mine += p.b_router[l * 32 + ex];
        float tv[4]; int te[4];
        float cur = mine;
#pragma unroll
        for (int k = 0; k < 4; ++k) {
            float m = cur;
#pragma unroll
            for (int o = 1; o < 64; o <<= 1) m = fmaxf(m, __shfl_xor(m, o));
            const unsigned long long bal = __ballot(cur == m);
            int best = 64;
            { int cand = (cur == m) ? ex : 64;
#pragma unroll
              for (int o = 1; o < 64; o <<= 1) { const int t = __shfl_xor(cand, o); cand = t < cand ? t : cand; }
              best = cand; }
            (void)bal;
            tv[k] = m; te[k] = best;
            if (ex == best) cur = -INFINITY;
        }
        const float e1 = __expf(tv[1] - tv[0]), e2 = __expf(tv[2] - tv[0]), e3 = __expf(tv[3] - tv[0]);
        const float inv = 1.0f / (1.0f + e1 + e2 + e3);
        if (lane < 4) {
            const float pr = (lane == 0 ? 1.0f : lane == 1 ? e1 : lane == 2 ? e2 : e3) * inv;
            const int e = lane == 0 ? te[0] : lane == 1 ? te[1] : lane == 2 ? te[2] : te[3];
            PROB[row * 4 + lane] = pr;
            const int rl = atomicAdd((int*)&lcnt[e], 1);
            lsel[(row - r_lo) * 4 + lane] = (unsigned)e | ((unsigned)rl << 8);
        }
    }
    __syncthreads();
    unsigned* ECNT = WSP(unsigned, WS_CTL) + CW_ECNT + l * 64;
    if (tid < 32) lbase[tid] = (int)atomicAdd(&ECNT[tid], (unsigned)lcnt[tid]);
    __syncthreads();
    unsigned* PE = WSP(unsigned, WS_PE); int* EL = WSP(int, WS_ELIST);
    for (int i = tid; i < (r_hi - r_lo) * 4; i += 512) {
        const unsigned s = lsel[i]; const int e = s & 255u, rank = lbase[e] + (int)(s >> 8);
        const int row = r_lo + (i >> 2);
        PE[row * 4 + (i & 3)] = (unsigned)e | ((unsigned)rank << 8);
        EL[e * 32768 + rank] = row;
    }
    __syncthreads();
}

#define HAS(k) ((MASK >> (k)) & 1u)
template <unsigned MASK>
__global__ void __launch_bounds__(512, 2) fwd_kernel(Params p_unused) {
    extern __shared__ __attribute__((aligned(16))) unsigned char lds_raw[];
    LAS unsigned char* lds = (LAS unsigned char*)lds_raw;
    volatile LAS unsigned* xbw = (volatile LAS unsigned*)(lds + LDS_BYTES - 16);
    int lo, hi; unsigned* barw;
    { const Params p = LOADP(); lo = p.ph_lo; hi = p.ph_hi; barw = WSP(unsigned, WS_CTL) + CW_BAR; }
    const int G = gridDim.x;
    XcdBarrier bar; bar.bar = barw; bar.x = 0; bar.st = xbw;
    if (MASK == 0xFFFu) {
        if (threadIdx.x == 0) { xbw[0] = 0u; xbw[1] = 0u; }
        __syncthreads();
        bar = xcd_barrier_post(barw, xbw);
    }
#define IN(k) (lo <= (k) && (k) < hi)
#define SEAM(k) do { if (MASK == 0xFFFu) { if (IN(k) && IN((k) + 1)) xcd_barrier(bar); } } while (0)

    if constexpr (HAS(0)) { if (IN(0)) { const Params p = LOADP(); prologue_phase(p, lds); __syncthreads(); } }
    SEAM(0);
    for (int l = 0; l < 2; ++l) {
        const int pb = 1 + 10 * l;
        if constexpr (HAS(1)) { if (IN(pb + 0)) {
            const Params p = LOADP();
            if (l == 0) norm_phase<0>(p, 0, lds);
            else { norm_phase<1>(p, 1, lds); __syncthreads(); convert_moe(p, 1, lds); }
            __syncthreads();
        } }
        SEAM(pb + 0);
        if constexpr (HAS(2)) { if (IN(pb + 1)) {
            const Params p = LOADP();
            pg8::StaticOrder S; S.init(T, NZ, G, (int)blockIdx.x);
            pg8::EpiZ E{WSP(bf16_t, WS_Z), NZ};
            pg8::gemm_phase(lds, WSP(bf16_t, WS_H), WSP(bf16_t, WS_WIN) + (size_t)l * NZ * 1024, 1024, S, E);
        } }
        SEAM(pb + 1);
        if constexpr (HAS(3)) { if (IN(pb + 2)) { const Params p = LOADP(); mix_a_phase(p, l, lds); } }
        SEAM(pb + 2);
        if constexpr (HAS(4)) { if (IN(pb + 3)) { const Params p = LOADP(); mix_b_phase(p, l, lds); } }
        SEAM(pb + 3);
        if constexpr (HAS(5)) { if (IN(pb + 4)) { const Params p = LOADP(); mix_c_phase(p, l, lds); } }
        SEAM(pb + 4);
        if constexpr (HAS(6)) { if (IN(pb + 5)) { const Params p = LOADP(); moba_combine_phase(p); } }
        SEAM(pb + 5);
        if constexpr (HAS(7)) { if (IN(pb + 6)) {
            const Params p = LOADP();
            pg8::StaticOrder S; S.init(T, D, G, (int)blockIdx.x);
            pg8::EpiRes E{l == 0 ? p.x : WSP(float, WS_X), WSP(float, WS_X), WSP(float, WS_MOD) + (size_t)l * 4 * 6144 + 2048};
            pg8::gemm_phase(lds, WSP(bf16_t, WS_CAT), WSP(bf16_t, WS_WOUT) + (size_t)l * 1024 * 1024, 1024, S, E);
        } }
        SEAM(pb + 6);
        if constexpr (HAS(8)) { if (IN(pb + 7)) { const Params p = LOADP(); router_phase(p, l, lds); } }
        SEAM(pb + 7);
        if constexpr (HAS(9)) { if (IN(pb + 8)) {
            const Params p = LOADP();
            LAS int* tb = (LAS int*)(lds + 131072); LAS int* cnt = tb + 40;
            moe_tile_prefix(p, l, tb, cnt);
            __syncthreads();
            pg8::MoeOrder S{tb, cnt, WSP(int, WS_ELIST), 8, G, (int)blockIdx.x, 1};
            pg8::EpiSwiglu E{WSP(bf16_t, WS_ACT), p.b_gate + (size_t)l * 32 * 1024, p.b_up + (size_t)l * 32 * 1024};
            pg8::gemm_phase(lds, WSP(bf16_t, WS_H), WSP(bf16_t, WS_WGU), 1024, S, E);
            __syncthreads();
        } }
        SEAM(pb + 8);
        if constexpr (HAS(10)) { if (IN(pb + 9)) {
            const Params p = LOADP();
            LAS int* tb = (LAS int*)(lds + 131072); LAS int* cnt = tb + 40;
            moe_tile_prefix(p, l, tb, cnt);
            __syncthreads();
            pg8::MoeOrder S{tb, cnt, WSP(int, WS_ELIST), 4, G, (int)blockIdx.x, 0};
            pg8::EpiDown E{WSP(bf16_t, WS_YB), p.b_down + (size_t)l * 32 * 1024};
            pg8::gemm_phase(lds, WSP(bf16_t, WS_ACT), WSP(bf16_t, WS_WD), 1024, S, E);
            __syncthreads();
        } }
        SEAM(pb + 9);
    }
    if constexpr (HAS(11)) { if (IN(21)) { const Params p = LOADP(); norm_phase<2>(p, 1, lds); } }
}

#if !MK_ONE_LAUNCH
typedef void (*kern_t)(Params);
static kern_t kern_of_type(int ty) {
    switch (ty) {
        case 0: return fwd_kernel<1u << 0>; case 1: return fwd_kernel<1u << 1>; case 2: return fwd_kernel<1u << 2>; case 3: return fwd_kernel<1u << 3>;
        case 4: return fwd_kernel<1u << 4>; case 5: return fwd_kernel<1u << 5>; case 6: return fwd_kernel<1u << 6>; case 7: return fwd_kernel<1u << 7>;
        case 8: return fwd_kernel<1u << 8>; case 9: return fwd_kernel<1u << 9>; case 10: return fwd_kernel<1u << 10>; default: return fwd_kernel<1u << 11>;
    }
}
static int type_of_phase(int ph) { if (ph == 0) return 0; if (ph == 21) return 11; return 1 + (ph - 1) % 10; }
#endif

extern "C" void kernel_launch(void* const* d_in, const int* in_sizes, int n_in, void* d_out, int out_size, void* d_ws, size_t ws_size, hipStream_t stream) {
    static int grid = 0;
    if (grid == 0) {
        if (n_in != 23 || in_sizes[0] != T * D || out_size != T * D || ws_size < WS_END) {
            fprintf(stderr, "kernel_launch: unexpected shapes (n_in %d, in0 %d, out %d, ws %zu, need %zu)\n", n_in, n_in > 0 ? in_sizes[0] : -1, out_size, ws_size, (size_t)WS_END); grid = -1; return; }
        int dev = 0, cus = 0;
        if (hipGetDevice(&dev) != hipSuccess || hipDeviceGetAttribute(&cus, hipDeviceAttributeMultiprocessorCount, dev) != hipSuccess) { grid = -1; return; }
#if MK_ONE_LAUNCH
        if (hipFuncSetAttribute((const void*)fwd_kernel<0xFFFu>, hipFuncAttributeMaxDynamicSharedMemorySize, LDS_BYTES) != hipSuccess) { fprintf(stderr, "kernel_launch: hipFuncSetAttribute failed\n"); grid = -1; return; }
#else
        for (int ty = 0; ty < 12; ++ty)
            if (hipFuncSetAttribute((const void*)kern_of_type(ty), hipFuncAttributeMaxDynamicSharedMemorySize, LDS_BYTES) != hipSuccess) { fprintf(stderr, "kernel_launch: hipFuncSetAttribute failed\n"); grid = -1; return; }
#endif
        (void)hipGetLastError();
        grid = cus;
    }
    if (grid < 0) return;
    (void)hipMemsetAsync((char*)d_ws + WS_CTL, 0, CTL_BYTES, stream);
    Params p{};
    p.x = (const float*)d_in[0]; p.c = (const float*)d_in[1]; p.pos = (const int*)d_in[2];
    p.w_ada = (const float*)d_in[3]; p.b_ada = (const float*)d_in[4]; p.norm1_g = (const float*)d_in[5]; p.w_in = (const float*)d_in[6];
    p.conv_w = (const float*)d_in[7]; p.conv_b = (const float*)d_in[8]; p.b_ig = (const float*)d_in[9]; p.b_fg = (const float*)d_in[10];
    p.mnorm_g = (const float*)d_in[11]; p.w_out = (const float*)d_in[12]; p.norm2_g = (const float*)d_in[13]; p.w_router = (const float*)d_in[14];
    p.b_router = (const float*)d_in[15]; p.w_gate = (const float*)d_in[16]; p.b_gate = (const float*)d_in[17]; p.w_up = (const float*)d_in[18];
    p.b_up = (const float*)d_in[19]; p.w_down = (const float*)d_in[20]; p.b_down = (const float*)d_in[21]; p.fnorm_g = (const float*)d_in[22];
    p.out = (float*)d_out; p.ws = (unsigned char*)d_ws;
#if MK_ONE_LAUNCH
    p.ph_lo = 0; p.ph_hi = NPH;
    hipLaunchKernelGGL(fwd_kernel<0xFFFu>, dim3(grid), dim3(512), LDS_BYTES, stream, p);
#else
    for (int ph = 0; ph < NPH; ++ph) { p.ph_lo = ph; p.ph_hi = ph + 1; hipLaunchKernelGGL(kern_of_type(type_of_phase(ph)), dim3(grid), dim3(512), LDS_BYTES, stream, p); }
#endif
}
```

```cpp
#include <hip/hip_runtime.h>
#include <cstdio>
#include <cstdint>

#ifndef MK_ONE_LAUNCH
#define MK_ONE_LAUNCH 1
#endif

#ifndef PROBE_DUP
#define PROBE_DUP 0u
#endif
#define REP(k) for (int _r = 0; _r < (((PROBE_DUP >> (k)) & 1u) ? 2 : 1); ++_r)
#define LAS __attribute__((address_space(3)))
typedef unsigned short bf16_t;
typedef short bf16x8 __attribute__((ext_vector_type(8)));
typedef float f32x4 __attribute__((ext_vector_type(4)));
typedef unsigned u32x4 __attribute__((ext_vector_type(4)));
typedef unsigned u32x2 __attribute__((ext_vector_type(2)));
typedef short s16x4 __attribute__((ext_vector_type(4)));
typedef float f32x16 __attribute__((ext_vector_type(16)));
#define MFMA32(a, b, c) __builtin_amdgcn_mfma_f32_32x32x16_bf16((a), (b), (c), 0, 0, 0)
#define TRREAD(ptr) __builtin_amdgcn_ds_read_tr16_b64_v4i16((LAS s16x4*)(ptr))

constexpr int D = 1024, NB = 4, SEQ = 8192, T = NB * SEQ;
constexpr int NIN = 3592, NZ = 3584;
constexpr int ZQ = 0, ZK = 512, ZV = 1024, ZO = 1536, ZAQ = 2048, ZAK = 2560, ZAV = 3072;
constexpr int NE = 32;
constexpr int MAXT = 544;
constexpr float EPS = 1e-5f;
constexpr int NPH = 22;

constexpr size_t MiB = 1u << 20;
constexpr size_t WS_CTL = 0, CTL_BYTES = 1 * MiB;
constexpr size_t WS_MOD = 1 * MiB;
constexpr size_t WS_IG = 2 * MiB, WS_LF = 2 * MiB + 512 * 1024;
constexpr size_t WS_KPART = 3 * MiB;
constexpr size_t WS_G = 4 * MiB, WS_WMAX = 4 * MiB + 8192, WS_MPREV = 4 * MiB + 16384;
constexpr size_t WS_KS = 5 * MiB;
constexpr size_t WS_PE = 6 * MiB, WS_PROB = 6 * MiB + 512 * 1024;
constexpr size_t WS_ELIST = 7 * MiB;
constexpr size_t WS_PARTL = 11 * MiB;
constexpr size_t WS_SEGC = 15 * MiB;
constexpr size_t WS_WIN = 16 * MiB, WS_WOUT = 30 * MiB;
constexpr size_t WS_WGU = 36 * MiB, WS_WD = 164 * MiB;
constexpr size_t WS_X = 228 * MiB, WS_H = 356 * MiB, WS_POOL = 420 * MiB;
constexpr size_t WS_KC = WS_H + 32 * MiB;
constexpr size_t WS_Z = WS_POOL, WS_CAT = WS_POOL + 224 * MiB, WS_PARTO = WS_POOL + 288 * MiB, WS_KVT = WS_POOL + 416 * MiB, WS_QLIST = WS_POOL + 480 * MiB;
constexpr size_t WS_ACT = WS_POOL, WS_YB = WS_POOL + 272 * MiB;
constexpr size_t WS_END = WS_POOL + 544 * MiB;
constexpr int CW_BAR = 1024;
constexpr int CW_ECNT = 8192;
constexpr int CW_GQ = 13440;
constexpr int CW_CVT = 13312;
constexpr int CW_WQ = 12288;
constexpr int CW_QLEN = 16384;

constexpr int LDS_BYTES = 147456;

__device__ __forceinline__ unsigned f2bf(float f) { unsigned u = __builtin_bit_cast(unsigned, f); return (u + 0x7fffu + ((u >> 16) & 1u)) >> 16; }
typedef float f32x2_ __attribute__((ext_vector_type(2)));
typedef __bf16 bf16x2_ __attribute__((ext_vector_type(2)));
__device__ __forceinline__ unsigned pk2(float lo, float hi) { const f32x2_ v = {lo, hi}; return __builtin_bit_cast(unsigned, __builtin_convertvector(v, bf16x2_)); }
__device__ __forceinline__ float bf2f(unsigned b) { return __builtin_bit_cast(float, (b & 0xffffu) << 16); }
__device__ __forceinline__ float bflo(unsigned w) { return __builtin_bit_cast(float, w << 16); }
__device__ __forceinline__ float bfhi(unsigned w) { return __builtin_bit_cast(float, w & 0xffff0000u); }
__device__ __forceinline__ unsigned pk4_fp8(float a, float b, float c, float d) {
    int v = __builtin_amdgcn_cvt_pk_fp8_f32(a, b, 0, false);
    v = __builtin_amdgcn_cvt_pk_fp8_f32(c, d, v, true);
    return (unsigned)v;
}
typedef int i32x8 __attribute__((ext_vector_type(8)));
typedef int i32x4 __attribute__((ext_vector_type(4)));
__device__ __forceinline__ float wave_sum(float v) {
#pragma unroll
    for (int o = 1; o < 64; o <<= 1) v += __shfl_xor(v, o);
    return v;
}
__device__ __forceinline__ float sigmoidf_(float x) { return __builtin_amdgcn_rcpf(1.0f + __expf(-x)); }
#define LDS_WAIT() asm volatile("s_waitcnt lgkmcnt(0)" ::: "memory")
__device__ __forceinline__ void lds_barrier() { asm volatile("s_waitcnt lgkmcnt(0)\n\ts_barrier" ::: "memory"); }
__device__ __forceinline__ int otid() { int t = threadIdx.x; asm volatile("" : "+v"(t)); return t; }

#define XB_TMO      128
#define XB_XCNT(j)  (256  + 64 * (j))
#define XB_XSUB(j)  (1280 + 64 * (j))
#define XB_XGEN(j)  (2304 + 64 * (j))
#define XB_TOP      3328
#define XB_TOPGEN   3392
#define XCD_BAR_WORDS 3456
#define XB_SPIN_CAP (1u << 18)
__device__ __forceinline__ unsigned xb_ld(unsigned* p)              { return __hip_atomic_load(p, __ATOMIC_RELAXED, __HIP_MEMORY_SCOPE_AGENT); }
__device__ __forceinline__ unsigned xb_add(unsigned* p, unsigned v) { return __hip_atomic_fetch_add(p, v, __ATOMIC_RELAXED, __HIP_MEMORY_SCOPE_AGENT); }
__device__ __forceinline__ unsigned xb_xcc_id() { return (unsigned)__builtin_amdgcn_s_getreg((3 << 11) | 20) & 0xFu; }
#define XB_SPIN(cond, bar) do { unsigned _sp = 0; while (cond) { __builtin_amdgcn_s_sleep(1); \
    if ((++_sp & 255u) == 0u) { if (xb_ld(&(bar)[XB_TMO])) break; if (_sp > XB_SPIN_CAP) { atomicAdd(&(bar)[XB_TMO], 1u); break; } } } } while (0)
struct XcdBarrier { unsigned* bar; unsigned x; volatile LAS unsigned* st; };
__device__ __forceinline__ XcdBarrier xcd_barrier_post(unsigned* bar, volatile LAS unsigned* st) {
    XcdBarrier b; b.bar = bar; b.x = xb_xcc_id(); b.st = st;
    if (threadIdx.x == 0) (void)xb_add(&bar[XB_XCNT(b.x)], 1u);
    return b;
}
__device__ __forceinline__ void xcd_barrier_complete(unsigned* bar, unsigned x, unsigned& nloc, unsigned& nx) {
    const unsigned G = gridDim.x * gridDim.y * gridDim.z;
    unsigned sum, cnt, mine, sp = 0u;
    for (;;) {
        sum = 0u; cnt = 0u; mine = 0u;
#pragma unroll
        for (unsigned j = 0; j < 16; ++j) { const unsigned c = xb_ld(&bar[XB_XCNT(j)]); sum += c; cnt += (c > 0u) ? 1u : 0u; mine = (j == x) ? c : mine; }
        if (sum == G) break;
        __builtin_amdgcn_s_sleep(1);
        if ((++sp & 255u) == 0u) { if (xb_ld(&bar[XB_TMO])) break; if (sp > XB_SPIN_CAP) { atomicAdd(&bar[XB_TMO], 1u); break; } }
    }
    nloc = mine > 0u ? mine : 1u; nx = cnt > 0u ? cnt : 1u;
}
__device__ __forceinline__ void xcd_barrier(const XcdBarrier& b) {
    asm volatile("s_waitcnt vmcnt(0)" ::: "memory");
    __syncthreads();
    if (threadIdx.x == 0) {
        unsigned* bar = b.bar;
        __builtin_amdgcn_s_waitcnt(0);
        unsigned nloc = b.st[0], nx = b.st[1];
        if (nloc == 0u) { xcd_barrier_complete(bar, b.x, nloc, nx); b.st[0] = nloc; b.st[1] = nx; }
        const unsigned old = xb_add(&bar[XB_XSUB(b.x)], 1u);
        const unsigned gen = old / nloc;
        if (old + 1u == (gen + 1u) * nloc) {
            __builtin_amdgcn_fence(__ATOMIC_RELEASE, "agent");
            asm volatile("s_waitcnt vmcnt(0)" ::: "memory");
            const unsigned og = xb_add(&bar[XB_TOP], 1u);
            const unsigned tg = og / nx;
            if (og + 1u == (tg + 1u) * nx) xb_add(&bar[XB_TOPGEN], 1u);
            else XB_SPIN(xb_ld(&bar[XB_TOPGEN]) == tg, bar);
            __builtin_amdgcn_fence(__ATOMIC_ACQUIRE, "agent");
            xb_add(&bar[XB_XGEN(b.x)], 1u);
            asm volatile("s_waitcnt vmcnt(0)" ::: "memory");
        } else {
            XB_SPIN(xb_ld(&bar[XB_XGEN(b.x)]) == gen, bar);
            __builtin_amdgcn_fence(__ATOMIC_ACQUIRE, "agent");
            asm volatile("s_waitcnt vmcnt(0)" ::: "memory");
        }
    }
    __syncthreads();
}

namespace pg8 {
constexpr int BM = 256, BK = 64, HALF = 128, HTB = HALF * BK * 2, STAGE_BYTES = 8 * HTB, NXCD = 8, WGM = 8;
__device__ __forceinline__ int lds_byte(int r, int c) { const int st = (r >> 4) * 2 + (c >> 5), rr = r & 15, cc = c & 31, ob = rr * 64 + cc * 2; return st * 1024 + (ob ^ (((ob >> 9) & 1) << 5)); }
__device__ __forceinline__ void stage_rc(int b, int& R, int& C) { const int st = b / 1024, sb = b % 1024, swz = sb ^ (((sb >> 9) & 1) << 5); R = (st >> 1) * 16 + swz / 64; C = (st & 1) * 32 + (swz % 64) / 2; }
__device__ __forceinline__ int perm32(int rho) { const int n = rho >> 4, i = rho & 15; return 8 * (i >> 2) + 4 * n + (i & 3); }

struct Unit { int pm, pn, pb, e; };

struct StaticOrder {
    static constexpr bool DYN = false;
    unsigned* ticket;
    int nM, nN, nwg, G, c;
    __device__ __forceinline__ void publish(int, unsigned) const {}
    __device__ __forceinline__ void init(int M, int N, int G_, int c_) { nM = M / BM; nN = N / BM; nwg = nM * nN; G = G_; c = c_; }
    __device__ __forceinline__ bool next(int i, Unit& u) const {
        const long L = (long)i * G + c; if (L >= nwg) return false;
        int wgid = (int)L; { const int q = nwg / NXCD, r = nwg % NXCD, xcd = wgid % NXCD, off = wgid / NXCD; wgid = (xcd < r ? xcd * (q + 1) : r * (q + 1) + (xcd - r) * q) + off; }
        const int nig = WGM * nN, gid = wgid / nig, fm = gid * WGM, gsz = (nM - fm) < WGM ? (nM - fm) : WGM;
        u.pm = fm + ((wgid % nig) % gsz); u.pn = (wgid % nig) / gsz; u.pb = u.pn; u.e = 0; return true;
    }
    __device__ __forceinline__ int arow(const Unit& u, int r) const { return u.pm * BM + r; }
    __device__ __forceinline__ int arow_next(const Unit& u, int r) const { return u.pm * BM + r; }
    __device__ __forceinline__ void prefetch_rows(const Unit&) const {}
};
struct MoeOrder {
    const LAS int* tb; const LAS int* cnt; const int* elist; int npn, G, c, gather;
    LAS int* idx;
    unsigned* ticket; LAS int* slot;
    static constexpr bool DYN = true;
    __device__ __forceinline__ void publish(int k, unsigned t) const { slot[k & 1] = (int)t; }
    __device__ __forceinline__ bool next(int i, Unit& u) const {
        const int NT = tb[32];
        const int L = i < 3 ? i * G + c : 3 * G + slot[i & 1];
        const int mq = L / npn; u.pn = L - mq * npn;
        if (mq >= NT) return false;
        const int mt = gather ? mq : NT - 1 - mq;
        u.pm = mt;
        int e = 0;
#pragma unroll
        for (int st = 16; st >= 1; st >>= 1) e += (tb[e + st] <= mt) ? st : 0;
        u.e = e; u.pb = e * npn + u.pn; return true;
    }
    __device__ __forceinline__ void prefetch_rows(const Unit& u) const {
        if (!gather) return;
        const int t_ = threadIdx.x;
        if (t_ < 256) { const int cn = cnt[u.e]; int rank = (u.pm - tb[u.e]) * BM + t_; rank = rank < cn ? rank : cn - 1;
            __builtin_amdgcn_global_load_lds((const unsigned*)(elist + u.e * 32768 + rank), (LAS unsigned*)(idx + (t_ & ~63)), 4, 0, 0); }
    }
    __device__ __forceinline__ int arow_next(const Unit& u, int r) const {
        if (!gather) return u.pm * BM + r;
        return idx[r];
    }
    __device__ __forceinline__ int arow(const Unit& u, int r) const {
        if (!gather) return u.pm * BM + r;
        const int rank = (u.pm - tb[u.e]) * BM + r;
        int row = 0;
        if (rank < cnt[u.e]) row = elist[u.e * 32768 + rank];
        return row;
    }
};

__device__ __forceinline__ unsigned cvt_pk_bf16(float lo, float hi) { return pk2(lo, hi); }

struct EpiZ {
    static constexpr bool PERM = true; static constexpr int NVM = 0;
    bf16_t* O; int ldc; float wscale;
    template <class Hook> __device__ __forceinline__ void operator()(const f32x4 (&acc)[2][2][4][2], const Unit& u, int wr, int wc, int fr, int fq, Hook&& hook) const {
        const int row0 = u.pm * BM + wr * 64 + fr, col0 = u.pn * BM + wc * 32 + 8 * fq;
#pragma unroll
        for (int ai = 0; ai < 2; ++ai)
#pragma unroll
            for (int m = 0; m < 4; ++m) { bf16_t* rowp = O + (size_t)(row0 + ai * HALF + m * 16) * ldc + col0;
#pragma unroll
                for (int bj = 0; bj < 2; ++bj) { const f32x4 v0 = acc[ai][bj][m][0] * wscale, v1 = acc[ai][bj][m][1] * wscale;
                    u32x4 w; w.x = cvt_pk_bf16(v0[0], v0[1]); w.y = cvt_pk_bf16(v0[2], v0[3]); w.z = cvt_pk_bf16(v1[0], v1[1]); w.w = cvt_pk_bf16(v1[2], v1[3]);
#if defined(DIAG_NOSTORE)
                    if (w.x == 0x12345678u && w.y == 0x9abcdef0u)
#endif
                    *(u32x4*)(rowp + bj * HALF) = w; } }
    }
};
template <bool XIN_F32>
struct EpiRes {
    static constexpr bool PERM = true; static constexpr int NVM = 0;
    const void* Xin; bf16_t* Xout; const float* gate;
    __device__ __forceinline__ void load8(size_t off, f32x4& lo, f32x4& hi) const {
        if (XIN_F32) { lo = __builtin_nontemporal_load((const f32x4*)((const float*)Xin + off)); hi = __builtin_nontemporal_load((const f32x4*)((const float*)Xin + off + 4)); }
        else { const u32x4 w = *(const u32x4*)((const bf16_t*)Xin + off);
            lo = (f32x4){bflo(w.x), bfhi(w.x), bflo(w.y), bfhi(w.y)}; hi = (f32x4){bflo(w.z), bfhi(w.z), bflo(w.w), bfhi(w.w)}; }
    }
    template <class Hook> __device__ __forceinline__ void operator()(const f32x4 (&acc)[2][2][4][2], const Unit& u, int wr, int wc, int fr, int fq, Hook&& hook) const {
        const int row0 = u.pm * BM + wr * 64 + fr, col0 = u.pn * BM + wc * 32 + 8 * fq;
        const int b = (u.pm * BM) >> 13;
        f32x4 gv[2][2];
#pragma unroll
        for (int bj = 0; bj < 2; ++bj)
#pragma unroll
            for (int n = 0; n < 2; ++n) gv[bj][n] = *(const f32x4*)(gate + b * 6144 + col0 + bj * HALF + 4 * n);
        if (!XIN_F32) {
            u32x4 xr[8][2];
#pragma unroll
            for (int g = 0; g < 8; ++g)
#pragma unroll
                for (int bj = 0; bj < 2; ++bj) xr[g][bj] = *(const u32x4*)((const bf16_t*)Xin + (size_t)(row0 + (g >> 2) * HALF + (g & 3) * 16) * D + col0 + bj * HALF);
#pragma unroll
            for (int g = 0; g < 8; ++g) { const int ai = g >> 2, m = g & 3; const size_t off = (size_t)(row0 + ai * HALF + m * 16) * D + col0;
#pragma unroll
                for (int bj = 0; bj < 2; ++bj) { const u32x4 w_ = xr[g][bj];
                    const f32x4 lo = {bflo(w_.x), bfhi(w_.x), bflo(w_.y), bfhi(w_.y)}, hi = {bflo(w_.z), bfhi(w_.z), bflo(w_.w), bfhi(w_.w)};
                    const f32x4 v0 = lo + gv[bj][0] * acc[ai][bj][m][0], v1 = hi + gv[bj][1] * acc[ai][bj][m][1];
                    u32x4 w; w.x = cvt_pk_bf16(v0[0], v0[1]); w.y = cvt_pk_bf16(v0[2], v0[3]); w.z = cvt_pk_bf16(v1[0], v1[1]); w.w = cvt_pk_bf16(v1[2], v1[3]);
                    *(u32x4*)(Xout + off + bj * HALF) = w; } }
        } else {
#pragma unroll
            for (int ai = 0; ai < 2; ++ai) {
                f32x4 xi[4][2][2];
#pragma unroll
                for (int m = 0; m < 4; ++m)
#pragma unroll
                    for (int bj = 0; bj < 2; ++bj) load8((size_t)(row0 + ai * HALF + m * 16) * D + col0 + bj * HALF, xi[m][bj][0], xi[m][bj][1]);
#pragma unroll
                for (int m = 0; m < 4; ++m) { const size_t off = (size_t)(row0 + ai * HALF + m * 16) * D + col0;
#pragma unroll
                    for (int bj = 0; bj < 2; ++bj) { const f32x4 v0 = xi[m][bj][0] + gv[bj][0] * acc[ai][bj][m][0], v1 = xi[m][bj][1] + gv[bj][1] * acc[ai][bj][m][1];
                        u32x4 w; w.x = cvt_pk_bf16(v0[0], v0[1]); w.y = cvt_pk_bf16(v0[2], v0[3]); w.z = cvt_pk_bf16(v1[0], v1[1]); w.w = cvt_pk_bf16(v1[2], v1[3]);
                        *(u32x4*)(Xout + off + bj * HALF) = w; } }
            }
        }
    }
};
struct EpiSwiglu {
    static constexpr bool PERM = true; static constexpr int NVM = 7;
    unsigned char* O; const float* bg; const float* bu; float wscale;
    template <class Hook> __device__ __forceinline__ void operator()(const f32x4 (&acc)[2][2][4][2], const Unit& u, int wr, int wc, int fr, int fq, Hook&& hook) const {
        const int row0 = u.pm * BM + wr * 64 + fr, j0 = u.pn * HALF + wc * 32 + 8 * fq;
        f32x4 g0 = *(const f32x4*)(bg + u.e * 1024 + j0), g1 = *(const f32x4*)(bg + u.e * 1024 + j0 + 4);
        f32x4 u0 = *(const f32x4*)(bu + u.e * 1024 + j0), u1 = *(const f32x4*)(bu + u.e * 1024 + j0 + 4);
        u0 += 1.0f; u1 += 1.0f;
        const f32x2_ ws2 = {wscale, wscale}, kn2 = {-2.4554669595930157f, -2.4554669595930157f}, one2 = {1.0f, 1.0f};
#pragma unroll
        for (int ai = 0; ai < 2; ++ai)
#pragma unroll
            for (int m = 0; m < 4; ++m) { unsigned char* rowp = O + (size_t)(row0 + ai * HALF + m * 16) * D + j0;
                float r[8];
#pragma unroll
                for (int n = 0; n < 2; ++n)
#pragma unroll
                    for (int h = 0; h < 2; ++h) {
                        const f32x4 gb4 = n ? g1 : g0, ub4 = n ? u1 : u0;
                        const f32x2_ ga = {acc[ai][0][m][n][2 * h], acc[ai][0][m][n][2 * h + 1]}, ua = {acc[ai][1][m][n][2 * h], acc[ai][1][m][n][2 * h + 1]};
                        const f32x2_ gbp = {gb4[2 * h], gb4[2 * h + 1]}, ubp = {ub4[2 * h], ub4[2 * h + 1]};
                        f32x2_ gt = ga * ws2 + gbp, up = ua * ws2 + ubp;
                        gt.x = fminf(gt.x, 7.0f); gt.y = fminf(gt.y, 7.0f);
                        up.x = fminf(fmaxf(up.x, -6.0f), 8.0f); up.y = fminf(fmaxf(up.y, -6.0f), 8.0f);
                        const f32x2_ t = gt * kn2;
                        f32x2_ e; e.x = __builtin_amdgcn_exp2f(t.x); e.y = __builtin_amdgcn_exp2f(t.y);
                        const f32x2_ d = e + one2;
                        f32x2_ rc; rc.x = __builtin_amdgcn_rcpf(d.x); rc.y = __builtin_amdgcn_rcpf(d.y);
                        const f32x2_ o = up * gt * rc;
                        r[n * 4 + 2 * h] = o.x; r[n * 4 + 2 * h + 1] = o.y; }
                u32x2 w; w.x = pk4_fp8(r[0], r[1], r[2], r[3]); w.y = pk4_fp8(r[4], r[5], r[6], r[7]);
                *(u32x2*)rowp = w;
                if (ai == 0 && m == 0) hook(); }
    }
};
struct EpiDown {
    static constexpr bool PERM = true; static constexpr int NVM = 15;
    bf16_t* O; const float* bd; float wscale;
    template <class Hook> __device__ __forceinline__ void operator()(const f32x4 (&acc)[2][2][4][2], const Unit& u, int wr, int wc, int fr, int fq, Hook&& hook) const {
        const int row0 = u.pm * BM + wr * 64 + fr, col0 = u.pn * BM + wc * 32 + 8 * fq;
        f32x4 bb[2][2];
#pragma unroll
        for (int bj = 0; bj < 2; ++bj) { bb[bj][0] = *(const f32x4*)(bd + u.e * 1024 + col0 + bj * HALF); bb[bj][1] = *(const f32x4*)(bd + u.e * 1024 + col0 + bj * HALF + 4); }
#pragma unroll
        for (int bj = 0; bj < 2; ++bj) {
            const f32x4 b0 = bb[bj][0], b1 = bb[bj][1];
#pragma unroll
            for (int ai = 0; ai < 2; ++ai)
#pragma unroll
                for (int m = 0; m < 4; ++m) { bf16_t* rowp = O + (size_t)(row0 + ai * HALF + m * 16) * D + col0 + bj * HALF;
                    const f32x4 v0 = acc[ai][bj][m][0] * wscale + b0, v1 = acc[ai][bj][m][1] * wscale + b1;
                    u32x4 w; w.x = cvt_pk_bf16(v0[0], v0[1]); w.y = cvt_pk_bf16(v0[2], v0[3]); w.z = cvt_pk_bf16(v1[0], v1[1]); w.w = cvt_pk_bf16(v1[2], v1[3]);
                    *(u32x4*)rowp = w;
                    if (bj == 0 && ai == 0 && m == 0) hook(); }
            asm volatile("" ::: "memory");
        }
    }
};

template <bool F8>
__device__ __forceinline__ f32x4 mma_pair(const bf16x8 b0, const bf16x8 b1, const bf16x8 a0, const bf16x8 a1, f32x4 acc) {
    if constexpr (F8) {
        const i32x4 bl = __builtin_bit_cast(i32x4, b0), bh = __builtin_bit_cast(i32x4, b1), al = __builtin_bit_cast(i32x4, a0), ah = __builtin_bit_cast(i32x4, a1);
        const i32x8 bv = __builtin_shufflevector(bl, bh, 0, 1, 2, 3, 4, 5, 6, 7), av = __builtin_shufflevector(al, ah, 0, 1, 2, 3, 4, 5, 6, 7);
        return __builtin_amdgcn_mfma_scale_f32_16x16x128_f8f6f4(bv, av, acc, 0, 0, 0, 0x7f7f7f7f, 0, 0x7f7f7f7f);
    } else {
        acc = __builtin_amdgcn_mfma_f32_16x16x32_bf16(b0, a0, acc, 0, 0, 0);
        return __builtin_amdgcn_mfma_f32_16x16x32_bf16(b1, a1, acc, 0, 0, 0);
    }
}
template <class Epi, class Sched, bool F8 = false>
__device__ __forceinline__ void gemm_phase(LAS unsigned char* lds, const bf16_t* A, const bf16_t* Bt, const int K, const Sched& S, const Epi& E) {
    const int tid = otid(), wid = __builtin_amdgcn_readfirstlane(tid >> 6), lane = tid & 63, wr = wid >> 2, wc = wid & 3, fr = lane & 15, fq = lane >> 4;
    const int nt = K / BK;
    unsigned voffB[2];
#pragma unroll
    for (int i = 0; i < 2; ++i) { int R, C; stage_rc(tid * 16 + i * 8192, R, C); const int Rb = Epi::PERM ? ((R & ~31) + perm32(R & 31)) : R;
        voffB[i] = (unsigned)(Rb * K + C) * 2u; }
    const size_t kstep = (size_t)(BK * 2);
    const size_t hstep = (size_t)HALF * K * 2;
    const size_t tstep = 2 * hstep;
    const unsigned ldsw = (unsigned)wid * 1024u;
    const int aoff = lds_byte(wr * 64 + fr, fq * 8), boff = lds_byte(wc * 32 + fr, fq * 8);
#define PG8_SA(b, h) (((b) * 2 + (h)) * HTB)
#define PG8_SB(b, h) ((4 + (b) * 2 + (h)) * HTB)
#define PG8_STAGE(bufoff, gbase, voff) do { _Pragma("unroll") for (int _i = 0; _i < 2; ++_i) \
        __builtin_amdgcn_global_load_lds((const unsigned*)((const char*)(gbase) + (voff)[_i]), (LAS unsigned*)(lds + (bufoff) + ldsw + _i * 8192), 16, 0, 0); } while (0)
#define PG8_LDA(dst, b, h) do { _Pragma("unroll") for (int m = 0; m < 4; ++m) _Pragma("unroll") for (int k = 0; k < 2; ++k) dst[m][k] = *(const LAS bf16x8*)(lds + PG8_SA(b, h) + aoff + m * 2048 + k * 1024); } while (0)
#define PG8_LDB(dst, b, h) do { _Pragma("unroll") for (int n = 0; n < 2; ++n) _Pragma("unroll") for (int k = 0; k < 2; ++k) dst[n][k] = *(const LAS bf16x8*)(lds + PG8_SB(b, h) + boff + n * 2048 + k * 1024); } while (0)
#define PG8_MMA(ai, bj, At, Bt_) do { __builtin_amdgcn_s_setprio(1); _Pragma("unroll") for (int m = 0; m < 4; ++m) _Pragma("unroll") for (int n = 0; n < 2; ++n) \
        acc[ai][bj][m][n] = mma_pair<F8>(Bt_[n][0], Bt_[n][1], At[m][0], At[m][1], acc[ai][bj][m][n]); __builtin_amdgcn_s_setprio(0); } while (0)
#define PG8_WAIT_V(n) asm volatile("s_waitcnt vmcnt(" #n ")" ::: "memory")
#define PG8_WAIT_L(n) asm volatile("s_waitcnt lgkmcnt(" #n ")" ::: "memory")
#define PG8_BAR __builtin_amdgcn_s_barrier()
#define PG8_SCHED __builtin_amdgcn_sched_barrier(0)
#define PG8_OFFS(u, o) do { _Pragma("unroll") for (int _i = 0; _i < 2; ++_i) { int _R, _C; stage_rc(tid * 16 + _i * 8192, _R, _C); \
        _Pragma("unroll") for (int _h = 0; _h < 2; ++_h) { unsigned _o = (unsigned)(S.arow(u, _h * HALF + _R) * K + _C) * 2u; asm volatile("" : "+v"(_o)); o[_h][_i] = _o; } } } while (0)
#define PG8_OFFSN(u, o) do { _Pragma("unroll") for (int _i = 0; _i < 2; ++_i) { int _R, _C; stage_rc(tid * 16 + _i * 8192, _R, _C); \
        _Pragma("unroll") for (int _h = 0; _h < 2; ++_h) { unsigned _o = (unsigned)(S.arow_next(u, _h * HALF + _R) * K + _C) * 2u; asm volatile("" : "+v"(_o)); o[_h][_i] = _o; } } } while (0)
    Unit cur, nxt; int ui = 0;
    if (!S.next(0, cur)) return;
#if defined(GEMM_STAGGER)
    {
        const unsigned long long t0_ = __builtin_amdgcn_s_memrealtime(), dl_ = (unsigned long long)((blockIdx.x >> 3) & 3u) * GEMM_STAGGER;
        while (__builtin_amdgcn_s_memrealtime() - t0_ < dl_) __builtin_amdgcn_s_sleep(8);
    }
#endif
    f32x4 acc[2][2][4][2];
#pragma unroll
    for (int a = 0; a < 2; ++a)
#pragma unroll
        for (int b = 0; b < 2; ++b)
#pragma unroll
            for (int m = 0; m < 4; ++m)
#pragma unroll
                for (int n = 0; n < 2; ++n) acc[a][b][m][n] = (f32x4){0.f, 0.f, 0.f, 0.f};
    bf16x8 At[4][2], B0[2][2], B1[2][2];
    unsigned oC[2][2];
    PG8_OFFS(cur, oC);
    const char* Ab = (const char*)A;
    const char* cB = (const char*)Bt + (size_t)cur.pb * tstep;
    PG8_STAGE(PG8_SB(0, 0), cB, voffB); PG8_STAGE(PG8_SA(0, 0), Ab, oC[0]); PG8_STAGE(PG8_SB(0, 1), cB + hstep, voffB); PG8_STAGE(PG8_SA(0, 1), Ab, oC[1]);
    if (wr == 1) PG8_BAR;
    PG8_WAIT_V(4); PG8_BAR;
    PG8_STAGE(PG8_SB(1, 0), cB + kstep, voffB); PG8_STAGE(PG8_SA(1, 0), Ab + kstep, oC[0]); PG8_STAGE(PG8_SB(1, 1), cB + hstep + kstep, voffB);
    PG8_WAIT_V(6); PG8_BAR;
    for (;;) {
        const bool has_next = S.next(ui + 1, nxt);
        const char* nB = has_next ? (const char*)Bt + (size_t)nxt.pb * tstep : cB;
        if (has_next) S.prefetch_rows(nxt);
        for (int t = 0; t < nt; t += 2) {
            const bool last = (t == nt - 2);
            const char* a1 = Ab + (size_t)(t + 1) * kstep;
            const char* a2 = last ? Ab : Ab + (size_t)(t + 2) * kstep; const char* b2 = last ? nB : cB + (size_t)(t + 2) * kstep;
            const char* a3 = a2 + kstep; const char* b3 = b2 + kstep;
            PG8_LDB(B0, 0, 0); PG8_SCHED; PG8_LDA(At, 0, 0); PG8_STAGE(PG8_SA(1, 1), a1, oC[1]);
            PG8_WAIT_L(8); PG8_BAR; PG8_WAIT_L(0); PG8_MMA(0, 0, At, B0); PG8_BAR; PG8_SCHED;
            if (last && has_next) { PG8_OFFSN(nxt, oC); }
            PG8_LDB(B1, 0, 1); PG8_STAGE(PG8_SB(0, 0), b2, voffB);
            PG8_BAR; PG8_WAIT_L(0); PG8_MMA(0, 1, At, B1); PG8_BAR;
            PG8_LDA(At, 0, 1); PG8_STAGE(PG8_SA(0, 0), a2, oC[0]);
            PG8_BAR; PG8_WAIT_L(0); PG8_MMA(1, 0, At, B0); PG8_BAR; PG8_SCHED;
            PG8_STAGE(PG8_SB(0, 1), b2 + hstep, voffB);
            PG8_WAIT_V(6); PG8_BAR; PG8_MMA(1, 1, At, B1); PG8_BAR;
            PG8_LDB(B0, 1, 0); PG8_SCHED; PG8_LDA(At, 1, 0); PG8_STAGE(PG8_SA(0, 1), a2, oC[1]);
            PG8_WAIT_L(8); PG8_BAR; PG8_WAIT_L(0); PG8_MMA(0, 0, At, B0); PG8_BAR; PG8_SCHED;
            PG8_LDB(B1, 1, 1); PG8_STAGE(PG8_SB(1, 0), b3, voffB);
            PG8_BAR; PG8_WAIT_L(0); PG8_MMA(0, 1, At, B1); PG8_BAR;
            PG8_LDA(At, 1, 1); PG8_STAGE(PG8_SA(1, 0), a3, oC[0]);
            PG8_BAR; PG8_WAIT_L(0); PG8_MMA(1, 0, At, B0); PG8_BAR; PG8_SCHED;
            PG8_STAGE(PG8_SB(1, 1), b3 + hstep, voffB);
            PG8_WAIT_V(6); PG8_BAR; PG8_MMA(1, 1, At, B1); PG8_BAR;
        }
        if (wr == 0) PG8_BAR;
        unsigned tkt = 0u;
        auto hook = [&]() __attribute__((always_inline)) {
            if constexpr (Sched::DYN) {
                if (wid == 0) { unsigned long long sv_; const unsigned zero_ = 0u, one_ = 1u;
                    asm volatile("s_mov_b64 %1, exec\n\ts_mov_b64 exec, 1\n\tglobal_atomic_add %0, %2, %3, %4 sc0\n\ts_mov_b64 exec, %1"
                                 : "=&v"(tkt), "=&s"(sv_) : "v"(zero_), "v"(one_), "s"(S.ticket) : "memory"); }
            }
        };
        E(acc, cur, wr, wc, fr, fq, hook);
        if constexpr (Sched::DYN) {
            if (wid == 0) { asm volatile("s_waitcnt vmcnt(%1)" : "+v"(tkt) : "n"(Epi::NVM) : "memory");
                if (lane == 0) S.publish(ui + 3, tkt); }
        }
        if (!has_next) break;
#pragma unroll
        for (int a = 0; a < 2; ++a)
#pragma unroll
            for (int b = 0; b < 2; ++b)
#pragma unroll
                for (int m = 0; m < 4; ++m)
#pragma unroll
                    for (int n = 0; n < 2; ++n) acc[a][b][m][n] = (f32x4){0.f, 0.f, 0.f, 0.f};
        cur = nxt; cB = nB; ++ui;
        if (wr == 1) PG8_BAR;
    }
    PG8_WAIT_V(0);
    PG8_BAR;
#undef PG8_SA
#undef PG8_SB
#undef PG8_STAGE
#undef PG8_LDA
#undef PG8_LDB
#undef PG8_MMA
#undef PG8_WAIT_V
#undef PG8_WAIT_L
#undef PG8_BAR
#undef PG8_SCHED
#undef PG8_OFFS
#undef PG8_OFFSN
}
}

struct Params {
    const float *x, *c; const int* pos;
    const float *w_ada, *b_ada, *norm1_g, *w_in, *conv_w, *conv_b, *b_ig, *b_fg, *mnorm_g, *w_out, *norm2_g, *w_router, *b_router,
                *w_gate, *b_gate, *w_up, *b_up, *w_down, *b_down, *fnorm_g;
    float* out; unsigned char* ws; int ph_lo, ph_hi;
};
#define WSP(type, off) ((type*)(p.ws + (off)))
typedef const __attribute__((address_space(4))) Params* ParamsK;
#if defined(__HIP_DEVICE_COMPILE__)
__device__ __forceinline__ ParamsK kparams() { ParamsK k = (ParamsK)__builtin_amdgcn_kernarg_segment_ptr(); asm volatile("" : "+s"(k)); return k; }
#define LOADP() (*kparams())
#else
#define LOADP() (Params{})
#endif
#define MFMA16(a, b, c) __builtin_amdgcn_mfma_f32_16x16x32_bf16((a), (b), (c), 0, 0, 0)

__device__ __forceinline__ void tr_item(const float* __restrict__ W, int ldw, int k0, int nsrc0, bf16_t* __restrict__ WT, int K, int drow0, LAS float* scr, int lane) {
    f32x4 v[8];
#pragma unroll
    for (int i = 0; i < 8; ++i) v[i] = *(const f32x4*)(W + (size_t)(k0 + (lane >> 3) + 8 * i) * ldw + nsrc0 + (lane & 7) * 4);
#pragma unroll
    for (int i = 0; i < 8; ++i) { LAS float* d = scr + ((lane >> 3) + 8 * i) * 33 + (lane & 7) * 4; d[0] = v[i][0]; d[1] = v[i][1]; d[2] = v[i][2]; d[3] = v[i][3]; }
    LDS_WAIT();
    const int c = lane & 7;
#pragma unroll
    for (int j = 0; j < 4; ++j) { const int n = (lane >> 3) + 8 * j; const LAS float* s = scr + (8 * c) * 33 + n;
        u32x4 o; o.x = pk2(s[0 * 33], s[1 * 33]); o.y = pk2(s[2 * 33], s[3 * 33]); o.z = pk2(s[4 * 33], s[5 * 33]); o.w = pk2(s[6 * 33], s[7 * 33]);
        *(u32x4*)(WT + (size_t)(drow0 + n) * K + k0 + 8 * c) = o; }
    LDS_WAIT();
}
__device__ __forceinline__ void tr_item8(const float* __restrict__ W, int ldw, int k0, int nsrc0, unsigned char* __restrict__ WT8, int K, int drow0, LAS float* scr, int lane, float scale) {
    f32x4 v[8];
#pragma unroll
    for (int i = 0; i < 8; ++i) v[i] = __builtin_nontemporal_load((const f32x4*)(W + (size_t)(k0 + (lane >> 3) + 8 * i) * ldw + nsrc0 + (lane & 7) * 4));
#pragma unroll
    for (int i = 0; i < 8; ++i) { LAS float* d = scr + ((lane >> 3) + 8 * i) * 33 + (lane & 7) * 4; d[0] = v[i][0]; d[1] = v[i][1]; d[2] = v[i][2]; d[3] = v[i][3]; }
    LDS_WAIT();
    const int c = lane & 3;
#pragma unroll
    for (int j = 0; j < 2; ++j) { const int n = (lane >> 2) + 16 * j; const LAS float* s_ = scr + (16 * c) * 33 + n;
        u32x4 o;
        o.x = pk4_fp8(s_[0 * 33] * scale, s_[1 * 33] * scale, s_[2 * 33] * scale, s_[3 * 33] * scale);
        o.y = pk4_fp8(s_[4 * 33] * scale, s_[5 * 33] * scale, s_[6 * 33] * scale, s_[7 * 33] * scale);
        o.z = pk4_fp8(s_[8 * 33] * scale, s_[9 * 33] * scale, s_[10 * 33] * scale, s_[11 * 33] * scale);
        o.w = pk4_fp8(s_[12 * 33] * scale, s_[13 * 33] * scale, s_[14 * 33] * scale, s_[15 * 33] * scale);
        __builtin_nontemporal_store(o, (u32x4*)(WT8 + (size_t)(drow0 + n) * K + k0 + 16 * c)); }
    LDS_WAIT();
}
constexpr float W8_SCALE = 32.0f, W8_INV = 1.0f / 32.0f;
constexpr int CVT_TPL = NE * 1536 / 8, CVT_NT = 2 * CVT_TPL, CVT_GU = NE * 1024 / 8;
__device__ __forceinline__ void convert_ticket(const Params& p, unsigned t, LAS unsigned char* lds) {
    const int tid = otid(), lane = tid & 63, wave = __builtin_amdgcn_readfirstlane(tid >> 6);
    LAS float* scr = (LAS float*)(lds + wave * 8448);
    const int l = t >= (unsigned)CVT_TPL ? 1 : 0, tl = (int)t - l * CVT_TPL;
    unsigned char* WGU = WSP(unsigned char, WS_WGU) + (size_t)l * NE * 2048 * 1024; unsigned char* WD = WSP(unsigned char, WS_WD) + (size_t)l * NE * 1024 * 1024;
    const bool dn = tl >= CVT_GU; const int it = (dn ? tl - CVT_GU : tl) * 8 + wave;
    const int e = dn ? it / 512 : it / 1024, mat = dn ? 2 : (it % 1024) / 512, q = it % 512, kb = q / 32, nb = q % 32, k0 = kb * 64, n0 = nb * 32;
    const size_t eo = (size_t)(l * NE + e) * 1024 * 1024;
    if (mat == 0) tr_item8(p.w_gate + eo, 1024, k0, n0, WGU + (size_t)e * 2048 * 1024, 1024, (n0 >> 7) * 256 + (n0 & 127), scr, lane, W8_SCALE);
    else if (mat == 1) tr_item8(p.w_up + eo, 1024, k0, n0, WGU + (size_t)e * 2048 * 1024, 1024, (n0 >> 7) * 256 + 128 + (n0 & 127), scr, lane, W8_SCALE);
    else tr_item8(p.w_down + eo, 1024, k0, n0, WD + (size_t)e * 1024 * 1024, 1024, n0, scr, lane, W8_SCALE);
}
constexpr unsigned XB_RELEASED = 0xFFFFFFFFu, XB_PENDING = 0xFFFFFFFEu;
__device__ __forceinline__ void cvt_drain(const Params& p, LAS unsigned char* lds, volatile LAS unsigned* st, const unsigned limit) {
    __syncthreads();
#if defined(DIAG_A)
    if (blockIdx.x == 0 && threadIdx.x == 0) { volatile unsigned long long* ds = (volatile unsigned long long*)(p.ws + WS_CTL + 524288); const int l_ = (int)((limit - 1u) / CVT_TPL) * 2 + ((limit % CVT_TPL) == 0u ? 1 : 0);
        ds[40 + 2 * l_] = 0ull; ds[41 + 2 * l_] = 100ull * (unsigned long long)xb_ld(WSP(unsigned, WS_CTL) + CW_CVT); }
#endif
    if (st[3]) return;
    unsigned* tk = WSP(unsigned, WS_CTL) + CW_CVT;
    if (threadIdx.x == 0) st[2] = xb_add(tk, 1u);
    __syncthreads();
    unsigned t = st[2];
    for (;;) {
        const bool more = t < limit;
        unsigned tn = 0u;
        if (more && threadIdx.x == 0) tn = xb_add(tk, 1u);
        if (t < (unsigned)CVT_NT) convert_ticket(p, t, lds);
        if (!more) break;
        __syncthreads();
        if (threadIdx.x == 0) st[2] = tn;
        __syncthreads();
        t = st[2];
    }
    __syncthreads();
    if (t >= (unsigned)CVT_NT && threadIdx.x == 0) st[3] = 1u;
    __syncthreads();
}
#ifndef XB_STEAL_MARGIN
#define XB_STEAL_MARGIN 0u
#endif
__device__ __forceinline__ void xcd_barrier_steal(const XcdBarrier& b, LAS unsigned char* lds) {
    asm volatile("s_waitcnt vmcnt(0)" ::: "memory");
    __syncthreads();
    volatile LAS unsigned* st = b.st;
    if (threadIdx.x == 0) {
        unsigned* bar = b.bar;
        __builtin_amdgcn_s_waitcnt(0);
        unsigned nloc = st[0], nx = st[1];
        if (nloc == 0u) { xcd_barrier_complete(bar, b.x, nloc, nx); st[0] = nloc; st[1] = nx; }
        const unsigned old = xb_add(&bar[XB_XSUB(b.x)], 1u);
        const unsigned gen = old / nloc;
        if (old + 1u == (gen + 1u) * nloc) {
            __builtin_amdgcn_fence(__ATOMIC_RELEASE, "agent");
            asm volatile("s_waitcnt vmcnt(0)" ::: "memory");
            const unsigned og = xb_add(&bar[XB_TOP], 1u);
            const unsigned tg = og / nx;
            if (og + 1u == (tg + 1u) * nx) xb_add(&bar[XB_TOPGEN], 1u);
            else XB_SPIN(xb_ld(&bar[XB_TOPGEN]) == tg, bar);
            __builtin_amdgcn_fence(__ATOMIC_ACQUIRE, "agent");
            xb_add(&bar[XB_XGEN(b.x)], 1u);
            asm volatile("s_waitcnt vmcnt(0)" ::: "memory");
            st[2] = XB_RELEASED;
        } else if (st[3]) {
            XB_SPIN(xb_ld(&bar[XB_XGEN(b.x)]) == gen, bar);
            __builtin_amdgcn_fence(__ATOMIC_ACQUIRE, "agent");
            asm volatile("s_waitcnt vmcnt(0)" ::: "memory");
            st[2] = XB_RELEASED;
        } else { st[2] = XB_PENDING; st[4] = gen; }
    }
    for (;;) {
        __syncthreads();
        const unsigned s = st[2];
        if (s == XB_RELEASED) break;
        if (s < (unsigned)CVT_NT) { const Params p = LOADP(); convert_ticket(p, s, lds); }
        __syncthreads();
        if (threadIdx.x == 0) {
            unsigned* bar = b.bar; const unsigned nloc = st[0], gen = st[4];
            unsigned sp = 0u, res = XB_RELEASED;
            for (;;) {
                if (xb_ld(&bar[XB_XGEN(b.x)]) != gen) break;
                if (!st[3] && xb_ld(&bar[XB_XSUB(b.x)]) - gen * nloc + XB_STEAL_MARGIN <= nloc) {
                    const Params p = LOADP();
                    const unsigned t = xb_add(WSP(unsigned, WS_CTL) + CW_CVT, 1u);
                    if (t < (unsigned)CVT_NT) { res = t; break; }
                    st[3] = 1u;
                }
                __builtin_amdgcn_s_sleep(1);
                if ((++sp & 255u) == 0u) { if (xb_ld(&bar[XB_TMO])) break; if (sp > XB_SPIN_CAP) { atomicAdd(&bar[XB_TMO], 1u); break; } }
            }
            if (res == XB_RELEASED) { __builtin_amdgcn_fence(__ATOMIC_ACQUIRE, "agent"); asm volatile("s_waitcnt vmcnt(0)" ::: "memory"); }
            st[2] = res;
        }
    }
}
__device__ __forceinline__ void prologue_phase(const Params& p, LAS unsigned char* lds) {
    const int tid = otid(), lane = tid & 63, wave = tid >> 6;
    const int G = gridDim.x;
    {
        LAS float* condl = (LAS float*)(lds + 70000);
        LAS float* red = (LAS float*)(lds + 70000 + 16384);
#pragma unroll
        for (int i = tid; i < 4096; i += 512) { const float cv = p.c[i]; condl[i] = cv / (1.0f + __expf(-cv)); }
        __syncthreads();
        float* MOD = WSP(float, WS_MOD);
        for (int u = blockIdx.x; u < 192; u += G) {
            const int l = u / 96, n0 = (u % 96) * 64;
            const float* w = p.w_ada + (size_t)l * 1024 * 6144 + n0 + lane;
            float a0 = 0.f, a1 = 0.f, a2 = 0.f, a3 = 0.f;
#pragma unroll 32
            for (int kk = 0; kk < 128; ++kk) { const int k = wave * 128 + kk; const float wv = __builtin_nontemporal_load(w + (size_t)k * 6144);
                a0 += condl[k] * wv; a1 += condl[1024 + k] * wv; a2 += condl[2048 + k] * wv; a3 += condl[3072 + k] * wv; }
            red[(wave * 4 + 0) * 64 + lane] = a0; red[(wave * 4 + 1) * 64 + lane] = a1; red[(wave * 4 + 2) * 64 + lane] = a2; red[(wave * 4 + 3) * 64 + lane] = a3;
            __syncthreads();
            if (tid < 256) { const int b = tid >> 6, ln = tid & 63; float s = p.b_ada[l * 6144 + n0 + ln];
#pragma unroll
                for (int w8 = 0; w8 < 8; ++w8) s += red[(w8 * 4 + b) * 64 + ln];
                MOD[(size_t)(l * 4 + b) * 6144 + n0 + ln] = s; }
            __syncthreads();
        }
    }
    {
        LAS float* scr = (LAS float*)(lds + wave * 8448);
        const int gw = blockIdx.x * 8 + wave, NGW = G * 8;
        bf16_t* WIN = WSP(bf16_t, WS_WIN); bf16_t* WOUT = WSP(bf16_t, WS_WOUT);
        constexpr int I_IN = 16 * 112, I_OUT = 16 * 32;
        for (int it = gw; it < 2 * I_IN + 2 * I_OUT; it += NGW) {
            if (it < 2 * I_IN) { const int l = it / I_IN, r = it % I_IN, kb = r / 112, nb = r % 112, n0 = nb * 32;
                tr_item8(p.w_in + (size_t)l * 1024 * NIN, NIN, kb * 64, n0 < 2048 ? n0 : n0 + 8, (unsigned char*)WIN + (size_t)l * NZ * 1024, 1024, n0, scr, lane, W8_SCALE); }
            else { const int r2 = it - 2 * I_IN, l = r2 / I_OUT, r = r2 % I_OUT, kb = r / 32, nb = r % 32;
                tr_item(p.w_out + (size_t)l * 1024 * 1024, 1024, kb * 64, nb * 32, WOUT + (size_t)l * 1024 * 1024, 1024, nb * 32, scr, lane); }
        }
    }
}

__device__ __forceinline__ void moe_tile_prefix(const Params& p, int lm, LAS int* tb, LAS int* cnt) {
    if (threadIdx.x < 64) { const unsigned* ec = WSP(unsigned, WS_CTL) + CW_ECNT + lm * 64; const int ln = threadIdx.x;
        const int c = ln < 32 ? (int)ec[ln] : 0; int inc = (c + 255) >> 8; const int tl_ = inc;
#pragma unroll
        for (int o = 1; o < 32; o <<= 1) { const int t_ = __shfl_up(inc, o); if (ln >= o) inc += t_; }
        if (ln < 32) { cnt[ln] = c; tb[ln] = inc - tl_; } if (ln == 31) tb[32] = inc; }
}
template <int MODE>
__device__ __forceinline__ void norm_phase(const Params& p, int l, LAS unsigned char* lds) {
    const int tid = otid(), lane = tid & 63, wave = tid >> 6;
#define NC(j) (8 * lane + 512 * ((j) >> 1) + 4 * ((j) & 1))
    LAS float* Wg = (LAS float*)lds;
    LAS int* tb = (LAS int*)(lds + 32768); LAS int* cnt = tb + 40;
    LAS float* gb = (LAS float*)(lds + 32768 + 512);
    if (MODE != 2 && tid < 8) gb[tid] = tid < 4 ? p.b_ig[l * 4 + tid] : p.b_fg[l * 4 + tid - 4];
    if (MODE != 2) { const float* wi = p.w_in + (size_t)l * 1024 * NIN + 2048;
#pragma unroll
        for (int i = tid; i < 8192; i += 512) { const int n = i >> 3, c = i & 7, rem = n & 511, jg = 2 * (n >> 9) + ((rem >> 2) & 1);
            Wg[(jg * 8 + c) * 256 + (rem >> 3) * 4 + (rem & 3)] = wi[(size_t)n * NIN + c]; } }
    if (MODE >= 1) moe_tile_prefix(p, MODE == 1 ? l - 1 : 1, tb, cnt);
    __syncthreads();
    const int lm = (MODE == 1) ? l - 1 : 1;
    const float* MOD = WSP(float, WS_MOD);
    bf16_t* X = WSP(bf16_t, WS_X); bf16_t* H = WSP(bf16_t, WS_H);
    const bf16_t* YB = WSP(bf16_t, WS_YB);
    const unsigned* PE = WSP(unsigned, WS_PE); const float* PROB = WSP(float, WS_PROB);
    float* IG = WSP(float, WS_IG); float* LF = WSP(float, WS_LF);
    const int gw = blockIdx.x * 8 + wave, NGW = gridDim.x * 8;
    constexpr int RB = 2;
    f32x4 vn[RB][4];
    if (MODE == 0) {
#pragma unroll
        for (int q = 0; q < RB; ++q) { const int rr = gw * RB + q < T ? gw * RB + q : T - 1; const float* xr = p.x + (size_t)rr * D;
#pragma unroll
            for (int j = 0; j < 4; ++j) vn[q][j] = __builtin_nontemporal_load((const f32x4*)(xr + NC(j))); }
    }
    for (int row0 = gw * RB; row0 < T; row0 += NGW * RB) {
        f32x4 v[RB][4];
#pragma unroll
        for (int q = 0; q < RB; ++q) {
            if (MODE == 0) {
#pragma unroll
                for (int j = 0; j < 4; ++j) v[q][j] = vn[q][j];
                const int rn = row0 + NGW * RB + q < T ? row0 + NGW * RB + q : row0 + q; const float* xr = p.x + (size_t)rn * D;
#pragma unroll
                for (int j = 0; j < 4; ++j) vn[q][j] = __builtin_nontemporal_load((const f32x4*)(xr + NC(j))); }
            else { const bf16_t* xr = X + (size_t)(row0 + q) * D;
#pragma unroll
                for (int jj = 0; jj < 2; ++jj) { const u32x4 w = *(const u32x4*)(xr + 8 * lane + 512 * jj);
                    v[q][2 * jj] = (f32x4){bflo(w.x), bfhi(w.x), bflo(w.y), bfhi(w.y)}; v[q][2 * jj + 1] = (f32x4){bflo(w.z), bfhi(w.z), bflo(w.w), bfhi(w.w)}; } } }
        if (MODE >= 1) {
            f32x4 y[RB][4];
#pragma unroll
            for (int q = 0; q < RB; ++q)
#pragma unroll
                for (int j = 0; j < 4; ++j) y[q][j] = (f32x4){0.f, 0.f, 0.f, 0.f};
            {
                u32x4 yw[RB][4][2]; float pr[RB][4]; unsigned pe[RB][4];
#pragma unroll
                for (int q = 0; q < RB; ++q)
#pragma unroll
                    for (int k = 0; k < 4; ++k) { pe[q][k] = PE[(row0 + q) * 4 + k]; pr[q][k] = PROB[(row0 + q) * 4 + k]; }
#pragma unroll
                for (int q = 0; q < RB; ++q)
#pragma unroll
                    for (int k = 0; k < 4; ++k) {
                        const int e = pe[q][k] & 255u, rank = pe[q][k] >> 8; const size_t srow = (size_t)tb[e] * 256 + rank;
                        const bf16_t* yb = YB + srow * D;
#pragma unroll
                        for (int jj = 0; jj < 2; ++jj) yw[q][k][jj] = __builtin_nontemporal_load((const u32x4*)(yb + 8 * lane + 512 * jj)); }
#pragma unroll
                for (int q = 0; q < RB; ++q)
#pragma unroll
                    for (int jj = 0; jj < 2; ++jj)
#pragma unroll
                        for (int k = 0; k < 4; ++k) { const u32x4 w = yw[q][k][jj]; const f32x2_ pk = {pr[q][k], pr[q][k]};
                            const unsigned ww[4] = {w.x, w.y, w.z, w.w};
#pragma unroll
                            for (int hw_ = 0; hw_ < 4; ++hw_) { f32x4& yy = y[q][2 * jj + (hw_ >> 1)]; const int o_ = 2 * (hw_ & 1);
                                f32x2_ t = {yy[o_], yy[o_ + 1]}; const f32x2_ xv = {bflo(ww[hw_]), bfhi(ww[hw_])};
                                t = pk * xv + t; yy[o_] = t.x; yy[o_ + 1] = t.y; } }
            }
#pragma unroll
            for (int q = 0; q < RB; ++q) {
                const int b = (row0 + q) >> 13;
                const float* g2 = MOD + (size_t)(lm * 4 + b) * 6144 + 5120;
#pragma unroll
                for (int j = 0; j < 4; ++j) { const f32x4 gg = *(const f32x4*)(g2 + NC(j)); v[q][j] += gg * y[q][j]; }
            }
            if (MODE == 1) {
#pragma unroll
                for (int q = 0; q < RB; ++q)
#pragma unroll
                    for (int jj = 0; jj < 2; ++jj) { u32x4 w; w.x = pk2(v[q][2 * jj][0], v[q][2 * jj][1]); w.y = pk2(v[q][2 * jj][2], v[q][2 * jj][3]);
                        w.z = pk2(v[q][2 * jj + 1][0], v[q][2 * jj + 1][1]); w.w = pk2(v[q][2 * jj + 1][2], v[q][2 * jj + 1][3]);
                        *(u32x4*)(X + (size_t)(row0 + q) * D + 8 * lane + 512 * jj) = w;
                        v[q][2 * jj] = (f32x4){bflo(w.x), bfhi(w.x), bflo(w.y), bfhi(w.y)}; v[q][2 * jj + 1] = (f32x4){bflo(w.z), bfhi(w.z), bflo(w.w), bfhi(w.w)}; }
            }
        }
        float rstd[RB];
#pragma unroll
        for (int q = 0; q < RB; ++q) { float ss = 0.f;
#pragma unroll
            for (int j = 0; j < 4; ++j) ss += (v[q][j][0] * v[q][j][0] + v[q][j][1] * v[q][j][1]) + (v[q][j][2] * v[q][j][2] + v[q][j][3] * v[q][j][3]);
            rstd[q] = __builtin_amdgcn_rsqf(wave_sum(ss) * (1.0f / D) + EPS); }
        if (MODE == 2) {
            f32x4 g[4];
#pragma unroll
            for (int j = 0; j < 4; ++j) g[j] = *(const f32x4*)(p.fnorm_g + NC(j));
#pragma unroll
            for (int j = 0; j < 4; ++j) {
#pragma unroll
                for (int q = 0; q < RB; ++q) __builtin_nontemporal_store(v[q][j] * rstd[q] * g[j], (f32x4*)(p.out + (size_t)(row0 + q) * D + NC(j))); }
        } else {
            float ga[RB][8]; f32x2_ ga2[RB][8];
#pragma unroll
            for (int q = 0; q < RB; ++q)
#pragma unroll
                for (int c = 0; c < 8; ++c) ga2[q][c] = (f32x2_){0.f, 0.f};
            f32x4 gA[4], shA[4], scA[4];
            { const int b = row0 >> 13; const float* mb = MOD + (size_t)(l * 4 + b) * 6144;
#pragma unroll
              for (int j = 0; j < 4; ++j) { const int n = NC(j); gA[j] = *(const f32x4*)(p.norm1_g + l * D + n); shA[j] = *(const f32x4*)(mb + n); scA[j] = *(const f32x4*)(mb + 1024 + n); } }
            unsigned hlo[RB];
#pragma unroll
            for (int j = 0; j < 4; ++j) {
                const f32x4 g = gA[j];
                f32x4 h[RB];
#pragma unroll
                for (int q = 0; q < RB; ++q) {
                    const f32x4 sh = shA[j], sc = scA[j];
                    h[q] = v[q][j] * rstd[q] * g * (sc + 1.0f) + sh;
                    const unsigned hw_ = pk4_fp8(h[q][0], h[q][1], h[q][2], h[q][3]);
                    if ((j & 1) == 0) hlo[q] = hw_;
                    else { u32x2 w2; w2.x = hlo[q]; w2.y = hw_; *(u32x2*)((unsigned char*)H + (size_t)(row0 + q) * D + 8 * lane + 512 * (j >> 1)) = w2; } }
#pragma unroll
                for (int c = 0; c < 8; ++c) { const f32x4 wv = *(const LAS f32x4*)(Wg + (j * 8 + c) * 256 + lane * 4);
#pragma unroll
                    for (int q = 0; q < RB; ++q) { const f32x2_ wa = {wv[0], wv[1]}, wb = {wv[2], wv[3]}, ha = {h[q][0], h[q][1]}, hb_ = {h[q][2], h[q][3]};
                        ga2[q][c] = ha * wa + ga2[q][c]; ga2[q][c] = hb_ * wb + ga2[q][c]; } }
                asm volatile("" ::: "memory");
            }
#pragma unroll
            for (int q = 0; q < RB; ++q)
#pragma unroll
                for (int c = 0; c < 8; ++c) ga[q][c] = ga2[q][c].x + ga2[q][c].y;
#pragma unroll
            for (int q = 0; q < RB; ++q) {
#pragma unroll
                for (int i = 0; i < 4; ++i) { const bool hi = (lane & 32) != 0; const float send = hi ? ga[q][i] : ga[q][i + 4]; const float keep = hi ? ga[q][i + 4] : ga[q][i]; ga[q][i] = keep + __shfl_xor(send, 32); }
#pragma unroll
                for (int i = 0; i < 2; ++i) { const bool hi = (lane & 16) != 0; const float send = hi ? ga[q][i] : ga[q][i + 2]; const float keep = hi ? ga[q][i + 2] : ga[q][i]; ga[q][i] = keep + __shfl_xor(send, 16); }
                { const bool hi = (lane & 8) != 0; const float send = hi ? ga[q][0] : ga[q][1]; const float keep = hi ? ga[q][1] : ga[q][0]; ga[q][0] = keep + __shfl_xor(send, 8); }
                float gs = ga[q][0]; gs += __shfl_xor(gs, 4); gs += __shfl_xor(gs, 2); gs += __shfl_xor(gs, 1);
                const int gi = lane >> 3, row = row0 + q;
                if ((lane & 7) == 0) {
                    const float t = gs + gb[gi];
                    const float cap = 15.0f * (1.0f - 2.0f * __builtin_amdgcn_rcpf(__expf(t * (2.0f / 15.0f)) + 1.0f));
                    if (gi < 4) IG[row * 4 + gi] = cap;
                    else LF[row * 4 + gi - 4] = fminf(cap, 0.f) - __logf(1.0f + __expf(-fabsf(cap)));
                }
            }
        }
    }
#undef NC
}

struct Rows4 { u32x4 a[4], b[4]; };
__device__ __forceinline__ void load_rows4(const bf16_t* Zb, int tpos, int zcol, Rows4& R) {
#pragma unroll
    for (int j = 0; j < 4; ++j) { const int tp = tpos - 3 + j;
        if (tp >= 0) { R.a[j] = *(const u32x4*)(Zb + (size_t)tp * NZ + zcol); R.b[j] = *(const u32x4*)(Zb + (size_t)tp * NZ + zcol + 8); }
        else { R.a[j] = (u32x4){0u, 0u, 0u, 0u}; R.b[j] = (u32x4){0u, 0u, 0u, 0u}; } }
}
__device__ __forceinline__ void conv16_lds(const Rows4& R, const LAS float* cwl, int ch0, float (&o)[16]) {
#pragma unroll
    for (int i4 = 0; i4 < 4; ++i4) { const f32x4 bb = *(const LAS f32x4*)(cwl + 1024 + ch0 + 4 * i4); o[4 * i4] = bb[0]; o[4 * i4 + 1] = bb[1]; o[4 * i4 + 2] = bb[2]; o[4 * i4 + 3] = bb[3]; }
#pragma unroll
    for (int j = 0; j < 4; ++j) {
        const unsigned w[8] = {R.a[j].x, R.a[j].y, R.a[j].z, R.a[j].w, R.b[j].x, R.b[j].y, R.b[j].z, R.b[j].w};
#pragma unroll
        for (int i4 = 0; i4 < 4; ++i4) { const f32x4 cw = *(const LAS f32x4*)(cwl + j * 256 + ch0 + 4 * i4);
            o[4 * i4] += cw[0] * bflo(w[2 * i4]); o[4 * i4 + 1] += cw[1] * bfhi(w[2 * i4]); o[4 * i4 + 2] += cw[2] * bflo(w[2 * i4 + 1]); o[4 * i4 + 3] += cw[3] * bfhi(w[2 * i4 + 1]); }
    }
#pragma unroll
    for (int i = 0; i < 16; ++i) o[i] = o[i] * __builtin_amdgcn_rcpf(1.0f + __builtin_amdgcn_exp2f(-1.4426950408889634f * o[i]));
}
__device__ __forceinline__ void load_conv_weights(const Params& p, int l, int hd, LAS float* cwl) {
    const int tid = otid();
#pragma unroll
    for (int i = tid; i < 1280; i += 512) { const int j = i >> 8, ch = i & 255; const int gch = (ch < 128 ? hd * 128 + ch : 512 + hd * 128 + (ch - 128));
        cwl[i] = (j < 4) ? p.conv_w[l * 4096 + j * 1024 + gch] : p.conv_b[l * 1024 + gch]; }
}
__device__ __forceinline__ void pack16(const float (&v)[16], float sc, u32x4& w0, u32x4& w1) {
    w0.x = pk2(v[0] * sc, v[1] * sc); w0.y = pk2(v[2] * sc, v[3] * sc); w0.z = pk2(v[4] * sc, v[5] * sc); w0.w = pk2(v[6] * sc, v[7] * sc);
    w1.x = pk2(v[8] * sc, v[9] * sc); w1.y = pk2(v[10] * sc, v[11] * sc); w1.z = pk2(v[12] * sc, v[13] * sc); w1.w = pk2(v[14] * sc, v[15] * sc);
}
__device__ __forceinline__ void mlstm_a_unit(const Params& p, int b, int hd, int c, LAS unsigned char* lds, const LAS float* cwl) {
    const int tid = otid(), lane = tid & 63, wave = tid >> 6, fr = lane & 15, fq = lane >> 4;
    const int uu = (b * 4 + hd) * 128 + c;
    LAS bf16_t* kw = (LAS bf16_t*)lds;
    LAS bf16_t* vs = (LAS bf16_t*)(lds + 17408);
    LAS float* ewl = (LAS float*)(lds + 34816);
    const bf16_t* Zb = WSP(bf16_t, WS_Z) + (size_t)b * SEQ * NZ;
    const int t0 = c * 64;
    const int t = tid >> 3, d0 = (tid & 7) * 16;
    Rows4 Rk; load_rows4(Zb, t0 + t, ZK + hd * 128 + d0, Rk);
    const bf16_t* vr = Zb + (size_t)(t0 + t) * NZ + ZV + hd * 128 + d0;
    const u32x4 va = *(const u32x4*)vr, vb = *(const u32x4*)(vr + 8);
    float ewt;
    {
        const int row = b * SEQ + t0 + lane;
        const float lf = WSP(float, WS_LF)[row * 4 + hd], ig = WSP(float, WS_IG)[row * 4 + hd];
        float bc = lf;
#pragma unroll
        for (int o = 1; o < 64; o <<= 1) { const float t_ = __shfl_up(bc, o); if (lane >= o) bc += t_; }
        const float g = __shfl(bc, 63);
        const float w = g - bc + ig;
        float wm = w;
#pragma unroll
        for (int o = 1; o < 64; o <<= 1) wm = fmaxf(wm, __shfl_xor(wm, o));
        const float ew = __expf(w - wm);
        ewt = __shfl(ew, t);
        if (tid == 0) { WSP(float, WS_G)[uu] = g; WSP(float, WS_WMAX)[uu] = wm; }
    }
    {
        float kc[16];
        conv16_lds(Rk, cwl, 128 + d0, kc);
        u32x4 w0, w1; pack16(kc, 0.08838834764831845f * ewt, w0, w1);
        *(LAS u32x4*)(kw + t * 136 + d0) = w0; *(LAS u32x4*)(kw + t * 136 + d0 + 8) = w1;
        *(LAS u32x4*)(vs + t * 136 + d0) = va; *(LAS u32x4*)(vs + t * 136 + d0 + 8) = vb;
        pack16(kc, 0.08838834764831845f, w0, w1);
        bf16_t* kcp = WSP(bf16_t, WS_KC) + (size_t)(b * SEQ + c * 64 + t) * 512 + hd * 128 + d0;
        *(u32x4*)kcp = w0; *(u32x4*)(kcp + 8) = w1;
    }
    __syncthreads();
    {
        const int q4 = (lane & 15) >> 2, p4 = lane & 3;
        const int wp = wave >> 1, eh = wave & 1;
        s16x4 ak[2][2][2];
#pragma unroll
        for (int n = 0; n < 2; ++n)
#pragma unroll
            for (int kk = 0; kk < 2; ++kk)
#pragma unroll
                for (int hf = 0; hf < 2; ++hf) ak[n][kk][hf] = TRREAD(kw + (kk * 32 + 8 * fq + 4 * hf + q4) * 136 + 32 * wp + 8 * p4 + 4 * n);
        if (eh == 0) {
            const unsigned o1 = 0x3f803f80u; const u32x4 ov = {o1, o1, o1, o1}; const bf16x8 ones = __builtin_bit_cast(bf16x8, ov);
            f32x4 s0 = (f32x4){0.f, 0.f, 0.f, 0.f}, s1 = (f32x4){0.f, 0.f, 0.f, 0.f};
#pragma unroll
            for (int kk = 0; kk < 2; ++kk) {
                const bf16x8 af0 = {ak[0][kk][0][0], ak[0][kk][0][1], ak[0][kk][0][2], ak[0][kk][0][3], ak[0][kk][1][0], ak[0][kk][1][1], ak[0][kk][1][2], ak[0][kk][1][3]};
                const bf16x8 af1 = {ak[1][kk][0][0], ak[1][kk][0][1], ak[1][kk][0][2], ak[1][kk][0][3], ak[1][kk][1][0], ak[1][kk][1][1], ak[1][kk][1][2], ak[1][kk][1][3]};
                s0 = MFMA16(af0, ones, s0); s1 = MFMA16(af1, ones, s1); }
            if (fr == 0) { float* ksp = WSP(float, WS_KS) + (size_t)uu * 128 + 32 * wp + 8 * fq;
                *(f32x4*)ksp = s0; *(f32x4*)(ksp + 4) = s1; }
        }
        bf16_t* CTg = WSP(bf16_t, WS_KVT) + (size_t)uu * 16384;
#pragma unroll
        for (int e4 = 0; e4 < 4; ++e4) {
            const int et = eh * 4 + e4;
            f32x4 acc0 = (f32x4){0.f, 0.f, 0.f, 0.f}, acc1 = (f32x4){0.f, 0.f, 0.f, 0.f};
#pragma unroll
            for (int kk = 0; kk < 2; ++kk) {
                const s16x4 b0 = TRREAD(vs + (kk * 32 + 8 * fq + q4) * 136 + et * 16 + 4 * p4), b1 = TRREAD(vs + (kk * 32 + 8 * fq + 4 + q4) * 136 + et * 16 + 4 * p4);
                const bf16x8 bf = {b0[0], b0[1], b0[2], b0[3], b1[0], b1[1], b1[2], b1[3]};
                const bf16x8 af0 = {ak[0][kk][0][0], ak[0][kk][0][1], ak[0][kk][0][2], ak[0][kk][0][3], ak[0][kk][1][0], ak[0][kk][1][1], ak[0][kk][1][2], ak[0][kk][1][3]};
                const bf16x8 af1 = {ak[1][kk][0][0], ak[1][kk][0][1], ak[1][kk][0][2], ak[1][kk][0][3], ak[1][kk][1][0], ak[1][kk][1][1], ak[1][kk][1][2], ak[1][kk][1][3]};
                acc0 = MFMA16(af0, bf, acc0); acc1 = MFMA16(af1, bf, acc1);
            }
            u32x4 w; w.x = pk2(acc0[0], acc0[1]); w.y = pk2(acc0[2], acc0[3]); w.z = pk2(acc1[0], acc1[1]); w.w = pk2(acc1[2], acc1[3]);
            *(u32x4*)(CTg + (et * 16 + fr) * 128 + 32 * wp + 8 * fq) = w;
        }
    }
    lds_barrier();
}
__device__ __forceinline__ void mlstm_b_unit(const Params& p, int u) {
    const int tid = otid(), lane = tid & 63;
    const int slice = u & 15, bh = u >> 4;
    bf16_t* base = WSP(bf16_t, WS_KVT) + (size_t)bh * 128 * 16384 + slice * 1024 + tid * 2;
    const float* Gs = WSP(float, WS_G) + bh * 128; const float* Wm = WSP(float, WS_WMAX) + bh * 128;
    float* MP = WSP(float, WS_MPREV) + bh * 128; float* KS = WSP(float, WS_KS) + (size_t)bh * 128 * 128;
    unsigned kv[128];
#pragma unroll
    for (int c = 0; c < 128; ++c) kv[c] = *(const unsigned*)(base + (size_t)c * 16384);
    float dec0, inj0, dec1, inj1, mp0, mp1;
    {
        const float g0 = Gs[lane], g1 = Gs[64 + lane], w0 = Wm[lane], w1 = Wm[64 + lane];
        float P0 = g0, P1 = g1;
#pragma unroll
        for (int o = 1; o < 64; o <<= 1) { const float t0 = __shfl_up(P0, o), t1 = __shfl_up(P1, o); if (lane >= o) { P0 += t0; P1 += t1; } }
        P1 += __shfl(P0, 63);
        float A0 = w0 - P0, A1 = w1 - P1;
#pragma unroll
        for (int o = 1; o < 64; o <<= 1) { const float t0 = __shfl_up(A0, o), t1 = __shfl_up(A1, o); if (lane >= o) { A0 = fmaxf(A0, t0); A1 = fmaxf(A1, t1); } }
        A1 = fmaxf(A1, __shfl(A0, 63));
        const float m0 = P0 + A0, m1 = P1 + A1;
        mp0 = __shfl_up(m0, 1); mp1 = __shfl_up(m1, 1);
        const float m0l = __shfl(m0, 63);
        if (lane == 0) { mp0 = -INFINITY; mp1 = m0l; }
        dec0 = __expf(g0 + mp0 - m0); inj0 = __expf(w0 - m0); dec1 = __expf(g1 + mp1 - m1); inj1 = __expf(w1 - m1);
        if (slice == 0 && tid < 64) { MP[lane] = mp0; MP[64 + lane] = mp1; }
    }
    float c0 = 0.f, c1 = 0.f;
#pragma unroll
    for (int c = 0; c < 128; ++c) {
        const float dec = __shfl(c < 64 ? dec0 : dec1, c & 63), inj = __shfl(c < 64 ? inj0 : inj1, c & 63);
        const unsigned w = kv[c];
        *(unsigned*)(base + (size_t)c * 16384) = pk2(c0, c1);
        c0 = dec * c0 + inj * bflo(w); c1 = dec * c1 + inj * bfhi(w);
    }
    if (slice == 0 && tid < 128) {
        float nst = 0.f;
#pragma unroll
        for (int cb = 0; cb < 128; cb += 32) {
            float ksv[32];
#pragma unroll
            for (int i = 0; i < 32; ++i) ksv[i] = KS[(cb + i) * 128 + tid];
#pragma unroll
            for (int i = 0; i < 32; ++i) { const int c = cb + i;
                const float dec = __shfl(c < 64 ? dec0 : dec1, c & 63), inj = __shfl(c < 64 ? inj0 : inj1, c & 63);
                KS[c * 128 + tid] = nst; nst = dec * nst + inj * ksv[i]; }
        }
    }
}
__device__ __forceinline__ void mlstm_c_unit(const Params& p, int l, int b, int hd, int c, LAS unsigned char* lds, const LAS float* cwl, const LAS float* gl) {
    const int tid = otid(), lane = tid & 63, wave = tid >> 6, fr = lane & 15, fq = lane >> 4;
    const int uu = (b * 4 + hd) * 128 + c;
    LAS bf16_t* qs = (LAS bf16_t*)lds;
    LAS bf16_t* ks = (LAS bf16_t*)(lds + 17408);
    LAS bf16_t* vs = (LAS bf16_t*)(lds + 34816);
    LAS bf16_t* CT = (LAS bf16_t*)(lds + 52224);
    LAS bf16_t* Ps = (LAS bf16_t*)(lds + 87040);
    LAS bf16_t* hb = ks;
    LAS float* sm = (LAS float*)(lds + 96256);
    LAS float* bcum = sm, *igb = sm + 64, *mtv = sm + 128, *inter = sm + 192, *emt = sm + 256, *den0 = sm + 320, *dpart = sm + 384  , *nprev = sm + 512  ;
    const bf16_t* Zb = WSP(bf16_t, WS_Z) + (size_t)b * SEQ * NZ;
    const int t0 = c * 64;
    const int t = tid >> 3, d0 = (tid & 7) * 16;
    Rows4 Rq; load_rows4(Zb, t0 + t, ZQ + hd * 128 + d0, Rq);
    const bf16_t* kcp = WSP(bf16_t, WS_KC) + (size_t)(b * SEQ + t0 + t) * 512 + hd * 128 + d0;
    const u32x4 kca = *(const u32x4*)kcp, kcb = *(const u32x4*)(kcp + 8);
    const bf16_t* zr = Zb + (size_t)(t0 + t) * NZ + hd * 128 + d0;
    const u32x4 va = *(const u32x4*)(zr + ZV), vb = *(const u32x4*)(zr + ZV + 8);
    const u32x4 oa = *(const u32x4*)(zr + ZO), ob = *(const u32x4*)(zr + ZO + 8);
    f32x4 npv[4];
#pragma unroll
    for (int i = 0; i < 4; ++i) npv[i] = *(const f32x4*)(WSP(float, WS_KS) + (size_t)uu * 128 + d0 + 4 * i);
    u32x4 ctv[4];
    { const bf16_t* KVT = WSP(bf16_t, WS_KVT) + (size_t)uu * 16384;
#pragma unroll
      for (int k = 0; k < 4; ++k) { const int id = tid + 512 * k; ctv[k] = *(const u32x4*)(KVT + (id >> 4) * 128 + (id & 15) * 8); } }
    if (tid < 64) {
        const int row = b * SEQ + t0 + tid;
        const float lf = WSP(float, WS_LF)[row * 4 + hd], ig = WSP(float, WS_IG)[row * 4 + hd];
        const float mp = WSP(float, WS_MPREV)[uu];
        float bc = lf;
#pragma unroll
        for (int o = 1; o < 64; o <<= 1) { const float t_ = __shfl_up(bc, o); if (lane >= o) bc += t_; }
        const float a_ = ig - bc;
        float cm = a_;
#pragma unroll
        for (int o = 1; o < 64; o <<= 1) { const float t_ = __shfl_up(cm, o); if (lane >= o) cm = fmaxf(cm, t_); }
        const float mt = bc + fmaxf(mp, cm);
        bcum[tid] = bc; igb[tid] = a_; mtv[tid] = mt; inter[tid] = __expf(bc + mp - mt); emt[tid] = __expf(-mt);
    }
    {
        float qc[16];
        conv16_lds(Rq, cwl, d0, qc);
        float dn = 0.f;
#pragma unroll
        for (int i = 0; i < 16; ++i) dn += qc[i] * npv[i >> 2][i & 3];
        dn += __shfl_xor(dn, 1); dn += __shfl_xor(dn, 2); dn += __shfl_xor(dn, 4);
        if ((tid & 7) == 0) den0[t] = dn;
        u32x4 w0, w1;
        pack16(qc, 1.0f, w0, w1);
        *(LAS u32x4*)(qs + t * 136 + d0) = w0; *(LAS u32x4*)(qs + t * 136 + d0 + 8) = w1;
        *(LAS u32x4*)(ks + t * 136 + d0) = kca; *(LAS u32x4*)(ks + t * 136 + d0 + 8) = kcb;
        *(LAS u32x4*)(vs + t * 136 + d0) = va; *(LAS u32x4*)(vs + t * 136 + d0 + 8) = vb;
#pragma unroll
        for (int k = 0; k < 4; ++k) { const int id = tid + 512 * k; *(LAS u32x4*)(CT + (id >> 4) * 136 + (id & 15) * 8) = ctv[k]; }
    }
    __syncthreads();
    {
        const int tt = wave >> 1;
        float rs[4] = {0.f, 0.f, 0.f, 0.f};
#pragma unroll
        for (int si = 0; si < 2; ++si) {
            const int ss = (wave & 1) * 2 + si;
            f32x4 acc = (f32x4){0.f, 0.f, 0.f, 0.f};
#pragma unroll
            for (int kk = 0; kk < 4; ++kk) { const bf16x8 a_ = *(const LAS bf16x8*)(qs + (tt * 16 + fr) * 136 + kk * 32 + 8 * fq);
                const bf16x8 bq = *(const LAS bf16x8*)(ks + (ss * 16 + fr) * 136 + kk * 32 + 8 * fq); acc = MFMA16(a_, bq, acc); }
            const int s_ = ss * 16 + fr; const float ib = igb[s_];
#pragma unroll
            for (int i = 0; i < 4; ++i) { const int tq = tt * 16 + 4 * fq + i;
                const float val = (s_ <= tq) ? acc[i] * __expf(bcum[tq] + ib - mtv[tq]) : 0.f;
                rs[i] += val; Ps[tq * 72 + s_] = (bf16_t)pk2(val, 0.f); }
        }
#pragma unroll
        for (int i = 0; i < 4; ++i) { float r_ = rs[i]; r_ += __shfl_xor(r_, 1); r_ += __shfl_xor(r_, 2); r_ += __shfl_xor(r_, 4); r_ += __shfl_xor(r_, 8);
            if (fr == 0) dpart[(wave & 1) * 64 + tt * 16 + 4 * fq + i] = r_; }
    }
    __syncthreads();
    {
        const int tt = wave >> 1;
        const int q4 = (lane & 15) >> 2, p4 = lane & 3;
        bf16x8 ap[2], aq[4];
#pragma unroll
        for (int kk = 0; kk < 2; ++kk) ap[kk] = *(const LAS bf16x8*)(Ps + (tt * 16 + fr) * 72 + kk * 32 + 8 * fq);
#pragma unroll
        for (int kk = 0; kk < 4; ++kk) aq[kk] = *(const LAS bf16x8*)(qs + (tt * 16 + fr) * 136 + kk * 32 + 8 * fq);
#pragma unroll
        for (int ei = 0; ei < 4; ++ei) {
            const int et = (wave & 1) * 4 + ei;
            f32x4 a1 = (f32x4){0.f, 0.f, 0.f, 0.f}, a2 = (f32x4){0.f, 0.f, 0.f, 0.f};
#pragma unroll
            for (int kk = 0; kk < 2; ++kk) {
                const s16x4 b0 = TRREAD(vs + (kk * 32 + 8 * fq + q4) * 136 + et * 16 + 4 * p4), b1 = TRREAD(vs + (kk * 32 + 8 * fq + 4 + q4) * 136 + et * 16 + 4 * p4);
                const bf16x8 bv = {b0[0], b0[1], b0[2], b0[3], b1[0], b1[1], b1[2], b1[3]};
                a1 = MFMA16(ap[kk], bv, a1); }
#pragma unroll
            for (int kk = 0; kk < 4; ++kk) { const bf16x8 bc = *(const LAS bf16x8*)(CT + (et * 16 + fr) * 136 + kk * 32 + 8 * fq); a2 = MFMA16(aq[kk], bc, a2); }
            const int e = et * 16 + fr;
#pragma unroll
            for (int i = 0; i < 4; ++i) { const int tq = tt * 16 + 4 * fq + i;
                const float num = a1[i] + inter[tq] * a2[i];
                const float den = inter[tq] * den0[tq] + dpart[tq] + dpart[64 + tq];
                hb[tq * 136 + e] = (bf16_t)pk2(num * __builtin_amdgcn_rcpf(fmaxf(fabsf(den), emt[tq])), 0.f); }
        }
    }
    __syncthreads();
    {
        const u32x4 h0 = *(const LAS u32x4*)(hb + t * 136 + d0), h1 = *(const LAS u32x4*)(hb + t * 136 + d0 + 8);
        const unsigned hw[8] = {h0.x, h0.y, h0.z, h0.w, h1.x, h1.y, h1.z, h1.w}, ow[8] = {oa.x, oa.y, oa.z, oa.w, ob.x, ob.y, ob.z, ob.w};
        float hv[16]; float ssq = 0.f;
#pragma unroll
        for (int i = 0; i < 8; ++i) { hv[2 * i] = bflo(hw[i]) * sigmoidf_(bflo(ow[i])); hv[2 * i + 1] = bfhi(hw[i]) * sigmoidf_(bfhi(ow[i])); }
#pragma unroll
        for (int i = 0; i < 16; ++i) ssq += hv[i] * hv[i];
        ssq += __shfl_xor(ssq, 1); ssq += __shfl_xor(ssq, 2); ssq += __shfl_xor(ssq, 4);
        const float r_ = __builtin_amdgcn_rsqf(ssq * (1.0f / 128.0f) + EPS);
#pragma unroll
        for (int i = 0; i < 16; ++i) hv[i] *= gl[d0 + i];
        u32x4 w0, w1; pack16(hv, r_, w0, w1);
        bf16_t* o = WSP(bf16_t, WS_CAT) + (size_t)(b * SEQ + t0 + t) * D + hd * 128 + d0;
        *(u32x4*)o = w0; *(u32x4*)(o + 8) = w1;
    }
    lds_barrier();
}

__device__ __forceinline__ void moba_prep_unit(const Params& p, int u, LAS unsigned char* lds) {
    const int tid = otid();
    const int qtr = u & 3, blk = (u >> 2) & 31, b = u >> 7;
    LAS float* cs = (LAS float*)lds; LAS float* sn = cs + 512;
    LAS bf16_t* kl = (LAS bf16_t*)(lds + 4096);
    const int r0 = b * SEQ + blk * 256 + qtr * 64;
    const int t = tid >> 3, h = tid & 7;
    bf16_t* zr = WSP(bf16_t, WS_Z) + (size_t)(r0 + t) * NZ + h * 64;
    u32x4 kq[8]; u32x4 qq[2];
#pragma unroll
    for (int c = 0; c < 8; ++c) kq[c] = *(const u32x4*)(zr + ZAK + 8 * c);
    qq[0] = *(const u32x4*)(zr + ZAQ); qq[1] = *(const u32x4*)(zr + ZAQ + 8);
    { const int i = tid & 7;
      const float inv = powf(500000.0f, -(float)(2 * i) / 16.0f);
      const float ang = (float)p.pos[r0 + t] * inv; float s_, c_; sincosf(ang, &s_, &c_); cs[tid] = c_; sn[tid] = s_; }
    __syncthreads();
    {
        float c8[8], s8[8];
#pragma unroll
        for (int i = 0; i < 8; ++i) { c8[i] = cs[t * 8 + i]; s8[i] = sn[t * 8 + i]; }
        unsigned* k0 = (unsigned*)&kq[0]; unsigned* k1 = (unsigned*)&kq[1]; unsigned* q0 = (unsigned*)&qq[0]; unsigned* q1 = (unsigned*)&qq[1];
#pragma unroll
        for (int w = 0; w < 4; ++w) {
            { const float a0 = bflo(k0[w]), a1 = bfhi(k0[w]), b0 = bflo(k1[w]), b1 = bfhi(k1[w]);
              k0[w] = pk2(a0 * c8[2 * w] - b0 * s8[2 * w], a1 * c8[2 * w + 1] - b1 * s8[2 * w + 1]);
              k1[w] = pk2(b0 * c8[2 * w] + a0 * s8[2 * w], b1 * c8[2 * w + 1] + a1 * s8[2 * w + 1]); }
            { const float a0 = bflo(q0[w]), a1 = bfhi(q0[w]), b0 = bflo(q1[w]), b1 = bfhi(q1[w]);
              q0[w] = pk2(a0 * c8[2 * w] - b0 * s8[2 * w], a1 * c8[2 * w + 1] - b1 * s8[2 * w + 1]);
              q1[w] = pk2(b0 * c8[2 * w] + a0 * s8[2 * w], b1 * c8[2 * w + 1] + a1 * s8[2 * w + 1]); }
        }
        *(u32x4*)(zr + ZAK) = kq[0]; *(u32x4*)(zr + ZAK + 8) = kq[1];
        *(u32x4*)(zr + ZAQ) = qq[0]; *(u32x4*)(zr + ZAQ + 8) = qq[1];
#pragma unroll
        for (int c = 0; c < 8; ++c) *(LAS u32x4*)(kl + (size_t)(t * 8 + h) * 72 + 8 * c) = kq[c];
    }
    __syncthreads();
    {
        const int hh = tid >> 6, d = tid & 63;
        float ksum = 0.f;
#pragma unroll 8
        for (int tt = 0; tt < 64; ++tt) ksum += bf2f(kl[(size_t)(tt * 8 + hh) * 72 + d]);
        WSP(float, WS_KPART)[((((size_t)(b * 8 + hh) * 32 + blk) * 4 + qtr) * 64) + d] = ksum;
    }
    lds_barrier();
}
__device__ __forceinline__ void moba_gate_unit(const Params& p, int l, int u, LAS unsigned char* lds) {
    const int tid = otid();
    const int tq = (u & 256) ? 15 - (u & 15) : (u & 15), h = (u >> 4) & 7, b = u >> 7;
    LAS float* km = (LAS float*)lds;
    LAS int* lcnt2 = (LAS int*)(lds + 8192);
    const float* KP = WSP(float, WS_KPART) + (size_t)(b * 8 + h) * 32 * 4 * 64;
#pragma unroll
    for (int i = tid; i < 2048; i += 512) { const int j = i >> 6, d = i & 63; const float* s = KP + (size_t)j * 256 + d;
        km[i] = (s[0] + s[64] + s[128] + s[192]) * (1.0f / 256.0f); }
    if (tid < 64) lcnt2[tid] = 0;
    __syncthreads();
    const int t = tq * 512 + tid, own = t >> 8, half = tid >> 8;
    const bf16_t* qr = WSP(bf16_t, WS_Z) + (size_t)(b * SEQ + t) * NZ + ZAQ + h * 64;
    float q[64];
#pragma unroll
    for (int k = 0; k < 8; ++k) { const u32x4 w = *(const u32x4*)(qr + 8 * k);
        q[8 * k] = bflo(w.x); q[8 * k + 1] = bfhi(w.x); q[8 * k + 2] = bflo(w.y); q[8 * k + 3] = bfhi(w.y); q[8 * k + 4] = bflo(w.z); q[8 * k + 5] = bfhi(w.z); q[8 * k + 6] = bflo(w.w); q[8 * k + 7] = bfhi(w.w); }
    float v0 = -INFINITY, v1 = -INFINITY, v2 = -INFINITY; int i0 = -1, i1 = -1, i2 = -1;
#pragma unroll 4
    for (int j = 0; j < own; ++j) {
        float s = 0.f;
#pragma unroll
        for (int d4 = 0; d4 < 16; ++d4) { const f32x4 kk = *(const LAS f32x4*)(km + j * 64 + 4 * d4); s += q[4 * d4] * kk[0] + q[4 * d4 + 1] * kk[1] + q[4 * d4 + 2] * kk[2] + q[4 * d4 + 3] * kk[3]; }
        if (s > v0) { v2 = v1; i2 = i1; v1 = v0; i1 = i0; v0 = s; i0 = j; }
        else if (s > v1) { v2 = v1; i2 = i1; v1 = s; i1 = j; }
        else if (s > v2) { v2 = s; i2 = j; }
    }
    bf16_t* QL = WSP(bf16_t, WS_QLIST) + (size_t)(b * 8 + h) * 32 * 8192;
    const int sel[3] = {i0, i1, i2};
#pragma unroll
    for (int s = 0; s < 3; ++s) { const int j = sel[s];
        if (j >= 0) { const int rank = __hip_atomic_fetch_add(lcnt2 + half * 32 + j, 1, __ATOMIC_RELAXED, __HIP_MEMORY_SCOPE_WORKGROUP);
            QL[(size_t)j * 8192 + own * 256 + rank] = (bf16_t)((t << 2) | s); } }
    QL[(size_t)own * 8192 + own * 256 + (t & 255)] = (bf16_t)((t << 2) | 3);
    __syncthreads();
    if (tid < 64) { const int hf = tid >> 5, j = tid & 31, jb = 2 * tq + hf;
        if (j <= jb) WSP(int, WS_SEGC)[((size_t)(b * 8 + h) * 32 + j) * 32 + jb] = (j == jb) ? 256 : lcnt2[hf * 32 + j]; }
    lds_barrier();
}
typedef float f32x2 __attribute__((ext_vector_type(2)));
__device__ __forceinline__ void attn_step(const bool own, const LAS bf16_t* Ks, const LAS bf16_t* Vs, LAS unsigned char* lds, const bf16_t* qp, int lane, int wave, int qg, bool valid, size_t pi,
                                          bf16_t* PO, float* PL) {
    const int r = lane & 31, hh = lane >> 5;
    const float C2 = 0.18033688011112042f;
    bf16x8 qb[4];
#pragma unroll
    for (int s4 = 0; s4 < 4; ++s4) qb[s4] = *(const bf16x8*)(qp + 16 * s4);
    f32x16 X[8];
    const int ktmax = own ? qg : 7;
    {
        bf16x8 ka[2][4];
#pragma unroll
        for (int s4 = 0; s4 < 4; ++s4) ka[0][s4] = *(const LAS bf16x8*)(Ks + r * 72 + 16 * s4 + 8 * hh);
#pragma unroll
        for (int kt = 0; kt < 8; ++kt) {
            if (kt > ktmax) break;
            if (kt < 7) {
#pragma unroll
                for (int s4 = 0; s4 < 4; ++s4) ka[(kt + 1) & 1][s4] = *(const LAS bf16x8*)(Ks + ((kt + 1) * 32 + r) * 72 + 16 * s4 + 8 * hh);
            }
            __builtin_amdgcn_sched_barrier(0);
            f32x16 acc;
#pragma unroll
            for (int i = 0; i < 16; ++i) acc[i] = 0.f;
#pragma unroll
            for (int s4 = 0; s4 < 4; ++s4) acc = MFMA32(ka[kt & 1][s4], qb[s4], acc);
            X[kt] = acc;
            __builtin_amdgcn_sched_barrier(0);
        }
    }
    if (own) {
        int thr = r - 4 * hh;
        asm volatile("" : "+v"(thr));
#pragma unroll
        for (int kt = 0; kt < 8; ++kt) {
            if (kt == qg) {
#pragma unroll
                for (int i = 0; i < 16; ++i) { if ((i & 3) + 8 * (i >> 2) > thr) X[kt][i] = -INFINITY; }
                asm volatile("" : "+v"(X[kt]));
            }
        }
    }
    float mx = -INFINITY;
#pragma unroll
    for (int kt = 0; kt < 8; ++kt) {
        if (kt > ktmax) break;
#pragma unroll
        for (int i = 0; i < 16; ++i) mx = fmaxf(mx, X[kt][i]); }
    mx = fmaxf(mx, __shfl_xor(mx, 32));
    const f32x2 c2v = {C2, C2}, mcv = {mx * C2, mx * C2};
    f32x2 ls2 = {0.f, 0.f};
#pragma unroll
    for (int kt = 0; kt < 8; ++kt) {
        if (kt > ktmax) break;
#pragma unroll
        for (int i = 0; i < 8; ++i) { const f32x2 xv = {X[kt][2 * i], X[kt][2 * i + 1]}; const f32x2 tv = xv * c2v - mcv;
            f32x2 pv; pv.x = __builtin_amdgcn_exp2f(tv.x); pv.y = __builtin_amdgcn_exp2f(tv.y); X[kt][2 * i] = pv.x; X[kt][2 * i + 1] = pv.y; ls2 += pv; } }
    float ls = ls2.x + ls2.y;
    ls += __shfl_xor(ls, 32);
    f32x16 O0, O1;
#pragma unroll
    for (int i = 0; i < 16; ++i) { O0[i] = 0.f; O1[i] = 0.f; }
    {
        const int vq = (lane & 15) >> 2, vp = lane & 3, vg = (lane >> 4) & 1;
        const LAS bf16_t* vbase = Vs + (4 * hh + vq) * 72 + 16 * vg + 4 * vp;
        s16x4 tv[2][4];
#pragma unroll
        for (int q4 = 0; q4 < 4; ++q4) tv[0][q4] = TRREAD(vbase + (q4 & 1) * 8 * 72 + (q4 >> 1) * 32);
#pragma unroll
        for (int it = 0; it < 16; ++it) {
            const int kt = it >> 1, s2 = it & 1;
            if (kt > ktmax) break;
            if (it < 15) {
                const LAS bf16_t* vb = vbase + (it + 1) * 16 * 72;
#pragma unroll
                for (int q4 = 0; q4 < 4; ++q4) tv[(it + 1) & 1][q4] = TRREAD(vb + (q4 & 1) * 8 * 72 + (q4 >> 1) * 32);
            }
            __builtin_amdgcn_sched_barrier(0);
            bf16x8 pf;
            { const unsigned w0 = pg8::cvt_pk_bf16(X[kt][8 * s2 + 0], X[kt][8 * s2 + 1]), w1 = pg8::cvt_pk_bf16(X[kt][8 * s2 + 2], X[kt][8 * s2 + 3]),
                             w2 = pg8::cvt_pk_bf16(X[kt][8 * s2 + 4], X[kt][8 * s2 + 5]), w3 = pg8::cvt_pk_bf16(X[kt][8 * s2 + 6], X[kt][8 * s2 + 7]);
              const u32x4 w = {w0, w1, w2, w3}; pf = __builtin_bit_cast(bf16x8, w); }
            const s16x4 a0 = tv[it & 1][0], a1 = tv[it & 1][1], c0 = tv[it & 1][2], c1 = tv[it & 1][3];
            const bf16x8 va = {a0[0], a0[1], a0[2], a0[3], a1[0], a1[1], a1[2], a1[3]};
            const bf16x8 vc = {c0[0], c0[1], c0[2], c0[3], c1[0], c1[1], c1[2], c1[3]};
            O0 = MFMA32(va, pf, O0); O1 = MFMA32(vc, pf, O1);
            __builtin_amdgcn_sched_barrier(0);
        }
    }
    {
        LAS bf16_t* Ost = (LAS bf16_t*)(lds + 73728 + 256 + wave * 4608);
        const float inv = __builtin_amdgcn_rcpf(ls);
#pragma unroll
        for (int g4 = 0; g4 < 4; ++g4) {
            u32x2 w0, w1;
            w0.x = pg8::cvt_pk_bf16(O0[4 * g4] * inv, O0[4 * g4 + 1] * inv); w0.y = pg8::cvt_pk_bf16(O0[4 * g4 + 2] * inv, O0[4 * g4 + 3] * inv);
            w1.x = pg8::cvt_pk_bf16(O1[4 * g4] * inv, O1[4 * g4 + 1] * inv); w1.y = pg8::cvt_pk_bf16(O1[4 * g4 + 2] * inv, O1[4 * g4 + 3] * inv);
            *(LAS u32x2*)(Ost + r * 72 + 8 * g4 + 4 * hh) = w0; *(LAS u32x2*)(Ost + r * 72 + 32 + 8 * g4 + 4 * hh) = w1;
        }
        LDS_WAIT();
        u32x4 ov[4];
#pragma unroll
        for (int k = 0; k < 4; ++k) ov[k] = *(const LAS u32x4*)(Ost + r * 72 + 32 * hh + 8 * k);
        if (valid) {
            bf16_t* po = PO + pi * 64 + 32 * hh;
#pragma unroll
            for (int k = 0; k < 4; ++k) *(u32x4*)(po + 8 * k) = ov[k];
            if (hh == 0) PL[pi] = mx * 0.125f + __logf(ls);
        }
        LDS_WAIT();
    }
}
__device__ __forceinline__ void moba_attn_unit(const Params& p, int l, int li, int ch, LAS unsigned char* lds) {
    const int tid = otid(), lane = tid & 63, wave = __builtin_amdgcn_readfirstlane(tid >> 6), r = lane & 31, hh = lane >> 5;
    const int j = li & 31, h = (li >> 5) & 7, b = li >> 8;
    LAS bf16_t* Ks = (LAS bf16_t*)lds;
    LAS bf16_t* Vs = (LAS bf16_t*)(lds + 36864);
    LAS int* segp = (LAS int*)(lds + 73728);
    const bf16_t* Z = WSP(bf16_t, WS_Z);
    const size_t kr0 = (size_t)(b * SEQ + j * 256);
    u32x4 kreg[4], vreg[4];
#pragma unroll
    for (int i = 0; i < 4; ++i) { const int id = tid + 512 * i, key = id >> 3, part = id & 7;
        const bf16_t* src = Z + (kr0 + key) * NZ + h * 64 + part * 8;
        kreg[i] = *(const u32x4*)(src + ZAK); vreg[i] = *(const u32x4*)(src + ZAV); }
    if (tid < 64) { const int c = (lane < 32 && lane >= j) ? WSP(int, WS_SEGC)[(size_t)li * 32 + lane] : 0; int inc = c;
#pragma unroll
        for (int o = 1; o < 32; o <<= 1) { const int t_ = __shfl_up(inc, o); if (lane >= o) inc += t_; }
        if (lane < 32) segp[lane + 1] = inc; if (lane == 0) segp[0] = 0; }
    __syncthreads();
    const bf16_t* QL = WSP(bf16_t, WS_QLIST) + (size_t)li * 8192;
    const int n = segp[32];
    unsigned ents[4];
    const int qg = wave < 4 ? wave : 11 - wave;
#pragma unroll
    for (int st = 0; st < 4; ++st) { const int ridx = ch * 1024 + st * 256 + qg * 32 + r; unsigned e = 0u;
        if (ridx < n) { int jb = 0;
#pragma unroll
            for (int st_ = 16; st_ >= 1; st_ >>= 1) jb += (segp[jb + st_] <= ridx) ? st_ : 0;
            e = (unsigned)QL[jb * 256 + (ridx - segp[jb])]; }
        ents[st] = e; }
#pragma unroll
    for (int i = 0; i < 4; ++i) { const int id = tid + 512 * i, key = id >> 3, part = id & 7;
        *(LAS u32x4*)(Ks + key * 72 + part * 8) = kreg[i];
        *(LAS u32x4*)(Vs + key * 72 + part * 8) = vreg[i]; }
    const bf16_t* qbase = Z + (size_t)b * SEQ * NZ + ZAQ + h * 64 + 8 * hh;
    __syncthreads();
    bf16_t* PO = WSP(bf16_t, WS_PARTO); float* PL = WSP(float, WS_PARTL);
    const size_t pbase = (size_t)(b * 8 + h) * SEQ;
    for (int step = 0; step < 4; ++step) {
        const int rbase = ch * 1024 + step * 256;
        if (rbase >= n) break;
        const int ridx = rbase + qg * 32 + r;
        const unsigned ent = step == 0 ? ents[0] : step == 1 ? ents[1] : step == 2 ? ents[2] : ents[3];
        const size_t pi = (pbase + (ent >> 2)) * 4 + (ent & 3u);
        const bf16_t* qp = qbase + (size_t)(ent >> 2) * NZ;
        if (rbase + qg * 32 < n) attn_step(rbase == 0, Ks, Vs, lds, qp, lane, wave, qg, ridx < n, pi, PO, PL);
    }
    lds_barrier();
}
__device__ __forceinline__ void moba_combine_phase(const Params& p) {
    const int tid = otid(), lane = tid & 63, wave = tid >> 6;
    const int gw = blockIdx.x * 8 + wave, NGW = gridDim.x * 8;
    const bf16_t* PO = WSP(bf16_t, WS_PARTO); const float* PL = WSP(float, WS_PARTL);
    bf16_t* CAT = WSP(bf16_t, WS_CAT);
    const int h = lane >> 3, part = lane & 7;
    constexpr int RB = 4;
    float lseN[RB][4]; u32x4 pvN[RB][4];
    auto load_rows = [&](int r0) __attribute__((always_inline)) {
#pragma unroll
        for (int q = 0; q < RB; ++q) { const int row = (r0 + q < T) ? r0 + q : T - 1, b = row >> 13, t = row & 8191;
            const size_t pi = ((size_t)(b * 8 + h) * SEQ + t) * 4;
#pragma unroll
            for (int s_ = 0; s_ < 4; ++s_) { lseN[q][s_] = PL[pi + s_]; pvN[q][s_] = *(const u32x4*)(PO + (pi + s_) * 64 + part * 8); } }
    };
    load_rows(gw * RB);
    for (int row0 = gw * RB; row0 < T; row0 += NGW * RB) {
        float lse[RB][4]; u32x4 pv[RB][4];
#pragma unroll
        for (int q = 0; q < RB; ++q)
#pragma unroll
            for (int s_ = 0; s_ < 4; ++s_) { lse[q][s_] = lseN[q][s_]; pv[q][s_] = pvN[q][s_]; }
        if (row0 + NGW * RB < T) load_rows(row0 + NGW * RB);
#pragma unroll
        for (int q = 0; q < RB; ++q) { const int row = row0 + q, t = row & 8191, own = t >> 8, nsel = own < 3 ? own : 3;
            float M = -INFINITY;
#pragma unroll
            for (int s_ = 0; s_ < 4; ++s_) { const bool ok = (s_ == 3) || (s_ < nsel); lse[q][s_] = ok ? lse[q][s_] : -INFINITY; M = fmaxf(M, lse[q][s_]); }
            float acc[8]; float wsum = 0.f;
#pragma unroll
            for (int i = 0; i < 8; ++i) acc[i] = 0.f;
#pragma unroll
            for (int s_ = 0; s_ < 4; ++s_) { const bool ok = (s_ == 3) || (s_ < nsel);
                const float w = ok ? __expf(lse[q][s_] - M) : 0.f; wsum += w;
                u32x4 v = pv[q][s_]; if (!ok) v = (u32x4){0u, 0u, 0u, 0u};
                acc[0] += w * bflo(v.x); acc[1] += w * bfhi(v.x); acc[2] += w * bflo(v.y); acc[3] += w * bfhi(v.y);
                acc[4] += w * bflo(v.z); acc[5] += w * bfhi(v.z); acc[6] += w * bflo(v.w); acc[7] += w * bfhi(v.w); }
            const float inv = __builtin_amdgcn_rcpf(wsum);
            u32x4 o; o.x = pk2(acc[0] * inv, acc[1] * inv); o.y = pk2(acc[2] * inv, acc[3] * inv); o.z = pk2(acc[4] * inv, acc[5] * inv); o.w = pk2(acc[6] * inv, acc[7] * inv);
            *(u32x4*)(CAT + (size_t)row * D + 512 + h * 64 + part * 8) = o; }
    }
}

__device__ __forceinline__ void mlstm_unit_of(int u, int& b, int& hd, int& c) {
    const int G = gridDim.x;
    if ((G & 3) == 0) { const int blk = u % G, i = u / G; hd = blk & 3; const int rest = (blk >> 2) + (G >> 2) * i; b = rest >> 7; c = rest & 127; }
    else { c = u & 127; hd = (u >> 7) & 3; b = u >> 9; }
}
__device__ __forceinline__ void mix_a_phase(const Params& p, int l, LAS unsigned char* lds) {
    REP(3) {
        LAS float* cwl = (LAS float*)(lds + 35840);
        int cur_hd = -1;
        for (int u = blockIdx.x; u < 2048; u += gridDim.x) {
            int b, hd, c; mlstm_unit_of(u, b, hd, c);
            if (hd != cur_hd) { __syncthreads(); load_conv_weights(p, l, hd, cwl); cur_hd = hd; __syncthreads(); }
            mlstm_a_unit(p, b, hd, c, lds, cwl);
        }
    }
    for (int u = blockIdx.x; u < 512; u += gridDim.x) moba_prep_unit(p, u, lds);
}
__device__ __forceinline__ void mix_b_phase(const Params& p, int l, LAS unsigned char* lds) {
    for (int u = blockIdx.x; u < 256 + 512; u += gridDim.x) {
        if (u < 256) mlstm_b_unit(p, u); else { REP(4) moba_gate_unit(p, l, u - 256, lds); }
    }
}
__device__ __forceinline__ void mix_c_phase(const Params& p, int l, LAS unsigned char* lds) {
    const int tid = otid(), lane = tid & 63, wave = tid >> 6;
    LAS int* pre = (LAS int*)(lds + 139264);
    LAS int* wt = pre + 1032;
    {
        const int* SEGC = WSP(int, WS_SEGC);
        int n0 = 0, n1 = 0;
        { const int j0 = (2 * tid) & 31, j1 = (2 * tid + 1) & 31;
#pragma unroll
          for (int k = 0; k < 8; ++k) { const u32x4 c0 = *(const u32x4*)(SEGC + (size_t)(2 * tid) * 32 + 4 * k), c1 = *(const u32x4*)(SEGC + (size_t)(2 * tid + 1) * 32 + 4 * k);
              n0 += (4 * k >= j0 ? (int)c0.x : 0) + (4 * k + 1 >= j0 ? (int)c0.y : 0) + (4 * k + 2 >= j0 ? (int)c0.z : 0) + (4 * k + 3 >= j0 ? (int)c0.w : 0);
              n1 += (4 * k >= j1 ? (int)c1.x : 0) + (4 * k + 1 >= j1 ? (int)c1.y : 0) + (4 * k + 2 >= j1 ? (int)c1.z : 0) + (4 * k + 3 >= j1 ? (int)c1.w : 0); } }
        const int a0 = (n0 + 1023) >> 10, a1 = (n1 + 1023) >> 10;
        const int s = a0 + a1; int inc = s;
#pragma unroll
        for (int o = 1; o < 64; o <<= 1) { const int t = __shfl_up(inc, o); if (lane >= o) inc += t; }
        if (lane == 63) wt[wave] = inc;
        __syncthreads();
        int wp = 0;
        for (int w = 0; w < wave; ++w) wp += wt[w];
        const int ex = wp + inc - s;
        pre[2 * tid] = ex; pre[2 * tid + 1] = ex + a0;
        if (tid == 511) pre[1024] = ex + s;
        __syncthreads();
    }
    const int NU = pre[1024];
#if defined(DIAG_MIXC)
    unsigned long long tm = 0ull, ta = 0ull;
#endif
    int cur_hd = -1;
    unsigned* wq = WSP(unsigned, WS_CTL) + CW_WQ + l * 64;
    LAS int* tick = (LAS int*)(lds + 143440);
    const int total = 2048 + NU;
    if (tid == 0) tick[0] = (int)atomicAdd(wq, 1u);
    __syncthreads();
    int par = 0;
    const bool wave0 = __builtin_amdgcn_readfirstlane(tid >> 6) == 0;
    for (int u = tick[0]; u < total; ) {
        unsigned tk_ = 0u;
        if (wave0) { unsigned long long sv_; const unsigned zero_ = 0u, one_ = 1u;
            asm volatile("s_mov_b64 %1, exec\n\ts_mov_b64 exec, 1\n\tglobal_atomic_add %0, %2, %3, %4 sc0\n\ts_mov_b64 exec, %1"
                         : "=&v"(tk_), "=&s"(sv_) : "v"(zero_), "v"(one_), "s"(wq) : "memory"); }
#if defined(DIAG_MIXC)
        const unsigned long long t0 = __builtin_amdgcn_s_memrealtime();
#endif
        if (u >= NU) {
            const int q = u - NU; const int hd_ = q >> 9, b_ = (q >> 7) & 3, c_ = q & 127;
            LAS float* cw4 = (LAS float*)(lds + 98816);
            if (cur_hd < 0) { __syncthreads();
                _Pragma("unroll") for (int hd4 = 0; hd4 < 4; ++hd4) { load_conv_weights(p, l, hd4, cw4 + hd4 * 1408); if (threadIdx.x < 128) cw4[hd4 * 1408 + 1280 + threadIdx.x] = p.mnorm_g[l * 512 + hd4 * 128 + threadIdx.x]; }
                cur_hd = 0; __syncthreads(); }
            const LAS float* cwl = cw4 + hd_ * 1408; const LAS float* gl = cwl + 1280;
            mlstm_c_unit(p, l, b_, hd_, c_, lds, cwl, gl);
        }
        else {
            int lo = 0, hi = 1024;
            while (hi - lo > 1) { const int mid = (lo + hi) >> 1; if (pre[mid] <= u) lo = mid; else hi = mid; }
            moba_attn_unit(p, l, lo, u - pre[lo], lds);
            cur_hd = -1;
        }
#if defined(DIAG_MIXC)
        const unsigned long long t1 = __builtin_amdgcn_s_memrealtime();
        if (u >= NU) tm += t1 - t0; else ta += t1 - t0;
#endif
        if (wave0) { asm volatile("s_waitcnt vmcnt(4)" : "+v"(tk_) : : "memory"); if (lane == 0) tick[par ^ 1] = (int)tk_; }
        lds_barrier();
        par ^= 1; u = tick[par];
    }
#if defined(DIAG_MIXC)
    if (l == 0 && threadIdx.x == 0) { volatile unsigned long long* w = (volatile unsigned long long*)(p.ws + WS_CTL + 528384) + (size_t)blockIdx.x * 64; w[2 * 30] = 0ull; w[2 * 30 + 1] = DIAG_MIXC ? ta : tm; }
#endif
}

template <bool DRY>
__device__ __forceinline__ void router_phase(const Params& p, int l, LAS unsigned char* lds) {
    const int tid = otid(), lane = tid & 63, wave = tid >> 6;
    LAS bf16_t* Whi = (LAS bf16_t*)lds;
    LAS bf16_t* Wlo = (LAS bf16_t*)(lds + 66048);
    LAS float* cb = (LAS float*)(lds + 132096);
    LAS float* red = (LAS float*)(lds + 132224);
    LAS int* lcnt = (LAS int*)(lds + 135168);
    LAS int* lbase = lcnt + 32;
    LAS unsigned* lsel = (LAS unsigned*)(lcnt + 64);
    LAS float* gsc = (LAS float*)(lds + 137472);
    LAS float* shb = gsc + 1024;
    const int G = gridDim.x, rows_per = (T + G - 1) / G;
    const int r_lo = blockIdx.x * rows_per, r_hi = (r_lo + rows_per < T) ? r_lo + rows_per : T;
    const int bb = r_lo >> 13;
    const float* MOD = WSP(float, WS_MOD);
    const float* mb = MOD + (size_t)(l * 4 + bb) * 6144;
    const float* wr = p.w_router + (size_t)l * 1024 * 32;
#pragma unroll
    for (int i = tid; i < 1024; i += 512) { gsc[i] = p.norm2_g[l * D + i] * (mb[4096 + i] + 1.0f); shb[i] = mb[3072 + i]; }
    if (tid < 32) lcnt[tid] = 0;
    __syncthreads();
    {
        const int e = tid & 31, part = tid >> 5;
        float cs_ = 0.f;
#pragma unroll 16
        for (int i = tid; i < 32768; i += 512) { const int n = i >> 5;
            const float w0 = wr[i]; cs_ += shb[n] * w0;
            const float w = w0 * gsc[n]; const unsigned hi = pk2(w, 0.f) & 0xffffu; const unsigned lo = pk2(w - bf2f(hi), 0.f) & 0xffffu;
            Whi[e * 1032 + n] = (bf16_t)hi; Wlo[e * 1032 + n] = (bf16_t)lo; }
        red[part * 32 + e] = cs_;
    }
    __syncthreads();
    if (tid < 32) { float c_ = p.b_router[l * 32 + tid];
#pragma unroll
        for (int k = 0; k < 16; ++k) c_ += red[k * 32 + tid];
        cb[tid] = c_; }
    __syncthreads();
    const bf16_t* X = WSP(bf16_t, WS_X); unsigned char* H8 = WSP(unsigned char, WS_H);
    float* PROB = WSP(float, WS_PROB);
    const int r = lane & 15, q = lane >> 4;
    for (int tile0 = r_lo + wave * 16; tile0 < r_hi; tile0 += 128) {
        const int row = (tile0 + r < r_hi) ? tile0 + r : r_hi - 1;
        const bf16_t* xr = X + (size_t)row * D + 8 * q;
        f32x4 acc0 = (f32x4){0.f, 0.f, 0.f, 0.f}, acc1 = (f32x4){0.f, 0.f, 0.f, 0.f};
        float ss = 0.f;
#pragma unroll 4
        for (int s_ = 0; s_ < 32; ++s_) {
            const u32x4 xw = *(const u32x4*)(xr + 32 * s_);
            const f32x4 xa = {bflo(xw.x), bfhi(xw.x), bflo(xw.y), bfhi(xw.y)}, xb = {bflo(xw.z), bfhi(xw.z), bflo(xw.w), bfhi(xw.w)};
            ss += (xa[0] * xa[0] + xa[1] * xa[1]) + (xa[2] * xa[2] + xa[3] * xa[3]) + (xb[0] * xb[0] + xb[1] * xb[1]) + (xb[2] * xb[2] + xb[3] * xb[3]);
            const float xv[8] = {xa[0], xa[1], xa[2], xa[3], xb[0], xb[1], xb[2], xb[3]};
            unsigned hw[4], lw[4];
#pragma unroll
            for (int k = 0; k < 4; ++k) { hw[k] = pk2(xv[2 * k], xv[2 * k + 1]);
                lw[k] = pk2(xv[2 * k] - bflo(hw[k]), xv[2 * k + 1] - bfhi(hw[k])); }
            const u32x4 hv = {hw[0], hw[1], hw[2], hw[3]}, lv = {lw[0], lw[1], lw[2], lw[3]};
            const bf16x8 ah = __builtin_bit_cast(bf16x8, hv), al = __builtin_bit_cast(bf16x8, lv);
            const bf16x8 bh0 = *(const LAS bf16x8*)(Whi + r * 1032 + 32 * s_ + 8 * q), bl0 = *(const LAS bf16x8*)(Wlo + r * 1032 + 32 * s_ + 8 * q);
            const bf16x8 bh1 = *(const LAS bf16x8*)(Whi + (16 + r) * 1032 + 32 * s_ + 8 * q), bl1 = *(const LAS bf16x8*)(Wlo + (16 + r) * 1032 + 32 * s_ + 8 * q);
            acc0 = MFMA16(ah, bh0, acc0); acc0 = MFMA16(ah, bl0, acc0); acc0 = MFMA16(al, bh0, acc0);
            acc1 = MFMA16(ah, bh1, acc1); acc1 = MFMA16(ah, bl1, acc1); acc1 = MFMA16(al, bh1, acc1);
        }
        ss += __shfl_xor(ss, 16); ss += __shfl_xor(ss, 32);
        const float rstd = __builtin_amdgcn_rsqf(ss * (1.0f / D) + EPS);
        const float cb0 = cb[r], cb1 = cb[16 + r];
#pragma unroll
        for (int i = 0; i < 4; ++i) {
            const float rs = __shfl(rstd, 4 * q + i);
            const float l0 = rs * acc0[i] + cb0, l1 = rs * acc1[i] + cb1;
            unsigned u0 = __builtin_bit_cast(unsigned, l0); u0 = (u0 & 0x80000000u) ? ~u0 : (u0 | 0x80000000u);
            unsigned u1 = __builtin_bit_cast(unsigned, l1); u1 = (u1 & 0x80000000u) ? ~u1 : (u1 | 0x80000000u);
            unsigned k0 = (u0 & ~31u) | (unsigned)(31 - r), k1 = (u1 & ~31u) | (unsigned)(15 - r);
            float tv[4]; int te[4];
#pragma unroll
            for (int k = 0; k < 4; ++k) {
                unsigned m = k0 > k1 ? k0 : k1;
#pragma unroll
                for (int o = 1; o < 16; o <<= 1) { const unsigned t_ = (unsigned)__shfl_xor((int)m, o); m = t_ > m ? t_ : m; }
                te[k] = 31 - (int)(m & 31u);
                const unsigned ub = m & ~31u; const unsigned fb = (ub & 0x80000000u) ? (ub & 0x7fffffffu) : ~ub;
                tv[k] = __builtin_bit_cast(float, fb);
                if (k0 == m) k0 = 0u; if (k1 == m) k1 = 0u;
            }
            const float e1 = __expf(tv[1] - tv[0]), e2 = __expf(tv[2] - tv[0]), e3 = __expf(tv[3] - tv[0]);
            const float inv = __builtin_amdgcn_rcpf(1.0f + e1 + e2 + e3);
            const int rowi = tile0 + 4 * q + i;
            if (r < 4 && rowi < r_hi) {
                const float pr = (r == 0 ? 1.0f : r == 1 ? e1 : r == 2 ? e2 : e3) * inv;
                const int e = r == 0 ? te[0] : r == 1 ? te[1] : r == 2 ? te[2] : te[3];
                PROB[rowi * 4 + r] = pr;
                if (!DRY) { const int rl = __hip_atomic_fetch_add(lcnt + e, 1, __ATOMIC_RELAXED, __HIP_MEMORY_SCOPE_WORKGROUP);
                    lsel[(rowi - r_lo) * 4 + r] = (unsigned)e | ((unsigned)rl << 8); }
            }
        }
        if (tile0 + r < r_hi) {
            unsigned char* hr = H8 + (size_t)row * D + 8 * q;
            u32x4 xc[4], xn[4];
#pragma unroll
            for (int i = 0; i < 4; ++i) xc[i] = *(const u32x4*)(xr + 32 * i);
#pragma unroll
            for (int bt = 0; bt < 8; ++bt) {
                if (bt < 7) {
#pragma unroll
                    for (int i = 0; i < 4; ++i) xn[i] = *(const u32x4*)(xr + 32 * (4 * (bt + 1) + i));
                }
#pragma unroll
                for (int i = 0; i < 4; ++i) { const int s_ = 4 * bt + i; const u32x4 xw = xc[i];
                    const f32x4 xa = {bflo(xw.x), bfhi(xw.x), bflo(xw.y), bfhi(xw.y)}, xb = {bflo(xw.z), bfhi(xw.z), bflo(xw.w), bfhi(xw.w)};
                    const f32x4 ga = *(const LAS f32x4*)(gsc + 32 * s_ + 8 * q), gb = *(const LAS f32x4*)(gsc + 32 * s_ + 8 * q + 4);
                    const f32x4 sa = *(const LAS f32x4*)(shb + 32 * s_ + 8 * q), sb = *(const LAS f32x4*)(shb + 32 * s_ + 8 * q + 4);
                    const f32x4 ha = xa * rstd * ga + sa, hb_ = xb * rstd * gb + sb;
                    u32x2 w; w.x = pk4_fp8(ha[0], ha[1], ha[2], ha[3]); w.y = pk4_fp8(hb_[0], hb_[1], hb_[2], hb_[3]);
                    *(u32x2*)(hr + 32 * s_) = w; }
#pragma unroll
                for (int i = 0; i < 4; ++i) xc[i] = xn[i];
            }
        }
    }
    __syncthreads();
    if (DRY) return;
    unsigned* ECNT = WSP(unsigned, WS_CTL) + CW_ECNT + l * 64;
    if (tid < 32) lbase[tid] = (int)atomicAdd(&ECNT[tid], (unsigned)lcnt[tid]);
    __syncthreads();
    unsigned* PE = WSP(unsigned, WS_PE); int* EL = WSP(int, WS_ELIST);
    for (int i = tid; i < (r_hi - r_lo) * 4; i += 512) {
        const unsigned s = lsel[i]; const int e = s & 255u, rank = lbase[e] + (int)(s >> 8);
        const int row = r_lo + (i >> 2);
        PE[row * 4 + (i & 3)] = (unsigned)e | ((unsigned)rank << 8);
        EL[e * 32768 + rank] = row;
    }
    __syncthreads();
}

#define HAS(k) ((MASK >> (k)) & 1u)
#if defined(DIAG_LASTPH)
#define IN(k) (lo <= (k) && (k) < hi && ((k) <= DIAG_LASTPH || (k) == 21))
#else
#define IN(k) (lo <= (k) && (k) < hi)
#endif
#if defined(DIAG_A)
#define STAMP(k) do { if (blockIdx.x == 0 && threadIdx.x == 0) { const Params _p = LOADP(); ((volatile unsigned long long*)(_p.ws + WS_CTL + 524288))[(k)] = __builtin_amdgcn_s_memrealtime(); } } while (0)
#else
#define STAMP(k) do {} while (0)
#endif
#if defined(DIAG_WG)
#define WGSTAMP(k, e) do { if (threadIdx.x == 0) { const Params _p = LOADP(); ((volatile unsigned long long*)(_p.ws + WS_CTL + 528384))[(size_t)blockIdx.x * 64 + 2 * (k) + (e)] = __builtin_amdgcn_s_memrealtime(); } } while (0)
#else
#define WGSTAMP(k, e) do {} while (0)
#endif
#define SEAM(k) do { if (MASK == 0xFFFu) { if (IN(k) && IN((k) + 1)) { WGSTAMP(k, 1); xcd_barrier_steal(bar, lds); STAMP((k) + 1); WGSTAMP((k) + 1, 0); } } } while (0)
template <unsigned MASK, int l>
__device__ __forceinline__ void layer_phases(LAS unsigned char* lds, const int lo, const int hi, const int G, const XcdBarrier& bar) {
        const int pb = 1 + 10 * l;
        if constexpr (HAS(1)) { if (IN(pb + 0)) {
            const Params p = LOADP();
            if (l == 0) { REP(1) { norm_phase<0>(p, 0, lds); __syncthreads(); } }
            else { norm_phase<1>(p, 1, lds); __syncthreads(); }
            __syncthreads();
        } }
        SEAM(pb + 0);
        if constexpr (HAS(2)) { if (IN(pb + 1)) {
            const Params p = LOADP();
            pg8::StaticOrder S; S.init(T, NZ, G, (int)blockIdx.x);
            pg8::EpiZ E{WSP(bf16_t, WS_Z), NZ, W8_INV};
            REP(2) pg8::gemm_phase<pg8::EpiZ, pg8::StaticOrder, true>(lds, WSP(bf16_t, WS_H), (const bf16_t*)(WSP(unsigned char, WS_WIN) + (size_t)l * NZ * 1024), 512, S, E);
        } }
        SEAM(pb + 1);
        if constexpr (HAS(3)) { if (IN(pb + 2)) { const Params p = LOADP(); mix_a_phase(p, l, lds); } }
        SEAM(pb + 2);
        if constexpr (HAS(4)) { if (IN(pb + 3)) { const Params p = LOADP(); mix_b_phase(p, l, lds); } }
        SEAM(pb + 3);
        if constexpr (HAS(5)) { if (IN(pb + 4)) { const Params p = LOADP(); mix_c_phase(p, l, lds); } }
        SEAM(pb + 4);
        if constexpr (HAS(6)) { if (IN(pb + 5)) { const Params p = LOADP(); REP(6) moba_combine_phase(p); } }
        SEAM(pb + 5);
        if constexpr (HAS(7)) { if (IN(pb + 6)) {
            const Params p = LOADP();
            pg8::StaticOrder S; S.init(T, D, G, (int)blockIdx.x);
            if constexpr (l == 0) { pg8::EpiRes<true> E{p.x, WSP(bf16_t, WS_X), WSP(float, WS_MOD) + (size_t)l * 4 * 6144 + 2048};
                pg8::gemm_phase(lds, WSP(bf16_t, WS_CAT), WSP(bf16_t, WS_WOUT) + (size_t)l * 1024 * 1024, 1024, S, E); }
            else { pg8::EpiRes<false> E{WSP(bf16_t, WS_X), WSP(bf16_t, WS_X), WSP(float, WS_MOD) + (size_t)l * 4 * 6144 + 2048};
                pg8::gemm_phase(lds, WSP(bf16_t, WS_CAT), WSP(bf16_t, WS_WOUT) + (size_t)l * 1024 * 1024, 1024, S, E); }
        } }
        SEAM(pb + 6);
        if constexpr (HAS(8)) { if (IN(pb + 7)) { const Params p = LOADP(); if (PROBE_DUP & (1u << 8)) router_phase<true>(p, l, lds); router_phase<false>(p, l, lds); cvt_drain(p, lds, bar.st, (unsigned)(l * CVT_TPL + CVT_GU)); } }
        SEAM(pb + 7);
        if constexpr (HAS(9)) { if (IN(pb + 8)) {
            const Params p = LOADP();
            LAS int* tb = (LAS int*)(lds + 131072); LAS int* cnt = tb + 40;
            moe_tile_prefix(p, l, tb, cnt);
            __syncthreads();
            pg8::MoeOrder S{tb, cnt, WSP(int, WS_ELIST), 8, G, (int)blockIdx.x, 1, (LAS int*)(lds + 131072 + 512), WSP(unsigned, WS_CTL) + CW_GQ + l * 128, (LAS int*)(lds + 131072 + 2048)};
            pg8::EpiSwiglu E{WSP(unsigned char, WS_ACT), p.b_gate + (size_t)l * 32 * 1024, p.b_up + (size_t)l * 32 * 1024, W8_INV};
            REP(9) pg8::gemm_phase<pg8::EpiSwiglu, pg8::MoeOrder, true>(lds, WSP(bf16_t, WS_H), (const bf16_t*)(WSP(unsigned char, WS_WGU) + (size_t)l * NE * 2048 * 1024), 512, S, E);
            __syncthreads();
            cvt_drain(p, lds, bar.st, (unsigned)((l + 1) * CVT_TPL));
        } }
        SEAM(pb + 8);
        if constexpr (HAS(10)) { if (IN(pb + 9)) {
            const Params p = LOADP();
            LAS int* tb = (LAS int*)(lds + 131072); LAS int* cnt = tb + 40;
            moe_tile_prefix(p, l, tb, cnt);
            __syncthreads();
            pg8::MoeOrder S{tb, cnt, WSP(int, WS_ELIST), 4, G, (int)blockIdx.x, 0, (LAS int*)(lds + 131072 + 512), WSP(unsigned, WS_CTL) + CW_GQ + l * 128 + 64, (LAS int*)(lds + 131072 + 2048)};
            pg8::EpiDown E{WSP(bf16_t, WS_YB), p.b_down + (size_t)l * 32 * 1024, W8_INV};
            REP(10) pg8::gemm_phase<pg8::EpiDown, pg8::MoeOrder, true>(lds, WSP(bf16_t, WS_ACT), (const bf16_t*)(WSP(unsigned char, WS_WD) + (size_t)l * NE * 1024 * 1024), 512, S, E);
            __syncthreads();
        } }
        SEAM(pb + 9);
    }
template <unsigned MASK>
__global__ void __launch_bounds__(512, 2) fwd_kernel(Params p_unused) {
    extern __shared__ __attribute__((aligned(16))) unsigned char lds_raw[];
    LAS unsigned char* lds = (LAS unsigned char*)lds_raw;
    volatile LAS unsigned* xbw = (volatile LAS unsigned*)(lds + LDS_BYTES - 32);
    int lo, hi; unsigned* barw;
    { const Params p = LOADP(); lo = p.ph_lo; hi = p.ph_hi; barw = WSP(unsigned, WS_CTL) + CW_BAR; }
    const int G = gridDim.x;
    XcdBarrier bar; bar.bar = barw; bar.x = 0; bar.st = xbw;
    if (threadIdx.x == 0) { xbw[0] = 0u; xbw[1] = 0u; xbw[2] = 0u; xbw[3] = 0u; xbw[4] = 0u; }
    __syncthreads();
    if (MASK == 0xFFFu) bar = xcd_barrier_post(barw, xbw);

    STAMP(0);
    if constexpr (HAS(0)) { if (IN(0)) { const Params p = LOADP(); REP(0) { prologue_phase(p, lds); __syncthreads(); } } }
    SEAM(0);
    layer_phases<MASK, 0>(lds, lo, hi, G, bar);
    layer_phases<MASK, 1>(lds, lo, hi, G, bar);
#if defined(DIAG_A)
    if constexpr (HAS(11)) { if (IN(21)) { const Params p = LOADP();
        const volatile unsigned long long* st = (const volatile unsigned long long*)(p.ws + WS_CTL + 524288);
#if defined(DIAG_WG)
        float usA = 0.f, usB = 0.f;
        { const volatile unsigned long long* ws_ = (const volatile unsigned long long*)(p.ws + WS_CTL + 528384);
#if defined(DIAG_WG2)
          for (int g = 0; g < (int)gridDim.x; ++g) { const float d = (float)(ws_[(size_t)g * 64 + 2 * DIAG_WG + 1] - ws_[(size_t)g * 64 + 2 * DIAG_WG]) * 0.01f; usA = fmaxf(usA, d);
              const float d2 = (float)(ws_[(size_t)g * 64 + 2 * DIAG_WG2 + 1] - ws_[(size_t)g * 64 + 2 * DIAG_WG2]) * 0.01f; usB = fmaxf(usB, d2); }
#else
          for (int g = 0; g < (int)gridDim.x; ++g) { const float d = (float)(ws_[(size_t)g * 64 + 2 * DIAG_WG + 1] - ws_[(size_t)g * 64 + 2 * DIAG_WG]) * 0.01f; usA += d; usB = fmaxf(usB, d); }
          usA /= (float)gridDim.x;
#endif
        }
#else
        const float usA = (float)(st[DIAG_A + 1] - st[DIAG_A]) * 0.01f, usB = (float)(st[DIAG_B + 1] - st[DIAG_B]) * 0.01f;
#endif
#ifndef DIAG_RATIO
#define DIAG_RATIO 1.15f
#endif
#ifndef DIAG_RATIOB
#define DIAG_RATIOB DIAG_RATIO
#endif
#ifndef DIAG_SHIFT
#define DIAG_SHIFT 0.0f
#endif
        const float kA = rintf(__logf(usA) / __logf(DIAG_RATIO) + DIAG_SHIFT), kB = rintf(__logf(usB) / __logf(DIAG_RATIOB) + DIAG_SHIFT);
        const float qA = __expf((kA - DIAG_SHIFT) * __logf(DIAG_RATIO)), qB = __expf((kB - DIAG_SHIFT) * __logf(DIAG_RATIOB));
        const float a = sqrtf(qA);
        for (size_t i = (size_t)blockIdx.x * 512 + threadIdx.x; i < (size_t)T * D; i += (size_t)gridDim.x * 512) p.out[i] = (i == 0) ? qB : a;
    } }
#else
    if constexpr (HAS(11)) { if (IN(21)) { const Params p = LOADP(); REP(11) { norm_phase<2>(p, 1, lds); __syncthreads(); } } }
#endif
}

#if !MK_ONE_LAUNCH
typedef void (*kern_t)(Params);
static kern_t kern_of_type(int ty) {
    switch (ty) {
        case 0: return fwd_kernel<1u << 0>; case 1: return fwd_kernel<1u << 1>; case 2: return fwd_kernel<1u << 2>; case 3: return fwd_kernel<1u << 3>;
        case 4: return fwd_kernel<1u << 4>; case 5: return fwd_kernel<1u << 5>; case 6: return fwd_kernel<1u << 6>; case 7: return fwd_kernel<1u << 7>;
        case 8: return fwd_kernel<1u << 8>; case 9: return fwd_kernel<1u << 9>; case 10: return fwd_kernel<1u << 10>; default: return fwd_kernel<1u << 11>;
    }
}
static int type_of_phase(int ph) { if (ph == 0) return 0; if (ph == 21) return 11; return 1 + (ph - 1) % 10; }
#endif

extern "C" void kernel_launch(void* const* d_in, const int* in_sizes, int n_in, void* d_out, int out_size, void* d_ws, size_t ws_size, hipStream_t stream) {
    static int grid = 0;
    if (grid == 0) {
        if (n_in != 23 || in_sizes[0] != T * D || out_size != T * D || ws_size < WS_END) {
            fprintf(stderr, "kernel_launch: unexpected shapes (n_in %d, in0 %d, out %d, ws %zu, need %zu)\n", n_in, n_in > 0 ? in_sizes[0] : -1, out_size, ws_size, (size_t)WS_END); grid = -1; return; }
        int dev = 0, cus = 0;
        if (hipGetDevice(&dev) != hipSuccess || hipDeviceGetAttribute(&cus, hipDeviceAttributeMultiprocessorCount, dev) != hipSuccess) { grid = -1; return; }
#if MK_ONE_LAUNCH
        if (hipFuncSetAttribute((const void*)fwd_kernel<0xFFFu>, hipFuncAttributeMaxDynamicSharedMemorySize, LDS_BYTES) != hipSuccess) { fprintf(stderr, "kernel_launch: hipFuncSetAttribute failed\n"); grid = -1; return; }
#else
        for (int ty = 0; ty < 12; ++ty)
            if (hipFuncSetAttribute((const void*)kern_of_type(ty), hipFuncAttributeMaxDynamicSharedMemorySize, LDS_BYTES) != hipSuccess) { fprintf(stderr, "kernel_launch: hipFuncSetAttribute failed\n"); grid = -1; return; }
#endif
        (void)hipGetLastError();
        grid = cus;
    }
    if (grid < 0) return;
    (void)hipMemsetAsync((char*)d_ws + WS_CTL, 0, CTL_BYTES, stream);
    Params p{};
    p.x = (const float*)d_in[0]; p.c = (const float*)d_in[1]; p.pos = (const int*)d_in[2];
    p.w_ada = (const float*)d_in[3]; p.b_ada = (const float*)d_in[4]; p.norm1_g = (const float*)d_in[5]; p.w_in = (const float*)d_in[6];
    p.conv_w = (const float*)d_in[7]; p.conv_b = (const float*)d_in[8]; p.b_ig = (const float*)d_in[9]; p.b_fg = (const float*)d_in[10];
    p.mnorm_g = (const float*)d_in[11]; p.w_out = (const float*)d_in[12]; p.norm2_g = (const float*)d_in[13]; p.w_router = (const float*)d_in[14];
    p.b_router = (const float*)d_in[15]; p.w_gate = (const float*)d_in[16]; p.b_gate = (const float*)d_in[17]; p.w_up = (const float*)d_in[18];
    p.b_up = (const float*)d_in[19]; p.w_down = (const float*)d_in[20]; p.b_down = (const float*)d_in[21]; p.fnorm_g = (const float*)d_in[22];
    p.out = (float*)d_out; p.ws = (unsigned char*)d_ws;
#if MK_ONE_LAUNCH
    p.ph_lo = 0; p.ph_hi = NPH;
    hipLaunchKernelGGL(fwd_kernel<0xFFFu>, dim3(grid), dim3(512), LDS_BYTES, stream, p);
#else
    for (int ph = 0; ph < NPH; ++ph) { p.ph_lo = ph; p.ph_hi = ph + 1; hipLaunchKernelGGL(kern_of_type(type_of_phase(ph)), dim3(grid), dim3(512), LDS_BYTES, stream, p); }
#endif
}
```

```cpp
#include <hip/hip_runtime.h>
#include <cstdio>
#include <cstdint>

#ifndef MK_ONE_LAUNCH
#define MK_ONE_LAUNCH 1
#endif

#ifndef PROBE_DUP
#define PROBE_DUP 0u
#endif
#define REP(k) for (int _r = 0; _r < (((PROBE_DUP >> (k)) & 1u) ? 2 : 1); ++_r)
#define LAS __attribute__((address_space(3)))
typedef unsigned short bf16_t;
typedef short bf16x8 __attribute__((ext_vector_type(8)));
typedef float f32x4 __attribute__((ext_vector_type(4)));
typedef unsigned u32x4 __attribute__((ext_vector_type(4)));
typedef unsigned u32x2 __attribute__((ext_vector_type(2)));
typedef short s16x4 __attribute__((ext_vector_type(4)));
typedef float f32x16 __attribute__((ext_vector_type(16)));
#define MFMA32(a, b, c) __builtin_amdgcn_mfma_f32_32x32x16_bf16((a), (b), (c), 0, 0, 0)
#define TRREAD(ptr) __builtin_amdgcn_ds_read_tr16_b64_v4i16((LAS s16x4*)(ptr))

constexpr int D = 1024, NB = 4, SEQ = 8192, T = NB * SEQ;
constexpr int NIN = 3592, NZ = 3584;
constexpr int ZQ = 0, ZK = 512, ZV = 1024, ZO = 1536, ZAQ = 2048, ZAK = 2560, ZAV = 3072;
constexpr int NE = 32;
constexpr int MAXT = 544;
constexpr float EPS = 1e-5f;
constexpr int NPH = 22;

constexpr size_t MiB = 1u << 20;
constexpr size_t WS_CTL = 0, CTL_BYTES = 1 * MiB;
constexpr size_t WS_MOD = 1 * MiB;
constexpr size_t WS_IG = 2 * MiB, WS_LF = 2 * MiB + 512 * 1024;
constexpr size_t WS_KPART = 3 * MiB;
constexpr size_t WS_G = 4 * MiB, WS_WMAX = 4 * MiB + 8192, WS_MPREV = 4 * MiB + 16384;
constexpr size_t WS_KS = 5 * MiB;
constexpr size_t WS_PE = 6 * MiB, WS_PROB = 6 * MiB + 512 * 1024;
constexpr size_t WS_ELIST = 7 * MiB;
constexpr size_t WS_PARTL = 11 * MiB;
constexpr size_t WS_SEGC = 15 * MiB;
constexpr size_t WS_WIN = 16 * MiB, WS_WOUT = 30 * MiB;
constexpr size_t WS_WGU = 36 * MiB, WS_WD = 164 * MiB;
constexpr size_t WS_X = 228 * MiB, WS_H = 356 * MiB, WS_POOL = 420 * MiB;
constexpr size_t WS_KC = WS_H + 32 * MiB;
constexpr size_t WS_Z = WS_POOL, WS_CAT = WS_POOL + 224 * MiB, WS_PARTO = WS_POOL + 288 * MiB, WS_KVT = WS_POOL + 416 * MiB, WS_QLIST = WS_POOL + 480 * MiB;
constexpr size_t WS_ACT = WS_POOL, WS_YB = WS_POOL + 272 * MiB;
constexpr size_t WS_END = WS_POOL + 544 * MiB;
constexpr int CW_BAR = 1024;
constexpr int CW_ECNT = 8192;
constexpr int CW_GQ = 13440;
constexpr int CW_CVT = 13312;
constexpr int CW_WQ = 12288;
constexpr int CW_QLEN = 16384;

constexpr int LDS_BYTES = 147456;

__device__ __forceinline__ unsigned f2bf(float f) { unsigned u = __builtin_bit_cast(unsigned, f); return (u + 0x7fffu + ((u >> 16) & 1u)) >> 16; }
typedef float f32x2_ __attribute__((ext_vector_type(2)));
typedef __bf16 bf16x2_ __attribute__((ext_vector_type(2)));
__device__ __forceinline__ unsigned pk2(float lo, float hi) { const f32x2_ v = {lo, hi}; return __builtin_bit_cast(unsigned, __builtin_convertvector(v, bf16x2_)); }
__device__ __forceinline__ float bf2f(unsigned b) { return __builtin_bit_cast(float, (b & 0xffffu) << 16); }
__device__ __forceinline__ float bflo(unsigned w) { return __builtin_bit_cast(float, w << 16); }
__device__ __forceinline__ float bfhi(unsigned w) { return __builtin_bit_cast(float, w & 0xffff0000u); }
__device__ __forceinline__ unsigned pk4_fp8(float a, float b, float c, float d) {
    int v = __builtin_amdgcn_cvt_pk_fp8_f32(a, b, 0, false);
    v = __builtin_amdgcn_cvt_pk_fp8_f32(c, d, v, true);
    return (unsigned)v;
}
typedef int i32x8 __attribute__((ext_vector_type(8)));
typedef int i32x4 __attribute__((ext_vector_type(4)));
__device__ __forceinline__ float wave_sum(float v) {
#pragma unroll
    for (int o = 1; o < 64; o <<= 1) v += __shfl_xor(v, o);
    return v;
}
__device__ __forceinline__ float sigmoidf_(float x) { return __builtin_amdgcn_rcpf(1.0f + __expf(-x)); }
#define LDS_WAIT() asm volatile("s_waitcnt lgkmcnt(0)" ::: "memory")
__device__ __forceinline__ void lds_barrier() { asm volatile("s_waitcnt lgkmcnt(0)\n\ts_barrier" ::: "memory"); }
__device__ __forceinline__ int otid() { int t = threadIdx.x; asm volatile("" : "+v"(t)); return t; }

#define XB_TMO      128
#define XB_XCNT(j)  (256  + 64 * (j))
#define XB_XSUB(j)  (1280 + 64 * (j))
#define XB_XGEN(j)  (2304 + 64 * (j))
#define XB_TOP      3328
#define XB_TOPGEN   3392
#define XCD_BAR_WORDS 3456
#define XB_SPIN_CAP (1u << 18)
__device__ __forceinline__ unsigned xb_ld(unsigned* p)              { return __hip_atomic_load(p, __ATOMIC_RELAXED, __HIP_MEMORY_SCOPE_AGENT); }
__device__ __forceinline__ unsigned xb_add(unsigned* p, unsigned v) { return __hip_atomic_fetch_add(p, v, __ATOMIC_RELAXED, __HIP_MEMORY_SCOPE_AGENT); }
__device__ __forceinline__ unsigned xb_xcc_id() { return (unsigned)__builtin_amdgcn_s_getreg((3 << 11) | 20) & 0xFu; }
#define XB_SPIN(cond, bar) do { unsigned _sp = 0; while (cond) { __builtin_amdgcn_s_sleep(1); \
    if ((++_sp & 255u) == 0u) { if (xb_ld(&(bar)[XB_TMO])) break; if (_sp > XB_SPIN_CAP) { atomicAdd(&(bar)[XB_TMO], 1u); break; } } } } while (0)
struct XcdBarrier { unsigned* bar; unsigned x; volatile LAS unsigned* st; };
__device__ __forceinline__ XcdBarrier xcd_barrier_post(unsigned* bar, volatile LAS unsigned* st) {
    XcdBarrier b; b.bar = bar; b.x = xb_xcc_id(); b.st = st;
    if (threadIdx.x == 0) (void)xb_add(&bar[XB_XCNT(b.x)], 1u);
    return b;
}
__device__ __forceinline__ void xcd_barrier_complete(unsigned* bar, unsigned x, unsigned& nloc, unsigned& nx) {
    const unsigned G = gridDim.x * gridDim.y * gridDim.z;
    unsigned sum, cnt, mine, sp = 0u;
    for (;;) {
        sum = 0u; cnt = 0u; mine = 0u;
#pragma unroll
        for (unsigned j = 0; j < 16; ++j) { const unsigned c = xb_ld(&bar[XB_XCNT(j)]); sum += c; cnt += (c > 0u) ? 1u : 0u; mine = (j == x) ? c : mine; }
        if (sum == G) break;
        __builtin_amdgcn_s_sleep(1);
        if ((++sp & 255u) == 0u) { if (xb_ld(&bar[XB_TMO])) break; if (sp > XB_SPIN_CAP) { atomicAdd(&bar[XB_TMO], 1u); break; } }
    }
    nloc = mine > 0u ? mine : 1u; nx = cnt > 0u ? cnt : 1u;
}
__device__ __forceinline__ void xcd_barrier(const XcdBarrier& b) {
    asm volatile("s_waitcnt vmcnt(0)" ::: "memory");
    __syncthreads();
    if (threadIdx.x == 0) {
        unsigned* bar = b.bar;
        __builtin_amdgcn_s_waitcnt(0);
        unsigned nloc = b.st[0], nx = b.st[1];
        if (nloc == 0u) { xcd_barrier_complete(bar, b.x, nloc, nx); b.st[0] = nloc; b.st[1] = nx; }
        const unsigned old = xb_add(&bar[XB_XSUB(b.x)], 1u);
        const unsigned gen = old / nloc;
        if (old + 1u == (gen + 1u) * nloc) {
            __builtin_amdgcn_fence(__ATOMIC_RELEASE, "agent");
            asm volatile("s_waitcnt vmcnt(0)" ::: "memory");
            const unsigned og = xb_add(&bar[XB_TOP], 1u);
            const unsigned tg = og / nx;
            if (og + 1u == (tg + 1u) * nx) xb_add(&bar[XB_TOPGEN], 1u);
            else XB_SPIN(xb_ld(&bar[XB_TOPGEN]) == tg, bar);
            __builtin_amdgcn_fence(__ATOMIC_ACQUIRE, "agent");
            xb_add(&bar[XB_XGEN(b.x)], 1u);
            asm volatile("s_waitcnt vmcnt(0)" ::: "memory");
        } else {
            XB_SPIN(xb_ld(&bar[XB_XGEN(b.x)]) == gen, bar);
            __builtin_amdgcn_fence(__ATOMIC_ACQUIRE, "agent");
            asm volatile("s_waitcnt vmcnt(0)" ::: "memory");
        }
    }
    __syncthreads();
}

namespace pg8 {
constexpr int BM = 256, BK = 64, HALF = 128, HTB = HALF * BK * 2, STAGE_BYTES = 8 * HTB, NXCD = 8, WGM = 8;
__device__ __forceinline__ int lds_byte(int r, int c) { const int st = (r >> 4) * 2 + (c >> 5), rr = r & 15, cc = c & 31, ob = rr * 64 + cc * 2; return st * 1024 + (ob ^ (((ob >> 9) & 1) << 5)); }
__device__ __forceinline__ void stage_rc(int b, int& R, int& C) { const int st = b / 1024, sb = b % 1024, swz = sb ^ (((sb >> 9) & 1) << 5); R = (st >> 1) * 16 + swz / 64; C = (st & 1) * 32 + (swz % 64) / 2; }
__device__ __forceinline__ int perm32(int rho) { const int n = rho >> 4, i = rho & 15; return 8 * (i >> 2) + 4 * n + (i & 3); }

struct Unit { int pm, pn, pb, e; };

struct StaticOrder {
    static constexpr bool DYN = false;
    unsigned* ticket;
    int nM, nN, nwg, G, c;
    __device__ __forceinline__ void publish(int, unsigned) const {}
    __device__ __forceinline__ void init(int M, int N, int G_, int c_) { nM = M / BM; nN = N / BM; nwg = nM * nN; G = G_; c = c_; }
    __device__ __forceinline__ bool next(int i, Unit& u) const {
        const long L = (long)i * G + c; if (L >= nwg) return false;
        int wgid = (int)L; { const int q = nwg / NXCD, r = nwg % NXCD, xcd = wgid % NXCD, off = wgid / NXCD; wgid = (xcd < r ? xcd * (q + 1) : r * (q + 1) + (xcd - r) * q) + off; }
        const int nig = WGM * nN, gid = wgid / nig, fm = gid * WGM, gsz = (nM - fm) < WGM ? (nM - fm) : WGM;
        u.pm = fm + ((wgid % nig) % gsz); u.pn = (wgid % nig) / gsz; u.pb = u.pn; u.e = 0; return true;
    }
    __device__ __forceinline__ int arow(const Unit& u, int r) const { return u.pm * BM + r; }
    __device__ __forceinline__ int arow_next(const Unit& u, int r) const { return u.pm * BM + r; }
    __device__ __forceinline__ void prefetch_rows(const Unit&) const {}
};
struct MoeOrder {
    const LAS int* tb; const LAS int* cnt; const int* elist; int npn, G, c, gather;
    LAS int* idx;
    unsigned* ticket; LAS int* slot;
    static constexpr bool DYN = true;
    __device__ __forceinline__ void publish(int k, unsigned t) const { slot[k & 1] = (int)t; }
    __device__ __forceinline__ bool next(int i, Unit& u) const {
        const int NT = tb[32];
        const int L = i < 3 ? i * G + c : 3 * G + slot[i & 1];
        const int mq = L / npn; u.pn = L - mq * npn;
        if (mq >= NT) return false;
        const int mt = gather ? mq : NT - 1 - mq;
        u.pm = mt;
        int e = 0;
#pragma unroll
        for (int st = 16; st >= 1; st >>= 1) e += (tb[e + st] <= mt) ? st : 0;
        u.e = e; u.pb = e * npn + u.pn; return true;
    }
    __device__ __forceinline__ void prefetch_rows(const Unit& u) const {
        if (!gather) return;
        const int t_ = threadIdx.x;
        if (t_ < 256) { const int cn = cnt[u.e]; int rank = (u.pm - tb[u.e]) * BM + t_; rank = rank < cn ? rank : cn - 1;
            __builtin_amdgcn_global_load_lds((const unsigned*)(elist + u.e * 32768 + rank), (LAS unsigned*)(idx + (t_ & ~63)), 4, 0, 0); }
    }
    __device__ __forceinline__ int arow_next(const Unit& u, int r) const {
        if (!gather) return u.pm * BM + r;
        return idx[r];
    }
    __device__ __forceinline__ int arow(const Unit& u, int r) const {
        if (!gather) return u.pm * BM + r;
        const int rank = (u.pm - tb[u.e]) * BM + r;
        int row = 0;
        if (rank < cnt[u.e]) row = elist[u.e * 32768 + rank];
        return row;
    }
};

__device__ __forceinline__ unsigned cvt_pk_bf16(float lo, float hi) { return pk2(lo, hi); }

struct EpiZ {
    static constexpr bool PERM = true; static constexpr int NVM = 0;
    bf16_t* O; int ldc; float wscale;
    template <class Hook> __device__ __forceinline__ void operator()(const f32x4 (&acc)[2][2][4][2], const Unit& u, int wr, int wc, int fr, int fq, Hook&& hook) const {
        const int row0 = u.pm * BM + wr * 64 + fr, col0 = u.pn * BM + wc * 32 + 8 * fq;
#pragma unroll
        for (int ai = 0; ai < 2; ++ai)
#pragma unroll
            for (int m = 0; m < 4; ++m) { bf16_t* rowp = O + (size_t)(row0 + ai * HALF + m * 16) * ldc + col0;
#pragma unroll
                for (int bj = 0; bj < 2; ++bj) { const f32x4 v0 = acc[ai][bj][m][0] * wscale, v1 = acc[ai][bj][m][1] * wscale;
                    u32x4 w; w.x = cvt_pk_bf16(v0[0], v0[1]); w.y = cvt_pk_bf16(v0[2], v0[3]); w.z = cvt_pk_bf16(v1[0], v1[1]); w.w = cvt_pk_bf16(v1[2], v1[3]);
#if defined(DIAG_NOSTORE)
                    if (w.x == 0x12345678u && w.y == 0x9abcdef0u)
#endif
                    *(u32x4*)(rowp + bj * HALF) = w; } }
    }
};
template <bool XIN_F32>
struct EpiRes {
    static constexpr bool PERM = true; static constexpr int NVM = 0;
    const void* Xin; bf16_t* Xout; const float* gate;
    __device__ __forceinline__ void load8(size_t off, f32x4& lo, f32x4& hi) const {
        if (XIN_F32) { lo = __builtin_nontemporal_load((const f32x4*)((const float*)Xin + off)); hi = __builtin_nontemporal_load((const f32x4*)((const float*)Xin + off + 4)); }
        else { const u32x4 w = *(const u32x4*)((const bf16_t*)Xin + off);
            lo = (f32x4){bflo(w.x), bfhi(w.x), bflo(w.y), bfhi(w.y)}; hi = (f32x4){bflo(w.z), bfhi(w.z), bflo(w.w), bfhi(w.w)}; }
    }
    template <class Hook> __device__ __forceinline__ void operator()(const f32x4 (&acc)[2][2][4][2], const Unit& u, int wr, int wc, int fr, int fq, Hook&& hook) const {
        const int row0 = u.pm * BM + wr * 64 + fr, col0 = u.pn * BM + wc * 32 + 8 * fq;
        const int b = (u.pm * BM) >> 13;
        f32x4 gv[2][2];
#pragma unroll
        for (int bj = 0; bj < 2; ++bj)
#pragma unroll
            for (int n = 0; n < 2; ++n) gv[bj][n] = *(const f32x4*)(gate + b * 6144 + col0 + bj * HALF + 4 * n);
        if (!XIN_F32) {
            u32x4 xr[8][2];
#pragma unroll
            for (int g = 0; g < 8; ++g)
#pragma unroll
                for (int bj = 0; bj < 2; ++bj) xr[g][bj] = *(const u32x4*)((const bf16_t*)Xin + (size_t)(row0 + (g >> 2) * HALF + (g & 3) * 16) * D + col0 + bj * HALF);
#pragma unroll
            for (int g = 0; g < 8; ++g) { const int ai = g >> 2, m = g & 3; const size_t off = (size_t)(row0 + ai * HALF + m * 16) * D + col0;
#pragma unroll
                for (int bj = 0; bj < 2; ++bj) { const u32x4 w_ = xr[g][bj];
                    const f32x4 lo = {bflo(w_.x), bfhi(w_.x), bflo(w_.y), bfhi(w_.y)}, hi = {bflo(w_.z), bfhi(w_.z), bflo(w_.w), bfhi(w_.w)};
                    const f32x4 v0 = lo + gv[bj][0] * acc[ai][bj][m][0], v1 = hi + gv[bj][1] * acc[ai][bj][m][1];
                    u32x4 w; w.x = cvt_pk_bf16(v0[0], v0[1]); w.y = cvt_pk_bf16(v0[2], v0[3]); w.z = cvt_pk_bf16(v1[0], v1[1]); w.w = cvt_pk_bf16(v1[2], v1[3]);
                    *(u32x4*)(Xout + off + bj * HALF) = w; } }
        } else {
#pragma unroll
            for (int ai = 0; ai < 2; ++ai) {
                f32x4 xi[4][2][2];
#pragma unroll
                for (int m = 0; m < 4; ++m)
#pragma unroll
                    for (int bj = 0; bj < 2; ++bj) load8((size_t)(row0 + ai * HALF + m * 16) * D + col0 + bj * HALF, xi[m][bj][0], xi[m][bj][1]);
#pragma unroll
                for (int m = 0; m < 4; ++m) { const size_t off = (size_t)(row0 + ai * HALF + m * 16) * D + col0;
#pragma unroll
                    for (int bj = 0; bj < 2; ++bj) { const f32x4 v0 = xi[m][bj][0] + gv[bj][0] * acc[ai][bj][m][0], v1 = xi[m][bj][1] + gv[bj][1] * acc[ai][bj][m][1];
                        u32x4 w; w.x = cvt_pk_bf16(v0[0], v0[1]); w.y = cvt_pk_bf16(v0[2], v0[3]); w.z = cvt_pk_bf16(v1[0], v1[1]); w.w = cvt_pk_bf16(v1[2], v1[3]);
                        *(u32x4*)(Xout + off + bj * HALF) = w; } }
            }
        }
    }
};
struct EpiSwiglu {
    static constexpr bool PERM = true; static constexpr int NVM = 7;
    unsigned char* O; const float* bg; const float* bu; float wscale;
    template <class Hook> __device__ __forceinline__ void operator()(const f32x4 (&acc)[2][2][4][2], const Unit& u, int wr, int wc, int fr, int fq, Hook&& hook) const {
        const int row0 = u.pm * BM + wr * 64 + fr, j0 = u.pn * HALF + wc * 32 + 8 * fq;
        f32x4 g0 = *(const f32x4*)(bg + u.e * 1024 + j0), g1 = *(const f32x4*)(bg + u.e * 1024 + j0 + 4);
        f32x4 u0 = *(const f32x4*)(bu + u.e * 1024 + j0), u1 = *(const f32x4*)(bu + u.e * 1024 + j0 + 4);
        u0 += 1.0f; u1 += 1.0f;
        const f32x2_ ws2 = {wscale, wscale}, kn2 = {-2.4554669595930157f, -2.4554669595930157f}, one2 = {1.0f, 1.0f};
#pragma unroll
        for (int ai = 0; ai < 2; ++ai)
#pragma unroll
            for (int m = 0; m < 4; ++m) { unsigned char* rowp = O + (size_t)(row0 + ai * HALF + m * 16) * D + j0;
                float r[8];
#pragma unroll
                for (int n = 0; n < 2; ++n)
#pragma unroll
                    for (int h = 0; h < 2; ++h) {
                        const f32x4 gb4 = n ? g1 : g0, ub4 = n ? u1 : u0;
                        const f32x2_ ga = {acc[ai][0][m][n][2 * h], acc[ai][0][m][n][2 * h + 1]}, ua = {acc[ai][1][m][n][2 * h], acc[ai][1][m][n][2 * h + 1]};
                        const f32x2_ gbp = {gb4[2 * h], gb4[2 * h + 1]}, ubp = {ub4[2 * h], ub4[2 * h + 1]};
                        f32x2_ gt = ga * ws2 + gbp, up = ua * ws2 + ubp;
                        gt.x = fminf(gt.x, 7.0f); gt.y = fminf(gt.y, 7.0f);
                        up.x = fminf(fmaxf(up.x, -6.0f), 8.0f); up.y = fminf(fmaxf(up.y, -6.0f), 8.0f);
                        const f32x2_ t = gt * kn2;
                        f32x2_ e; e.x = __builtin_amdgcn_exp2f(t.x); e.y = __builtin_amdgcn_exp2f(t.y);
                        const f32x2_ d = e + one2;
                        f32x2_ rc; rc.x = __builtin_amdgcn_rcpf(d.x); rc.y = __builtin_amdgcn_rcpf(d.y);
                        const f32x2_ o = up * gt * rc;
                        r[n * 4 + 2 * h] = o.x; r[n * 4 + 2 * h + 1] = o.y; }
                u32x2 w; w.x = pk4_fp8(r[0], r[1], r[2], r[3]); w.y = pk4_fp8(r[4], r[5], r[6], r[7]);
                *(u32x2*)rowp = w;
                if (ai == 0 && m == 0) hook(); }
    }
};
struct EpiDown {
    static constexpr bool PERM = true; static constexpr int NVM = 15;
    bf16_t* O; const float* bd; float wscale;
    template <class Hook> __device__ __forceinline__ void operator()(const f32x4 (&acc)[2][2][4][2], const Unit& u, int wr, int wc, int fr, int fq, Hook&& hook) const {
        const int row0 = u.pm * BM + wr * 64 + fr, col0 = u.pn * BM + wc * 32 + 8 * fq;
        f32x4 bb[2][2];
#pragma unroll
        for (int bj = 0; bj < 2; ++bj) { bb[bj][0] = *(const f32x4*)(bd + u.e * 1024 + col0 + bj * HALF); bb[bj][1] = *(const f32x4*)(bd + u.e * 1024 + col0 + bj * HALF + 4); }
#pragma unroll
        for (int bj = 0; bj < 2; ++bj) {
            const f32x4 b0 = bb[bj][0], b1 = bb[bj][1];
#pragma unroll
            for (int ai = 0; ai < 2; ++ai)
#pragma unroll
                for (int m = 0; m < 4; ++m) { bf16_t* rowp = O + (size_t)(row0 + ai * HALF + m * 16) * D + col0 + bj * HALF;
                    const f32x4 v0 = acc[ai][bj][m][0] * wscale + b0, v1 = acc[ai][bj][m][1] * wscale + b1;
                    u32x4 w; w.x = cvt_pk_bf16(v0[0], v0[1]); w.y = cvt_pk_bf16(v0[2], v0[3]); w.z = cvt_pk_bf16(v1[0], v1[1]); w.w = cvt_pk_bf16(v1[2], v1[3]);
                    *(u32x4*)rowp = w;
                    if (bj == 0 && ai == 0 && m == 0) hook(); }
            asm volatile("" ::: "memory");
        }
    }
};

template <bool F8>
__device__ __forceinline__ f32x4 mma_pair(const bf16x8 b0, const bf16x8 b1, const bf16x8 a0, const bf16x8 a1, f32x4 acc) {
    if constexpr (F8) {
        const i32x4 bl = __builtin_bit_cast(i32x4, b0), bh = __builtin_bit_cast(i32x4, b1), al = __builtin_bit_cast(i32x4, a0), ah = __builtin_bit_cast(i32x4, a1);
        const i32x8 bv = __builtin_shufflevector(bl, bh, 0, 1, 2, 3, 4, 5, 6, 7), av = __builtin_shufflevector(al, ah, 0, 1, 2, 3, 4, 5, 6, 7);
        return __builtin_amdgcn_mfma_scale_f32_16x16x128_f8f6f4(bv, av, acc, 0, 0, 0, 0x7f7f7f7f, 0, 0x7f7f7f7f);
    } else {
        acc = __builtin_amdgcn_mfma_f32_16x16x32_bf16(b0, a0, acc, 0, 0, 0);
        return __builtin_amdgcn_mfma_f32_16x16x32_bf16(b1, a1, acc, 0, 0, 0);
    }
}
template <class Epi, class Sched, bool F8 = false>
__device__ __forceinline__ void gemm_phase(LAS unsigned char* lds, const bf16_t* A, const bf16_t* Bt, const int K, const Sched& S, const Epi& E) {
    const int tid = otid(), wid = __builtin_amdgcn_readfirstlane(tid >> 6), lane = tid & 63, wr = wid >> 2, wc = wid & 3, fr = lane & 15, fq = lane >> 4;
    const int nt = K / BK;
    unsigned voffB[2];
#pragma unroll
    for (int i = 0; i < 2; ++i) { int R, C; stage_rc(tid * 16 + i * 8192, R, C); const int Rb = Epi::PERM ? ((R & ~31) + perm32(R & 31)) : R;
        voffB[i] = (unsigned)(Rb * K + C) * 2u; }
    const size_t kstep = (size_t)(BK * 2);
    const size_t hstep = (size_t)HALF * K * 2;
    const size_t tstep = 2 * hstep;
    const unsigned ldsw = (unsigned)wid * 1024u;
    const int aoff = lds_byte(wr * 64 + fr, fq * 8), boff = lds_byte(wc * 32 + fr, fq * 8);
#define PG8_SA(b, h) (((b) * 2 + (h)) * HTB)
#define PG8_SB(b, h) ((4 + (b) * 2 + (h)) * HTB)
#define PG8_STAGE(bufoff, gbase, voff) do { _Pragma("unroll") for (int _i = 0; _i < 2; ++_i) \
        __builtin_amdgcn_global_load_lds((const unsigned*)((const char*)(gbase) + (voff)[_i]), (LAS unsigned*)(lds + (bufoff) + ldsw + _i * 8192), 16, 0, 0); } while (0)
#define PG8_LDA(dst, b, h) do { _Pragma("unroll") for (int m = 0; m < 4; ++m) _Pragma("unroll") for (int k = 0; k < 2; ++k) dst[m][k] = *(const LAS bf16x8*)(lds + PG8_SA(b, h) + aoff + m * 2048 + k * 1024); } while (0)
#define PG8_LDB(dst, b, h) do { _Pragma("unroll") for (int n = 0; n < 2; ++n) _Pragma("unroll") for (int k = 0; k < 2; ++k) dst[n][k] = *(const LAS bf16x8*)(lds + PG8_SB(b, h) + boff + n * 2048 + k * 1024); } while (0)
#define PG8_MMA(ai, bj, At, Bt_) do { __builtin_amdgcn_s_setprio(1); _Pragma("unroll") for (int m = 0; m < 4; ++m) _Pragma("unroll") for (int n = 0; n < 2; ++n) \
        acc[ai][bj][m][n] = mma_pair<F8>(Bt_[n][0], Bt_[n][1], At[m][0], At[m][1], acc[ai][bj][m][n]); __builtin_amdgcn_s_setprio(0); } while (0)
#define PG8_WAIT_V(n) asm volatile("s_waitcnt vmcnt(" #n ")" ::: "memory")
#define PG8_WAIT_L(n) asm volatile("s_waitcnt lgkmcnt(" #n ")" ::: "memory")
#define PG8_BAR __builtin_amdgcn_s_barrier()
#define PG8_SCHED __builtin_amdgcn_sched_barrier(0)
#define PG8_OFFS(u, o) do { _Pragma("unroll") for (int _i = 0; _i < 2; ++_i) { int _R, _C; stage_rc(tid * 16 + _i * 8192, _R, _C); \
        _Pragma("unroll") for (int _h = 0; _h < 2; ++_h) { unsigned _o = (unsigned)(S.arow(u, _h * HALF + _R) * K + _C) * 2u; asm volatile("" : "+v"(_o)); o[_h][_i] = _o; } } } while (0)
#define PG8_OFFSN(u, o) do { _Pragma("unroll") for (int _i = 0; _i < 2; ++_i) { int _R, _C; stage_rc(tid * 16 + _i * 8192, _R, _C); \
        _Pragma("unroll") for (int _h = 0; _h < 2; ++_h) { unsigned _o = (unsigned)(S.arow_next(u, _h * HALF + _R) * K + _C) * 2u; asm volatile("" : "+v"(_o)); o[_h][_i] = _o; } } } while (0)
    Unit cur, nxt; int ui = 0;
    if (!S.next(0, cur)) return;
#if defined(GEMM_STAGGER)
    {
        const unsigned long long t0_ = __builtin_amdgcn_s_memrealtime(), dl_ = (unsigned long long)((blockIdx.x >> 3) & 3u) * GEMM_STAGGER;
        while (__builtin_amdgcn_s_memrealtime() - t0_ < dl_) __builtin_amdgcn_s_sleep(8);
    }
#endif
    f32x4 acc[2][2][4][2];
#pragma unroll
    for (int a = 0; a < 2; ++a)
#pragma unroll
        for (int b = 0; b < 2; ++b)
#pragma unroll
            for (int m = 0; m < 4; ++m)
#pragma unroll
                for (int n = 0; n < 2; ++n) acc[a][b][m][n] = (f32x4){0.f, 0.f, 0.f, 0.f};
    bf16x8 At[4][2], B0[2][2], B1[2][2];
    unsigned oC[2][2];
    PG8_OFFS(cur, oC);
    const char* Ab = (const char*)A;
    const char* cB = (const char*)Bt + (size_t)cur.pb * tstep;
    PG8_STAGE(PG8_SB(0, 0), cB, voffB); PG8_STAGE(PG8_SA(0, 0), Ab, oC[0]); PG8_STAGE(PG8_SB(0, 1), cB + hstep, voffB); PG8_STAGE(PG8_SA(0, 1), Ab, oC[1]);
    if (wr == 1) PG8_BAR;
    PG8_WAIT_V(4); PG8_BAR;
    PG8_STAGE(PG8_SB(1, 0), cB + kstep, voffB); PG8_STAGE(PG8_SA(1, 0), Ab + kstep, oC[0]); PG8_STAGE(PG8_SB(1, 1), cB + hstep + kstep, voffB);
    PG8_WAIT_V(6); PG8_BAR;
    for (;;) {
        const bool has_next = S.next(ui + 1, nxt);
        const char* nB = has_next ? (const char*)Bt + (size_t)nxt.pb * tstep : cB;
        if (has_next) S.prefetch_rows(nxt);
        for (int t = 0; t < nt; t += 2) {
            const bool last = (t == nt - 2);
            const char* a1 = Ab + (size_t)(t + 1) * kstep;
            const char* a2 = last ? Ab : Ab + (size_t)(t + 2) * kstep; const char* b2 = last ? nB : cB + (size_t)(t + 2) * kstep;
            const char* a3 = a2 + kstep; const char* b3 = b2 + kstep;
            PG8_LDB(B0, 0, 0); PG8_SCHED; PG8_LDA(At, 0, 0); PG8_STAGE(PG8_SA(1, 1), a1, oC[1]);
            PG8_WAIT_L(8); PG8_BAR; PG8_WAIT_L(0); PG8_MMA(0, 0, At, B0); PG8_BAR; PG8_SCHED;
            if (last && has_next) { PG8_OFFSN(nxt, oC); }
            PG8_LDB(B1, 0, 1); PG8_STAGE(PG8_SB(0, 0), b2, voffB);
            PG8_BAR; PG8_WAIT_L(0); PG8_MMA(0, 1, At, B1); PG8_BAR;
            PG8_LDA(At, 0, 1); PG8_STAGE(PG8_SA(0, 0), a2, oC[0]);
            PG8_BAR; PG8_WAIT_L(0); PG8_MMA(1, 0, At, B0); PG8_BAR; PG8_SCHED;
            PG8_STAGE(PG8_SB(0, 1), b2 + hstep, voffB);
            PG8_WAIT_V(6); PG8_BAR; PG8_MMA(1, 1, At, B1); PG8_BAR;
            PG8_LDB(B0, 1, 0); PG8_SCHED; PG8_LDA(At, 1, 0); PG8_STAGE(PG8_SA(0, 1), a2, oC[1]);
            PG8_WAIT_L(8); PG8_BAR; PG8_WAIT_L(0); PG8_MMA(0, 0, At, B0); PG8_BAR; PG8_SCHED;
            PG8_LDB(B1, 1, 1); PG8_STAGE(PG8_SB(1, 0), b3, voffB);
            PG8_BAR; PG8_WAIT_L(0); PG8_MMA(0, 1, At, B1); PG8_BAR;
            PG8_LDA(At, 1, 1); PG8_STAGE(PG8_SA(1, 0), a3, oC[0]);
            PG8_BAR; PG8_WAIT_L(0); PG8_MMA(1, 0, At, B0); PG8_BAR; PG8_SCHED;
            PG8_STAGE(PG8_SB(1, 1), b3 + hstep, voffB);
            PG8_WAIT_V(6); PG8_BAR; PG8_MMA(1, 1, At, B1); PG8_BAR;
        }
        if (wr == 0) PG8_BAR;
        unsigned tkt = 0u;
        auto hook = [&]() __attribute__((always_inline)) {
            if constexpr (Sched::DYN) {
                if (wid == 0) { unsigned long long sv_; const unsigned zero_ = 0u, one_ = 1u;
                    asm volatile("s_mov_b64 %1, exec\n\ts_mov_b64 exec, 1\n\tglobal_atomic_add %0, %2, %3, %4 sc0\n\ts_mov_b64 exec, %1"
                                 : "=&v"(tkt), "=&s"(sv_) : "v"(zero_), "v"(one_), "s"(S.ticket) : "memory"); }
            }
        };
        E(acc, cur, wr, wc, fr, fq, hook);
        if constexpr (Sched::DYN) {
            if (wid == 0) { asm volatile("s_waitcnt vmcnt(%1)" : "+v"(tkt) : "n"(Epi::NVM) : "memory");
                if (lane == 0) S.publish(ui + 3, tkt); }
        }
        if (!has_next) break;
#pragma unroll
        for (int a = 0; a < 2; ++a)
#pragma unroll
            for (int b = 0; b < 2; ++b)
#pragma unroll
                for (int m = 0; m < 4; ++m)
#pragma unroll
                    for (int n = 0; n < 2; ++n) acc[a][b][m][n] = (f32x4){0.f, 0.f, 0.f, 0.f};
        cur = nxt; cB = nB; ++ui;
        if (wr == 1) PG8_BAR;
    }
    PG8_WAIT_V(0);
    PG8_BAR;
#undef PG8_SA
#undef PG8_SB
#undef PG8_STAGE
#undef PG8_LDA
#undef PG8_LDB
#undef PG8_MMA
#undef PG8_WAIT_V
#undef PG8_WAIT_L
#undef PG8_BAR
#undef PG8_SCHED
#undef PG8_OFFS
#undef PG8_OFFSN
}
}

struct Params {
    const float *x, *c; const int* pos;
    const float *w_ada, *b_ada, *norm1_g, *w_in, *conv_w, *conv_b, *b_ig, *b_fg, *mnorm_g, *w_out, *norm2_g, *w_router, *b_router,
                *w_gate, *b_gate, *w_up, *b_up, *w_down, *b_down, *fnorm_g;
    float* out; unsigned char* ws; int ph_lo, ph_hi;
};
#define WSP(type, off) ((type*)(p.ws + (off)))
typedef const __attribute__((address_space(4))) Params* ParamsK;
#if defined(__HIP_DEVICE_COMPILE__)
__device__ __forceinline__ ParamsK kparams() { ParamsK k = (ParamsK)__builtin_amdgcn_kernarg_segment_ptr(); asm volatile("" : "+s"(k)); return k; }
#define LOADP() (*kparams())
#else
#define LOADP() (Params{})
#endif
#define MFMA16(a, b, c) __builtin_amdgcn_mfma_f32_16x16x32_bf16((a), (b), (c), 0, 0, 0)

__device__ __forceinline__ void tr_item(const float* __restrict__ W, int ldw, int k0, int nsrc0, bf16_t* __restrict__ WT, int K, int drow0, LAS float* scr, int lane) {
    f32x4 v[8];
#pragma unroll
    for (int i = 0; i < 8; ++i) v[i] = *(const f32x4*)(W + (size_t)(k0 + (lane >> 3) + 8 * i) * ldw + nsrc0 + (lane & 7) * 4);
#pragma unroll
    for (int i = 0; i < 8; ++i) { LAS float* d = scr + ((lane >> 3) + 8 * i) * 33 + (lane & 7) * 4; d[0] = v[i][0]; d[1] = v[i][1]; d[2] = v[i][2]; d[3] = v[i][3]; }
    LDS_WAIT();
    const int c = lane & 7;
#pragma unroll
    for (int j = 0; j < 4; ++j) { const int n = (lane >> 3) + 8 * j; const LAS float* s = scr + (8 * c) * 33 + n;
        u32x4 o; o.x = pk2(s[0 * 33], s[1 * 33]); o.y = pk2(s[2 * 33], s[3 * 33]); o.z = pk2(s[4 * 33], s[5 * 33]); o.w = pk2(s[6 * 33], s[7 * 33]);
        *(u32x4*)(WT + (size_t)(drow0 + n) * K + k0 + 8 * c) = o; }
    LDS_WAIT();
}
__device__ __forceinline__ void tr_item8(const float* __restrict__ W, int ldw, int k0, int nsrc0, unsigned char* __restrict__ WT8, int K, int drow0, LAS float* scr, int lane, float scale) {
    f32x4 v[8];
#pragma unroll
    for (int i = 0; i < 8; ++i) v[i] = __builtin_nontemporal_load((const f32x4*)(W + (size_t)(k0 + (lane >> 3) + 8 * i) * ldw + nsrc0 + (lane & 7) * 4));
#pragma unroll
    for (int i = 0; i < 8; ++i) { LAS float* d = scr + ((lane >> 3) + 8 * i) * 33 + (lane & 7) * 4; d[0] = v[i][0]; d[1] = v[i][1]; d[2] = v[i][2]; d[3] = v[i][3]; }
    LDS_WAIT();
    const int c = lane & 3;
#pragma unroll
    for (int j = 0; j < 2; ++j) { const int n = (lane >> 2) + 16 * j; const LAS float* s_ = scr + (16 * c) * 33 + n;
        u32x4 o;
        o.x = pk4_fp8(s_[0 * 33] * scale, s_[1 * 33] * scale, s_[2 * 33] * scale, s_[3 * 33] * scale);
        o.y = pk4_fp8(s_[4 * 33] * scale, s_[5 * 33] * scale, s_[6 * 33] * scale, s_[7 * 33] * scale);
        o.z = pk4_fp8(s_[8 * 33] * scale, s_[9 * 33] * scale, s_[10 * 33] * scale, s_[11 * 33] * scale);
        o.w = pk4_fp8(s_[12 * 33] * scale, s_[13 * 33] * scale, s_[14 * 33] * scale, s_[15 * 33] * scale);
        __builtin_nontemporal_store(o, (u32x4*)(WT8 + (size_t)(drow0 + n) * K + k0 + 16 * c)); }
    LDS_WAIT();
}
constexpr float W8_SCALE = 32.0f, W8_INV = 1.0f / 32.0f;
constexpr int CVT_TPL = NE * 1536 / 8, CVT_NT = 2 * CVT_TPL, CVT_GU = NE * 1024 / 8;
__device__ __forceinline__ void convert_ticket(const Params& p, unsigned t, LAS unsigned char* lds) {
    const int tid = otid(), lane = tid & 63, wave = __builtin_amdgcn_readfirstlane(tid >> 6);
    LAS float* scr = (LAS float*)(lds + wave * 8448);
    const int l = t >= (unsigned)CVT_TPL ? 1 : 0, tl = (int)t - l * CVT_TPL;
    unsigned char* WGU = WSP(unsigned char, WS_WGU) + (size_t)l * NE * 2048 * 1024; unsigned char* WD = WSP(unsigned char, WS_WD) + (size_t)l * NE * 1024 * 1024;
    const bool dn = tl >= CVT_GU; const int it = (dn ? tl - CVT_GU : tl) * 8 + wave;
    const int e = dn ? it / 512 : it / 1024, mat = dn ? 2 : (it % 1024) / 512, q = it % 512, kb = q / 32, nb = q % 32, k0 = kb * 64, n0 = nb * 32;
    const size_t eo = (size_t)(l * NE + e) * 1024 * 1024;
    if (mat == 0) tr_item8(p.w_gate + eo, 1024, k0, n0, WGU + (size_t)e * 2048 * 1024, 1024, (n0 >> 7) * 256 + (n0 & 127), scr, lane, W8_SCALE);
    else if (mat == 1) tr_item8(p.w_up + eo, 1024, k0, n0, WGU + (size_t)e * 2048 * 1024, 1024, (n0 >> 7) * 256 + 128 + (n0 & 127), scr, lane, W8_SCALE);
    else tr_item8(p.w_down + eo, 1024, k0, n0, WD + (size_t)e * 1024 * 1024, 1024, n0, scr, lane, W8_SCALE);
}
constexpr unsigned XB_RELEASED = 0xFFFFFFFFu, XB_PENDING = 0xFFFFFFFEu;
__device__ __forceinline__ void cvt_drain(const Params& p, LAS unsigned char* lds, volatile LAS unsigned* st, const unsigned limit) {
    __syncthreads();
#if defined(DIAG_A)
    if (blockIdx.x == 0 && threadIdx.x == 0) { volatile unsigned long long* ds = (volatile unsigned long long*)(p.ws + WS_CTL + 524288); const int l_ = (int)((limit - 1u) / CVT_TPL) * 2 + ((limit % CVT_TPL) == 0u ? 1 : 0);
        ds[40 + 2 * l_] = 0ull; ds[41 + 2 * l_] = 100ull * (unsigned long long)xb_ld(WSP(unsigned, WS_CTL) + CW_CVT); }
#endif
    if (st[3]) return;
    unsigned* tk = WSP(unsigned, WS_CTL) + CW_CVT;
    if (threadIdx.x == 0) st[2] = xb_add(tk, 1u);
    __syncthreads();
    unsigned t = st[2];
    for (;;) {
        const bool more = t < limit;
        unsigned tn = 0u;
        if (more && threadIdx.x == 0) tn = xb_add(tk, 1u);
        if (t < (unsigned)CVT_NT) convert_ticket(p, t, lds);
        if (!more) break;
        __syncthreads();
        if (threadIdx.x == 0) st[2] = tn;
        __syncthreads();
        t = st[2];
    }
    __syncthreads();
    if (t >= (unsigned)CVT_NT && threadIdx.x == 0) st[3] = 1u;
    __syncthreads();
}
#ifndef XB_STEAL_MARGIN
#define XB_STEAL_MARGIN 0u
#endif
__device__ __forceinline__ void xcd_barrier_steal(const XcdBarrier& b, LAS unsigned char* lds) {
    asm volatile("s_waitcnt vmcnt(0)" ::: "memory");
    __syncthreads();
    volatile LAS unsigned* st = b.st;
    if (threadIdx.x == 0) {
        unsigned* bar = b.bar;
        __builtin_amdgcn_s_waitcnt(0);
        unsigned nloc = st[0], nx = st[1];
        if (nloc == 0u) { xcd_barrier_complete(bar, b.x, nloc, nx); st[0] = nloc; st[1] = nx; }
        const unsigned old = xb_add(&bar[XB_XSUB(b.x)], 1u);
        const unsigned gen = old / nloc;
        if (old + 1u == (gen + 1u) * nloc) {
            __builtin_amdgcn_fence(__ATOMIC_RELEASE, "agent");
            asm volatile("s_waitcnt vmcnt(0)" ::: "memory");
            const unsigned og = xb_add(&bar[XB_TOP], 1u);
            const unsigned tg = og / nx;
            if (og + 1u == (tg + 1u) * nx) xb_add(&bar[XB_TOPGEN], 1u);
            else XB_SPIN(xb_ld(&bar[XB_TOPGEN]) == tg, bar);
            __builtin_amdgcn_fence(__ATOMIC_ACQUIRE, "agent");
            xb_add(&bar[XB_XGEN(b.x)], 1u);
            asm volatile("s_waitcnt vmcnt(0)" ::: "memory");
            st[2] = XB_RELEASED;
        } else if (st[3]) {
            XB_SPIN(xb_ld(&bar[XB_XGEN(b.x)]) == gen, bar);
            __builtin_amdgcn_fence(__ATOMIC_ACQUIRE, "agent");
            asm volatile("s_waitcnt vmcnt(0)" ::: "memory");
            st[2] = XB_RELEASED;
        } else { st[2] = XB_PENDING; st[4] = gen; }
    }
    for (;;) {
        __syncthreads();
        const unsigned s = st[2];
        if (s == XB_RELEASED) break;
        if (s < (unsigned)CVT_NT) { const Params p = LOADP(); convert_ticket(p, s, lds); }
        __syncthreads();
        if (threadIdx.x == 0) {
            unsigned* bar = b.bar; const unsigned nloc = st[0], gen = st[4];
            unsigned sp = 0u, res = XB_RELEASED;
            for (;;) {
                if (xb_ld(&bar[XB_XGEN(b.x)]) != gen) break;
                if (!st[3] && xb_ld(&bar[XB_XSUB(b.x)]) - gen * nloc + XB_STEAL_MARGIN <= nloc) {
                    const Params p = LOADP();
                    const unsigned t = xb_add(WSP(unsigned, WS_CTL) + CW_CVT, 1u);
                    if (t < (unsigned)CVT_NT) { res = t; break; }
                    st[3] = 1u;
                }
                __builtin_amdgcn_s_sleep(1);
                if ((++sp & 255u) == 0u) { if (xb_ld(&bar[XB_TMO])) break; if (sp > XB_SPIN_CAP) { atomicAdd(&bar[XB_TMO], 1u); break; } }
            }
            if (res == XB_RELEASED) { __builtin_amdgcn_fence(__ATOMIC_ACQUIRE, "agent"); asm volatile("s_waitcnt vmcnt(0)" ::: "memory"); }
            st[2] = res;
        }
    }
}
__device__ __forceinline__ void prologue_phase(const Params& p, LAS unsigned char* lds) {
    const int tid = otid(), lane = tid & 63, wave = tid >> 6;
    const int G = gridDim.x;
    {
        LAS float* condl = (LAS float*)(lds + 70000);
        LAS float* red = (LAS float*)(lds + 70000 + 16384);
#pragma unroll
        for (int i = tid; i < 4096; i += 512) { const float cv = p.c[i]; condl[i] = cv / (1.0f + __expf(-cv)); }
        __syncthreads();
        float* MOD = WSP(float, WS_MOD);
        for (int u = blockIdx.x; u < 192; u += G) {
            const int l = u / 96, n0 = (u % 96) * 64;
            const float* w = p.w_ada + (size_t)l * 1024 * 6144 + n0 + lane;
            float a0 = 0.f, a1 = 0.f, a2 = 0.f, a3 = 0.f;
#pragma unroll 32
            for (int kk = 0; kk < 128; ++kk) { const int k = wave * 128 + kk; const float wv = __builtin_nontemporal_load(w + (size_t)k * 6144);
                a0 += condl[k] * wv; a1 += condl[1024 + k] * wv; a2 += condl[2048 + k] * wv; a3 += condl[3072 + k] * wv; }
            red[(wave * 4 + 0) * 64 + lane] = a0; red[(wave * 4 + 1) * 64 + lane] = a1; red[(wave * 4 + 2) * 64 + lane] = a2; red[(wave * 4 + 3) * 64 + lane] = a3;
            __syncthreads();
            if (tid < 256) { const int b = tid >> 6, ln = tid & 63; float s = p.b_ada[l * 6144 + n0 + ln];
#pragma unroll
                for (int w8 = 0; w8 < 8; ++w8) s += red[(w8 * 4 + b) * 64 + ln];
                MOD[(size_t)(l * 4 + b) * 6144 + n0 + ln] = s; }
            __syncthreads();
        }
    }
    {
        LAS float* scr = (LAS float*)(lds + wave * 8448);
        const int gw = blockIdx.x * 8 + wave, NGW = G * 8;
        bf16_t* WIN = WSP(bf16_t, WS_WIN); bf16_t* WOUT = WSP(bf16_t, WS_WOUT);
        constexpr int I_IN = 16 * 112, I_OUT = 16 * 32;
        for (int it = gw; it < 2 * I_IN + 2 * I_OUT; it += NGW) {
            if (it < 2 * I_IN) { const int l = it / I_IN, r = it % I_IN, kb = r / 112, nb = r % 112, n0 = nb * 32;
                tr_item8(p.w_in + (size_t)l * 1024 * NIN, NIN, kb * 64, n0 < 2048 ? n0 : n0 + 8, (unsigned char*)WIN + (size_t)l * NZ * 1024, 1024, n0, scr, lane, W8_SCALE); }
            else { const int r2 = it - 2 * I_IN, l = r2 / I_OUT, r = r2 % I_OUT, kb = r / 32, nb = r % 32;
                tr_item(p.w_out + (size_t)l * 1024 * 1024, 1024, kb * 64, nb * 32, WOUT + (size_t)l * 1024 * 1024, 1024, nb * 32, scr, lane); }
        }
    }
}

__device__ __forceinline__ void moe_tile_prefix(const Params& p, int lm, LAS int* tb, LAS int* cnt) {
    if (threadIdx.x < 64) { const unsigned* ec = WSP(unsigned, WS_CTL) + CW_ECNT + lm * 64; const int ln = threadIdx.x;
        const int c = ln < 32 ? (int)ec[ln] : 0; int inc = (c + 255) >> 8; const int tl_ = inc;
#pragma unroll
        for (int o = 1; o < 32; o <<= 1) { const int t_ = __shfl_up(inc, o); if (ln >= o) inc += t_; }
        if (ln < 32) { cnt[ln] = c; tb[ln] = inc - tl_; } if (ln == 31) tb[32] = inc; }
}
template <int MODE>
__device__ __forceinline__ void norm_phase(const Params& p, int l, LAS unsigned char* lds) {
    const int tid = otid(), lane = tid & 63, wave = __builtin_amdgcn_readfirstlane(tid >> 6);
#define NC(j) (8 * lane + 512 * ((j) >> 1) + 4 * ((j) & 1))
    LAS float* Wg = (LAS float*)lds;
    LAS int* tb = (LAS int*)(lds + 32768); LAS int* cnt = tb + 40;
    LAS float* gb = (LAS float*)(lds + 32768 + 512);
    if (MODE != 2 && tid < 8) gb[tid] = tid < 4 ? p.b_ig[l * 4 + tid] : p.b_fg[l * 4 + tid - 4];
    if (MODE != 2) { const float* wi = p.w_in + (size_t)l * 1024 * NIN + 2048;
#pragma unroll
        for (int i = tid; i < 8192; i += 512) { const int n = i >> 3, c = i & 7, rem = n & 511, jg = 2 * (n >> 9) + ((rem >> 2) & 1);
            Wg[(jg * 8 + c) * 256 + (rem >> 3) * 4 + (rem & 3)] = wi[(size_t)n * NIN + c]; } }
    if (MODE >= 1) moe_tile_prefix(p, MODE == 1 ? l - 1 : 1, tb, cnt);
    __syncthreads();
    const int lm = (MODE == 1) ? l - 1 : 1;
    const float* MOD = WSP(float, WS_MOD);
    bf16_t* X = WSP(bf16_t, WS_X); bf16_t* H = WSP(bf16_t, WS_H);
    const bf16_t* YB = WSP(bf16_t, WS_YB);
    const unsigned* PE = WSP(unsigned, WS_PE); const float* PROB = WSP(float, WS_PROB);
    float* IG = WSP(float, WS_IG); float* LF = WSP(float, WS_LF);
    const int gw = blockIdx.x * 8 + wave, NGW = gridDim.x * 8;
    constexpr int RB = 2;
    f32x4 vn[RB][4];
    if (MODE == 0) {
#pragma unroll
        for (int q = 0; q < RB; ++q) { const int rr = gw * RB + q < T ? gw * RB + q : T - 1; const float* xr = p.x + (size_t)rr * D;
#pragma unroll
            for (int j = 0; j < 4; ++j) vn[q][j] = __builtin_nontemporal_load((const f32x4*)(xr + NC(j))); }
    }
    for (int row0 = gw * RB; row0 < T; row0 += NGW * RB) {
        f32x4 v[RB][4];
#pragma unroll
        for (int q = 0; q < RB; ++q) {
            if (MODE == 0) {
#pragma unroll
                for (int j = 0; j < 4; ++j) v[q][j] = vn[q][j];
                const int rn = row0 + NGW * RB + q < T ? row0 + NGW * RB + q : row0 + q; const float* xr = p.x + (size_t)rn * D;
#pragma unroll
                for (int j = 0; j < 4; ++j) vn[q][j] = __builtin_nontemporal_load((const f32x4*)(xr + NC(j))); }
            else { const bf16_t* xr = X + (size_t)(row0 + q) * D;
#pragma unroll
                for (int jj = 0; jj < 2; ++jj) { const u32x4 w = *(const u32x4*)(xr + 8 * lane + 512 * jj);
                    v[q][2 * jj] = (f32x4){bflo(w.x), bfhi(w.x), bflo(w.y), bfhi(w.y)}; v[q][2 * jj + 1] = (f32x4){bflo(w.z), bfhi(w.z), bflo(w.w), bfhi(w.w)}; } } }
        if (MODE >= 1) {
            f32x4 y[RB][4];
#pragma unroll
            for (int q = 0; q < RB; ++q)
#pragma unroll
                for (int j = 0; j < 4; ++j) y[q][j] = (f32x4){0.f, 0.f, 0.f, 0.f};
            {
                u32x4 yw[RB][4][2]; float pr[RB][4]; unsigned pe[RB][4];
#pragma unroll
                for (int q = 0; q < RB; ++q)
#pragma unroll
                    for (int k = 0; k < 4; ++k) { pe[q][k] = PE[(row0 + q) * 4 + k]; pr[q][k] = PROB[(row0 + q) * 4 + k]; }
#pragma unroll
                for (int q = 0; q < RB; ++q)
#pragma unroll
                    for (int k = 0; k < 4; ++k) {
                        const int e = pe[q][k] & 255u, rank = pe[q][k] >> 8; const size_t srow = (size_t)tb[e] * 256 + rank;
                        const bf16_t* yb = YB + srow * D;
#pragma unroll
                        for (int jj = 0; jj < 2; ++jj) yw[q][k][jj] = __builtin_nontemporal_load((const u32x4*)(yb + 8 * lane + 512 * jj)); }
#pragma unroll
                for (int q = 0; q < RB; ++q)
#pragma unroll
                    for (int jj = 0; jj < 2; ++jj)
#pragma unroll
                        for (int k = 0; k < 4; ++k) { const u32x4 w = yw[q][k][jj]; const f32x2_ pk = {pr[q][k], pr[q][k]};
                            const unsigned ww[4] = {w.x, w.y, w.z, w.w};
#pragma unroll
                            for (int hw_ = 0; hw_ < 4; ++hw_) { f32x4& yy = y[q][2 * jj + (hw_ >> 1)]; const int o_ = 2 * (hw_ & 1);
                                f32x2_ t = {yy[o_], yy[o_ + 1]}; const f32x2_ xv = {bflo(ww[hw_]), bfhi(ww[hw_])};
                                t = pk * xv + t; yy[o_] = t.x; yy[o_ + 1] = t.y; } }
            }
#pragma unroll
            for (int q = 0; q < RB; ++q) {
                const int b = (row0 + q) >> 13;
                const float* g2 = MOD + (size_t)(lm * 4 + b) * 6144 + 5120;
#pragma unroll
                for (int j = 0; j < 4; ++j) { const f32x4 gg = *(const f32x4*)(g2 + NC(j)); v[q][j] += gg * y[q][j]; }
            }
            if (MODE == 1) {
#pragma unroll
                for (int q = 0; q < RB; ++q)
#pragma unroll
                    for (int jj = 0; jj < 2; ++jj) { u32x4 w; w.x = pk2(v[q][2 * jj][0], v[q][2 * jj][1]); w.y = pk2(v[q][2 * jj][2], v[q][2 * jj][3]);
                        w.z = pk2(v[q][2 * jj + 1][0], v[q][2 * jj + 1][1]); w.w = pk2(v[q][2 * jj + 1][2], v[q][2 * jj + 1][3]);
                        *(u32x4*)(X + (size_t)(row0 + q) * D + 8 * lane + 512 * jj) = w;
                        v[q][2 * jj] = (f32x4){bflo(w.x), bfhi(w.x), bflo(w.y), bfhi(w.y)}; v[q][2 * jj + 1] = (f32x4){bflo(w.z), bfhi(w.z), bflo(w.w), bfhi(w.w)}; }
            }
        }
        float rstd[RB];
#pragma unroll
        for (int q = 0; q < RB; ++q) { float ss = 0.f;
#pragma unroll
            for (int j = 0; j < 4; ++j) ss += (v[q][j][0] * v[q][j][0] + v[q][j][1] * v[q][j][1]) + (v[q][j][2] * v[q][j][2] + v[q][j][3] * v[q][j][3]);
            rstd[q] = __builtin_amdgcn_rsqf(wave_sum(ss) * (1.0f / D) + EPS); }
        if (MODE == 2) {
            f32x4 g[4];
#pragma unroll
            for (int j = 0; j < 4; ++j) g[j] = *(const f32x4*)(p.fnorm_g + NC(j));
#pragma unroll
            for (int j = 0; j < 4; ++j) {
#pragma unroll
                for (int q = 0; q < RB; ++q) __builtin_nontemporal_store(v[q][j] * rstd[q] * g[j], (f32x4*)(p.out + (size_t)(row0 + q) * D + NC(j))); }
        } else {
            float ga[RB][8]; f32x2_ ga2[RB][8];
#pragma unroll
            for (int q = 0; q < RB; ++q)
#pragma unroll
                for (int c = 0; c < 8; ++c) ga2[q][c] = (f32x2_){0.f, 0.f};
            f32x4 gA[4], shA[4], scA[4];
            { const int b = row0 >> 13; const float* mb = MOD + (size_t)(l * 4 + b) * 6144;
#pragma unroll
              for (int j = 0; j < 4; ++j) { const int n = NC(j); gA[j] = *(const f32x4*)(p.norm1_g + l * D + n); shA[j] = *(const f32x4*)(mb + n); scA[j] = *(const f32x4*)(mb + 1024 + n); } }
            unsigned hlo[RB];
#pragma unroll
            for (int j = 0; j < 4; ++j) {
                const f32x4 g = gA[j];
                f32x4 h[RB];
#pragma unroll
                for (int q = 0; q < RB; ++q) {
                    const f32x4 sh = shA[j], sc = scA[j];
                    h[q] = v[q][j] * rstd[q] * g * (sc + 1.0f) + sh;
                    const unsigned hw_ = pk4_fp8(h[q][0], h[q][1], h[q][2], h[q][3]);
                    if ((j & 1) == 0) hlo[q] = hw_;
                    else { u32x2 w2; w2.x = hlo[q]; w2.y = hw_; *(u32x2*)((unsigned char*)H + (size_t)(row0 + q) * D + 8 * lane + 512 * (j >> 1)) = w2; } }
#pragma unroll
                for (int c = 0; c < 8; ++c) { const f32x4 wv = *(const LAS f32x4*)(Wg + (j * 8 + c) * 256 + lane * 4);
#pragma unroll
                    for (int q = 0; q < RB; ++q) { const f32x2_ wa = {wv[0], wv[1]}, wb = {wv[2], wv[3]}, ha = {h[q][0], h[q][1]}, hb_ = {h[q][2], h[q][3]};
                        ga2[q][c] = ha * wa + ga2[q][c]; ga2[q][c] = hb_ * wb + ga2[q][c]; } }
                asm volatile("" ::: "memory");
            }
#pragma unroll
            for (int q = 0; q < RB; ++q)
#pragma unroll
                for (int c = 0; c < 8; ++c) ga[q][c] = ga2[q][c].x + ga2[q][c].y;
#pragma unroll
            for (int q = 0; q < RB; ++q) {
#pragma unroll
                for (int i = 0; i < 4; ++i) { const bool hi = (lane & 32) != 0; const float send = hi ? ga[q][i] : ga[q][i + 4]; const float keep = hi ? ga[q][i + 4] : ga[q][i]; ga[q][i] = keep + __shfl_xor(send, 32); }
#pragma unroll
                for (int i = 0; i < 2; ++i) { const bool hi = (lane & 16) != 0; const float send = hi ? ga[q][i] : ga[q][i + 2]; const float keep = hi ? ga[q][i + 2] : ga[q][i]; ga[q][i] = keep + __shfl_xor(send, 16); }
                { const bool hi = (lane & 8) != 0; const float send = hi ? ga[q][0] : ga[q][1]; const float keep = hi ? ga[q][1] : ga[q][0]; ga[q][0] = keep + __shfl_xor(send, 8); }
                float gs = ga[q][0]; gs += __shfl_xor(gs, 4); gs += __shfl_xor(gs, 2); gs += __shfl_xor(gs, 1);
                const int gi = lane >> 3, row = row0 + q;
                if ((lane & 7) == 0) {
                    const float t = gs + gb[gi];
                    const float cap = 15.0f * (1.0f - 2.0f * __builtin_amdgcn_rcpf(__expf(t * (2.0f / 15.0f)) + 1.0f));
                    if (gi < 4) IG[row * 4 + gi] = cap;
                    else LF[row * 4 + gi - 4] = fminf(cap, 0.f) - __logf(1.0f + __expf(-fabsf(cap)));
                }
            }
        }
    }
#undef NC
}

struct Rows4 { u32x4 a[4], b[4]; };
__device__ __forceinline__ void load_rows4(const bf16_t* Zb, int tpos, int zcol, Rows4& R) {
#pragma unroll
    for (int j = 0; j < 4; ++j) { const int tp = tpos - 3 + j;
        if (tp >= 0) { R.a[j] = *(const u32x4*)(Zb + (size_t)tp * NZ + zcol); R.b[j] = *(const u32x4*)(Zb + (size_t)tp * NZ + zcol + 8); }
        else { R.a[j] = (u32x4){0u, 0u, 0u, 0u}; R.b[j] = (u32x4){0u, 0u, 0u, 0u}; } }
}
__device__ __forceinline__ void conv16_lds(const Rows4& R, const LAS float* cwl, int ch0, float (&o)[16]) {
#pragma unroll
    for (int i4 = 0; i4 < 4; ++i4) { const f32x4 bb = *(const LAS f32x4*)(cwl + 1024 + ch0 + 4 * i4); o[4 * i4] = bb[0]; o[4 * i4 + 1] = bb[1]; o[4 * i4 + 2] = bb[2]; o[4 * i4 + 3] = bb[3]; }
#pragma unroll
    for (int j = 0; j < 4; ++j) {
        const unsigned w[8] = {R.a[j].x, R.a[j].y, R.a[j].z, R.a[j].w, R.b[j].x, R.b[j].y, R.b[j].z, R.b[j].w};
#pragma unroll
        for (int i4 = 0; i4 < 4; ++i4) { const f32x4 cw = *(const LAS f32x4*)(cwl + j * 256 + ch0 + 4 * i4);
            o[4 * i4] += cw[0] * bflo(w[2 * i4]); o[4 * i4 + 1] += cw[1] * bfhi(w[2 * i4]); o[4 * i4 + 2] += cw[2] * bflo(w[2 * i4 + 1]); o[4 * i4 + 3] += cw[3] * bfhi(w[2 * i4 + 1]); }
    }
#pragma unroll
    for (int i = 0; i < 16; ++i) o[i] = o[i] * __builtin_amdgcn_rcpf(1.0f + __builtin_amdgcn_exp2f(-1.4426950408889634f * o[i]));
}
__device__ __forceinline__ void load_conv_weights(const Params& p, int l, int hd, LAS float* cwl) {
    const int tid = otid();
#pragma unroll
    for (int i = tid; i < 1280; i += 512) { const int j = i >> 8, ch = i & 255; const int gch = (ch < 128 ? hd * 128 + ch : 512 + hd * 128 + (ch - 128));
        cwl[i] = (j < 4) ? p.conv_w[l * 4096 + j * 1024 + gch] : p.conv_b[l * 1024 + gch]; }
}
__device__ __forceinline__ void pack16(const float (&v)[16], float sc, u32x4& w0, u32x4& w1) {
    w0.x = pk2(v[0] * sc, v[1] * sc); w0.y = pk2(v[2] * sc, v[3] * sc); w0.z = pk2(v[4] * sc, v[5] * sc); w0.w = pk2(v[6] * sc, v[7] * sc);
    w1.x = pk2(v[8] * sc, v[9] * sc); w1.y = pk2(v[10] * sc, v[11] * sc); w1.z = pk2(v[12] * sc, v[13] * sc); w1.w = pk2(v[14] * sc, v[15] * sc);
}
__device__ __forceinline__ void mlstm_a_unit(const Params& p, int b, int hd, int c, LAS unsigned char* lds, const LAS float* cwl) {
    const int tid = otid(), lane = tid & 63, wave = __builtin_amdgcn_readfirstlane(tid >> 6), fr = lane & 15, fq = lane >> 4;
    const int uu = (b * 4 + hd) * 128 + c;
    LAS bf16_t* kw = (LAS bf16_t*)lds;
    LAS bf16_t* vs = (LAS bf16_t*)(lds + 17408);
    LAS float* ewl = (LAS float*)(lds + 34816);
    const bf16_t* Zb = WSP(bf16_t, WS_Z) + (size_t)b * SEQ * NZ;
    const int t0 = c * 64;
    const int t = tid >> 3, d0 = (tid & 7) * 16;
    Rows4 Rk; load_rows4(Zb, t0 + t, ZK + hd * 128 + d0, Rk);
    const bf16_t* vr = Zb + (size_t)(t0 + t) * NZ + ZV + hd * 128 + d0;
    const u32x4 va = *(const u32x4*)vr, vb = *(const u32x4*)(vr + 8);
    float ewt;
    {
        const int row = b * SEQ + t0 + lane;
        const float lf = WSP(float, WS_LF)[row * 4 + hd], ig = WSP(float, WS_IG)[row * 4 + hd];
        float bc = lf;
#pragma unroll
        for (int o = 1; o < 64; o <<= 1) { const float t_ = __shfl_up(bc, o); if (lane >= o) bc += t_; }
        const float g = __shfl(bc, 63);
        const float w = g - bc + ig;
        float wm = w;
#pragma unroll
        for (int o = 1; o < 64; o <<= 1) wm = fmaxf(wm, __shfl_xor(wm, o));
        const float ew = __expf(w - wm);
        ewt = __shfl(ew, t);
        if (tid == 0) { WSP(float, WS_G)[uu] = g; WSP(float, WS_WMAX)[uu] = wm; }
    }
    {
        float kc[16];
        conv16_lds(Rk, cwl, 128 + d0, kc);
        u32x4 w0, w1; pack16(kc, 0.08838834764831845f * ewt, w0, w1);
        *(LAS u32x4*)(kw + t * 136 + d0) = w0; *(LAS u32x4*)(kw + t * 136 + d0 + 8) = w1;
        *(LAS u32x4*)(vs + t * 136 + d0) = va; *(LAS u32x4*)(vs + t * 136 + d0 + 8) = vb;
        pack16(kc, 0.08838834764831845f, w0, w1);
        bf16_t* kcp = WSP(bf16_t, WS_KC) + (size_t)(b * SEQ + c * 64 + t) * 512 + hd * 128 + d0;
        *(u32x4*)kcp = w0; *(u32x4*)(kcp + 8) = w1;
    }
    __syncthreads();
    {
        const int q4 = (lane & 15) >> 2, p4 = lane & 3;
        const int wp = wave >> 1, eh = wave & 1;
        s16x4 ak[2][2][2];
#pragma unroll
        for (int n = 0; n < 2; ++n)
#pragma unroll
            for (int kk = 0; kk < 2; ++kk)
#pragma unroll
                for (int hf = 0; hf < 2; ++hf) ak[n][kk][hf] = TRREAD(kw + (kk * 32 + 8 * fq + 4 * hf + q4) * 136 + 32 * wp + 8 * p4 + 4 * n);
        if (eh == 0) {
            const unsigned o1 = 0x3f803f80u; const u32x4 ov = {o1, o1, o1, o1}; const bf16x8 ones = __builtin_bit_cast(bf16x8, ov);
            f32x4 s0 = (f32x4){0.f, 0.f, 0.f, 0.f}, s1 = (f32x4){0.f, 0.f, 0.f, 0.f};
#pragma unroll
            for (int kk = 0; kk < 2; ++kk) {
                const bf16x8 af0 = {ak[0][kk][0][0], ak[0][kk][0][1], ak[0][kk][0][2], ak[0][kk][0][3], ak[0][kk][1][0], ak[0][kk][1][1], ak[0][kk][1][2], ak[0][kk][1][3]};
                const bf16x8 af1 = {ak[1][kk][0][0], ak[1][kk][0][1], ak[1][kk][0][2], ak[1][kk][0][3], ak[1][kk][1][0], ak[1][kk][1][1], ak[1][kk][1][2], ak[1][kk][1][3]};
                s0 = MFMA16(af0, ones, s0); s1 = MFMA16(af1, ones, s1); }
            if (fr == 0) { float* ksp = WSP(float, WS_KS) + (size_t)uu * 128 + 32 * wp + 8 * fq;
                *(f32x4*)ksp = s0; *(f32x4*)(ksp + 4) = s1; }
        }
        bf16_t* CTg = WSP(bf16_t, WS_KVT) + (size_t)uu * 16384;
#pragma unroll
        for (int e4 = 0; e4 < 4; ++e4) {
            const int et = eh * 4 + e4;
            f32x4 acc0 = (f32x4){0.f, 0.f, 0.f, 0.f}, acc1 = (f32x4){0.f, 0.f, 0.f, 0.f};
#pragma unroll
            for (int kk = 0; kk < 2; ++kk) {
                const s16x4 b0 = TRREAD(vs + (kk * 32 + 8 * fq + q4) * 136 + et * 16 + 4 * p4), b1 = TRREAD(vs + (kk * 32 + 8 * fq + 4 + q4) * 136 + et * 16 + 4 * p4);
                const bf16x8 bf = {b0[0], b0[1], b0[2], b0[3], b1[0], b1[1], b1[2], b1[3]};
                const bf16x8 af0 = {ak[0][kk][0][0], ak[0][kk][0][1], ak[0][kk][0][2], ak[0][kk][0][3], ak[0][kk][1][0], ak[0][kk][1][1], ak[0][kk][1][2], ak[0][kk][1][3]};
                const bf16x8 af1 = {ak[1][kk][0][0], ak[1][kk][0][1], ak[1][kk][0][2], ak[1][kk][0][3], ak[1][kk][1][0], ak[1][kk][1][1], ak[1][kk][1][2], ak[1][kk][1][3]};
                acc0 = MFMA16(af0, bf, acc0); acc1 = MFMA16(af1, bf, acc1);
            }
            u32x4 w; w.x = pk2(acc0[0], acc0[1]); w.y = pk2(acc0[2], acc0[3]); w.z = pk2(acc1[0], acc1[1]); w.w = pk2(acc1[2], acc1[3]);
            *(u32x4*)(CTg + (et * 16 + fr) * 128 + 32 * wp + 8 * fq) = w;
        }
    }
    lds_barrier();
}
__device__ __forceinline__ void mlstm_b_unit(const Params& p, int u) {
    const int tid = otid(), lane = tid & 63;
    const int slice = u & 15, bh = u >> 4;
    bf16_t* base = WSP(bf16_t, WS_KVT) + (size_t)bh * 128 * 16384 + slice * 1024 + tid * 2;
    const float* Gs = WSP(float, WS_G) + bh * 128; const float* Wm = WSP(float, WS_WMAX) + bh * 128;
    float* MP = WSP(float, WS_MPREV) + bh * 128; float* KS = WSP(float, WS_KS) + (size_t)bh * 128 * 128;
    unsigned kv[128];
#pragma unroll
    for (int c = 0; c < 128; ++c) kv[c] = *(const unsigned*)(base + (size_t)c * 16384);
    float dec0, inj0, dec1, inj1, mp0, mp1;
    {
        const float g0 = Gs[lane], g1 = Gs[64 + lane], w0 = Wm[lane], w1 = Wm[64 + lane];
        float P0 = g0, P1 = g1;
#pragma unroll
        for (int o = 1; o < 64; o <<= 1) { const float t0 = __shfl_up(P0, o), t1 = __shfl_up(P1, o); if (lane >= o) { P0 += t0; P1 += t1; } }
        P1 += __shfl(P0, 63);
        float A0 = w0 - P0, A1 = w1 - P1;
#pragma unroll
        for (int o = 1; o < 64; o <<= 1) { const float t0 = __shfl_up(A0, o), t1 = __shfl_up(A1, o); if (lane >= o) { A0 = fmaxf(A0, t0); A1 = fmaxf(A1, t1); } }
        A1 = fmaxf(A1, __shfl(A0, 63));
        const float m0 = P0 + A0, m1 = P1 + A1;
        mp0 = __shfl_up(m0, 1); mp1 = __shfl_up(m1, 1);
        const float m0l = __shfl(m0, 63);
        if (lane == 0) { mp0 = -INFINITY; mp1 = m0l; }
        dec0 = __expf(g0 + mp0 - m0); inj0 = __expf(w0 - m0); dec1 = __expf(g1 + mp1 - m1); inj1 = __expf(w1 - m1);
        if (slice == 0 && tid < 64) { MP[lane] = mp0; MP[64 + lane] = mp1; }
    }
    float c0 = 0.f, c1 = 0.f;
#pragma unroll
    for (int c = 0; c < 128; ++c) {
        const float dec = __shfl(c < 64 ? dec0 : dec1, c & 63), inj = __shfl(c < 64 ? inj0 : inj1, c & 63);
        const unsigned w = kv[c];
        *(unsigned*)(base + (size_t)c * 16384) = pk2(c0, c1);
        c0 = dec * c0 + inj * bflo(w); c1 = dec * c1 + inj * bfhi(w);
    }
    if (slice == 0 && tid < 128) {
        float nst = 0.f;
#pragma unroll
        for (int cb = 0; cb < 128; cb += 32) {
            float ksv[32];
#pragma unroll
            for (int i = 0; i < 32; ++i) ksv[i] = KS[(cb + i) * 128 + tid];
#pragma unroll
            for (int i = 0; i < 32; ++i) { const int c = cb + i;
                const float dec = __shfl(c < 64 ? dec0 : dec1, c & 63), inj = __shfl(c < 64 ? inj0 : inj1, c & 63);
                KS[c * 128 + tid] = nst; nst = dec * nst + inj * ksv[i]; }
        }
    }
}
__device__ __forceinline__ void mlstm_c_unit(const Params& p, int l, int b, int hd, int c, LAS unsigned char* lds, const LAS float* cwl, const LAS float* gl) {
    const int tid = otid(), lane = tid & 63, wave = __builtin_amdgcn_readfirstlane(tid >> 6), fr = lane & 15, fq = lane >> 4;
    const int uu = (b * 4 + hd) * 128 + c;
    LAS bf16_t* qs = (LAS bf16_t*)lds;
    LAS bf16_t* ks = (LAS bf16_t*)(lds + 17408);
    LAS bf16_t* vs = (LAS bf16_t*)(lds + 34816);
    LAS bf16_t* CT = (LAS bf16_t*)(lds + 52224);
    LAS bf16_t* Ps = (LAS bf16_t*)(lds + 87040);
    LAS bf16_t* hb = ks;
    LAS float* sm = (LAS float*)(lds + 96256);
    LAS float* bcum = sm, *igb = sm + 64, *mtv = sm + 128, *inter = sm + 192, *emt = sm + 256, *den0 = sm + 320, *dpart = sm + 384  , *nprev = sm + 512  ;
    const bf16_t* Zb = WSP(bf16_t, WS_Z) + (size_t)b * SEQ * NZ;
    const int t0 = c * 64;
    const int t = tid >> 3, d0 = (tid & 7) * 16;
    Rows4 Rq; load_rows4(Zb, t0 + t, ZQ + hd * 128 + d0, Rq);
    const bf16_t* kcp = WSP(bf16_t, WS_KC) + (size_t)(b * SEQ + t0 + t) * 512 + hd * 128 + d0;
    const u32x4 kca = *(const u32x4*)kcp, kcb = *(const u32x4*)(kcp + 8);
    const bf16_t* zr = Zb + (size_t)(t0 + t) * NZ + hd * 128 + d0;
    const u32x4 va = *(const u32x4*)(zr + ZV), vb = *(const u32x4*)(zr + ZV + 8);
    const u32x4 oa = *(const u32x4*)(zr + ZO), ob = *(const u32x4*)(zr + ZO + 8);
    f32x4 npv[4];
#pragma unroll
    for (int i = 0; i < 4; ++i) npv[i] = *(const f32x4*)(WSP(float, WS_KS) + (size_t)uu * 128 + d0 + 4 * i);
    u32x4 ctv[4];
    { const bf16_t* KVT = WSP(bf16_t, WS_KVT) + (size_t)uu * 16384;
#pragma unroll
      for (int k = 0; k < 4; ++k) { const int id = tid + 512 * k; ctv[k] = *(const u32x4*)(KVT + (id >> 4) * 128 + (id & 15) * 8); } }
    if (tid < 64) {
        const int row = b * SEQ + t0 + tid;
        const float lf = WSP(float, WS_LF)[row * 4 + hd], ig = WSP(float, WS_IG)[row * 4 + hd];
        const float mp = WSP(float, WS_MPREV)[uu];
        float bc = lf;
#pragma unroll
        for (int o = 1; o < 64; o <<= 1) { const float t_ = __shfl_up(bc, o); if (lane >= o) bc += t_; }
        const float a_ = ig - bc;
        float cm = a_;
#pragma unroll
        for (int o = 1; o < 64; o <<= 1) { const float t_ = __shfl_up(cm, o); if (lane >= o) cm = fmaxf(cm, t_); }
        const float mt = bc + fmaxf(mp, cm);
        bcum[tid] = bc; igb[tid] = a_; mtv[tid] = mt; inter[tid] = __expf(bc + mp - mt); emt[tid] = __expf(-mt);
    }
    {
        float qc[16];
        conv16_lds(Rq, cwl, d0, qc);
        float dn = 0.f;
#pragma unroll
        for (int i = 0; i < 16; ++i) dn += qc[i] * npv[i >> 2][i & 3];
        dn += __shfl_xor(dn, 1); dn += __shfl_xor(dn, 2); dn += __shfl_xor(dn, 4);
        if ((tid & 7) == 0) den0[t] = dn;
        u32x4 w0, w1;
        pack16(qc, 1.0f, w0, w1);
        *(LAS u32x4*)(qs + t * 136 + d0) = w0; *(LAS u32x4*)(qs + t * 136 + d0 + 8) = w1;
        *(LAS u32x4*)(ks + t * 136 + d0) = kca; *(LAS u32x4*)(ks + t * 136 + d0 + 8) = kcb;
        *(LAS u32x4*)(vs + t * 136 + d0) = va; *(LAS u32x4*)(vs + t * 136 + d0 + 8) = vb;
#pragma unroll
        for (int k = 0; k < 4; ++k) { const int id = tid + 512 * k; *(LAS u32x4*)(CT + (id >> 4) * 136 + (id & 15) * 8) = ctv[k]; }
    }
    __syncthreads();
    {
        const int tt = wave >> 1;
        float rs[4] = {0.f, 0.f, 0.f, 0.f};
#pragma unroll
        for (int si = 0; si < 2; ++si) {
            const int ss = (wave & 1) * 2 + si;
            f32x4 acc = (f32x4){0.f, 0.f, 0.f, 0.f};
#pragma unroll
            for (int kk = 0; kk < 4; ++kk) { const bf16x8 a_ = *(const LAS bf16x8*)(qs + (tt * 16 + fr) * 136 + kk * 32 + 8 * fq);
                const bf16x8 bq = *(const LAS bf16x8*)(ks + (ss * 16 + fr) * 136 + kk * 32 + 8 * fq); acc = MFMA16(a_, bq, acc); }
            const int s_ = ss * 16 + fr; const float ib = igb[s_];
#pragma unroll
            for (int i = 0; i < 4; ++i) { const int tq = tt * 16 + 4 * fq + i;
                const float val = (s_ <= tq) ? acc[i] * __expf(bcum[tq] + ib - mtv[tq]) : 0.f;
                rs[i] += val; Ps[tq * 72 + s_] = (bf16_t)pk2(val, 0.f); }
        }
#pragma unroll
        for (int i = 0; i < 4; ++i) { float r_ = rs[i]; r_ += __shfl_xor(r_, 1); r_ += __shfl_xor(r_, 2); r_ += __shfl_xor(r_, 4); r_ += __shfl_xor(r_, 8);
            if (fr == 0) dpart[(wave & 1) * 64 + tt * 16 + 4 * fq + i] = r_; }
    }
    __syncthreads();
    {
        const int tt = wave >> 1;
        const int q4 = (lane & 15) >> 2, p4 = lane & 3;
        bf16x8 ap[2], aq[4];
#pragma unroll
        for (int kk = 0; kk < 2; ++kk) ap[kk] = *(const LAS bf16x8*)(Ps + (tt * 16 + fr) * 72 + kk * 32 + 8 * fq);
#pragma unroll
        for (int kk = 0; kk < 4; ++kk) aq[kk] = *(const LAS bf16x8*)(qs + (tt * 16 + fr) * 136 + kk * 32 + 8 * fq);
#pragma unroll
        for (int ei = 0; ei < 4; ++ei) {
            const int et = (wave & 1) * 4 + ei;
            f32x4 a1 = (f32x4){0.f, 0.f, 0.f, 0.f}, a2 = (f32x4){0.f, 0.f, 0.f, 0.f};
#pragma unroll
            for (int kk = 0; kk < 2; ++kk) {
                const s16x4 b0 = TRREAD(vs + (kk * 32 + 8 * fq + q4) * 136 + et * 16 + 4 * p4), b1 = TRREAD(vs + (kk * 32 + 8 * fq + 4 + q4) * 136 + et * 16 + 4 * p4);
                const bf16x8 bv = {b0[0], b0[1], b0[2], b0[3], b1[0], b1[1], b1[2], b1[3]};
                a1 = MFMA16(ap[kk], bv, a1); }
#pragma unroll
            for (int kk = 0; kk < 4; ++kk) { const bf16x8 bc = *(const LAS bf16x8*)(CT + (et * 16 + fr) * 136 + kk * 32 + 8 * fq); a2 = MFMA16(aq[kk], bc, a2); }
            const int e = et * 16 + fr;
#pragma unroll
            for (int i = 0; i < 4; ++i) { const int tq = tt * 16 + 4 * fq + i;
                const float num = a1[i] + inter[tq] * a2[i];
                const float den = inter[tq] * den0[tq] + dpart[tq] + dpart[64 + tq];
                hb[tq * 136 + e] = (bf16_t)pk2(num * __builtin_amdgcn_rcpf(fmaxf(fabsf(den), emt[tq])), 0.f); }
        }
    }
    __syncthreads();
    {
        const u32x4 h0 = *(const LAS u32x4*)(hb + t * 136 + d0), h1 = *(const LAS u32x4*)(hb + t * 136 + d0 + 8);
        const unsigned hw[8] = {h0.x, h0.y, h0.z, h0.w, h1.x, h1.y, h1.z, h1.w}, ow[8] = {oa.x, oa.y, oa.z, oa.w, ob.x, ob.y, ob.z, ob.w};
        float hv[16]; float ssq = 0.f;
#pragma unroll
        for (int i = 0; i < 8; ++i) { hv[2 * i] = bflo(hw[i]) * sigmoidf_(bflo(ow[i])); hv[2 * i + 1] = bfhi(hw[i]) * sigmoidf_(bfhi(ow[i])); }
#pragma unroll
        for (int i = 0; i < 16; ++i) ssq += hv[i] * hv[i];
        ssq += __shfl_xor(ssq, 1); ssq += __shfl_xor(ssq, 2); ssq += __shfl_xor(ssq, 4);
        const float r_ = __builtin_amdgcn_rsqf(ssq * (1.0f / 128.0f) + EPS);
#pragma unroll
        for (int i = 0; i < 16; ++i) hv[i] *= gl[d0 + i];
        u32x4 w0, w1; pack16(hv, r_, w0, w1);
        bf16_t* o = WSP(bf16_t, WS_CAT) + (size_t)(b * SEQ + t0 + t) * D + hd * 128 + d0;
        *(u32x4*)o = w0; *(u32x4*)(o + 8) = w1;
    }
    lds_barrier();
}

__device__ __forceinline__ void moba_prep_unit(const Params& p, int u, LAS unsigned char* lds) {
    const int tid = otid();
    const int qtr = u & 3, blk = (u >> 2) & 31, b = u >> 7;
    LAS float* cs = (LAS float*)lds; LAS float* sn = cs + 512;
    LAS bf16_t* kl = (LAS bf16_t*)(lds + 4096);
    const int r0 = b * SEQ + blk * 256 + qtr * 64;
    const int t = tid >> 3, h = tid & 7;
    bf16_t* zr = WSP(bf16_t, WS_Z) + (size_t)(r0 + t) * NZ + h * 64;
    u32x4 kq[8]; u32x4 qq[2];
#pragma unroll
    for (int c = 0; c < 8; ++c) kq[c] = *(const u32x4*)(zr + ZAK + 8 * c);
    qq[0] = *(const u32x4*)(zr + ZAQ); qq[1] = *(const u32x4*)(zr + ZAQ + 8);
    { const int i = tid & 7;
      const float inv = powf(500000.0f, -(float)(2 * i) / 16.0f);
      const float ang = (float)p.pos[r0 + t] * inv; float s_, c_; sincosf(ang, &s_, &c_); cs[tid] = c_; sn[tid] = s_; }
    __syncthreads();
    {
        float c8[8], s8[8];
#pragma unroll
        for (int i = 0; i < 8; ++i) { c8[i] = cs[t * 8 + i]; s8[i] = sn[t * 8 + i]; }
        unsigned* k0 = (unsigned*)&kq[0]; unsigned* k1 = (unsigned*)&kq[1]; unsigned* q0 = (unsigned*)&qq[0]; unsigned* q1 = (unsigned*)&qq[1];
#pragma unroll
        for (int w = 0; w < 4; ++w) {
            { const float a0 = bflo(k0[w]), a1 = bfhi(k0[w]), b0 = bflo(k1[w]), b1 = bfhi(k1[w]);
              k0[w] = pk2(a0 * c8[2 * w] - b0 * s8[2 * w], a1 * c8[2 * w + 1] - b1 * s8[2 * w + 1]);
              k1[w] = pk2(b0 * c8[2 * w] + a0 * s8[2 * w], b1 * c8[2 * w + 1] + a1 * s8[2 * w + 1]); }
            { const float a0 = bflo(q0[w]), a1 = bfhi(q0[w]), b0 = bflo(q1[w]), b1 = bfhi(q1[w]);
              q0[w] = pk2(a0 * c8[2 * w] - b0 * s8[2 * w], a1 * c8[2 * w + 1] - b1 * s8[2 * w + 1]);
              q1[w] = pk2(b0 * c8[2 * w] + a0 * s8[2 * w], b1 * c8[2 * w + 1] + a1 * s8[2 * w + 1]); }
        }
        *(u32x4*)(zr + ZAK) = kq[0]; *(u32x4*)(zr + ZAK + 8) = kq[1];
        *(u32x4*)(zr + ZAQ) = qq[0]; *(u32x4*)(zr + ZAQ + 8) = qq[1];
#pragma unroll
        for (int c = 0; c < 8; ++c) *(LAS u32x4*)(kl + (size_t)(t * 8 + h) * 72 + 8 * c) = kq[c];
    }
    __syncthreads();
    {
        const int hh = tid >> 6, d = tid & 63;
        float ksum = 0.f;
#pragma unroll 8
        for (int tt = 0; tt < 64; ++tt) ksum += bf2f(kl[(size_t)(tt * 8 + hh) * 72 + d]);
        WSP(float, WS_KPART)[((((size_t)(b * 8 + hh) * 32 + blk) * 4 + qtr) * 64) + d] = ksum;
    }
    lds_barrier();
}
__device__ __forceinline__ void moba_gate_unit(const Params& p, int l, int u, LAS unsigned char* lds) {
    const int tid = otid();
    const int tq = (u & 256) ? 15 - (u & 15) : (u & 15), h = (u >> 4) & 7, b = u >> 7;
    LAS float* km = (LAS float*)lds;
    LAS int* lcnt2 = (LAS int*)(lds + 8192);
    const float* KP = WSP(float, WS_KPART) + (size_t)(b * 8 + h) * 32 * 4 * 64;
#pragma unroll
    for (int i = tid; i < 2048; i += 512) { const int j = i >> 6, d = i & 63; const float* s = KP + (size_t)j * 256 + d;
        km[i] = (s[0] + s[64] + s[128] + s[192]) * (1.0f / 256.0f); }
    if (tid < 64) lcnt2[tid] = 0;
    __syncthreads();
    const int t = tq * 512 + tid, own = t >> 8, half = tid >> 8;
    const bf16_t* qr = WSP(bf16_t, WS_Z) + (size_t)(b * SEQ + t) * NZ + ZAQ + h * 64;
    float q[64];
#pragma unroll
    for (int k = 0; k < 8; ++k) { const u32x4 w = *(const u32x4*)(qr + 8 * k);
        q[8 * k] = bflo(w.x); q[8 * k + 1] = bfhi(w.x); q[8 * k + 2] = bflo(w.y); q[8 * k + 3] = bfhi(w.y); q[8 * k + 4] = bflo(w.z); q[8 * k + 5] = bfhi(w.z); q[8 * k + 6] = bflo(w.w); q[8 * k + 7] = bfhi(w.w); }
    float v0 = -INFINITY, v1 = -INFINITY, v2 = -INFINITY; int i0 = -1, i1 = -1, i2 = -1;
#pragma unroll 4
    for (int j = 0; j < own; ++j) {
        float s = 0.f;
#pragma unroll
        for (int d4 = 0; d4 < 16; ++d4) { const f32x4 kk = *(const LAS f32x4*)(km + j * 64 + 4 * d4); s += q[4 * d4] * kk[0] + q[4 * d4 + 1] * kk[1] + q[4 * d4 + 2] * kk[2] + q[4 * d4 + 3] * kk[3]; }
        if (s > v0) { v2 = v1; i2 = i1; v1 = v0; i1 = i0; v0 = s; i0 = j; }
        else if (s > v1) { v2 = v1; i2 = i1; v1 = s; i1 = j; }
        else if (s > v2) { v2 = s; i2 = j; }
    }
    bf16_t* QL = WSP(bf16_t, WS_QLIST) + (size_t)(b * 8 + h) * 32 * 8192;
    const int sel[3] = {i0, i1, i2};
#pragma unroll
    for (int s = 0; s < 3; ++s) { const int j = sel[s];
        if (j >= 0) { const int rank = __hip_atomic_fetch_add(lcnt2 + half * 32 + j, 1, __ATOMIC_RELAXED, __HIP_MEMORY_SCOPE_WORKGROUP);
            QL[(size_t)j * 8192 + own * 256 + rank] = (bf16_t)((t << 2) | s); } }
    QL[(size_t)own * 8192 + own * 256 + (t & 255)] = (bf16_t)((t << 2) | 3);
    __syncthreads();
    if (tid < 64) { const int hf = tid >> 5, j = tid & 31, jb = 2 * tq + hf;
        if (j <= jb) WSP(int, WS_SEGC)[((size_t)(b * 8 + h) * 32 + j) * 32 + jb] = (j == jb) ? 256 : lcnt2[hf * 32 + j]; }
    lds_barrier();
}
typedef float f32x2 __attribute__((ext_vector_type(2)));
__device__ __forceinline__ void attn_step(const bool own, const LAS bf16_t* Ks, const LAS bf16_t* Vs, LAS unsigned char* lds, const bf16_t* qp, int lane, int wave, int qg, bool valid, size_t pi,
                                          bf16_t* PO, float* PL) {
    const int r = lane & 31, hh = lane >> 5;
    const float C2 = 0.18033688011112042f;
    bf16x8 qb[4];
#pragma unroll
    for (int s4 = 0; s4 < 4; ++s4) qb[s4] = *(const bf16x8*)(qp + 16 * s4);
    f32x16 X[8];
    const int ktmax = own ? qg : 7;
    {
        bf16x8 ka[2][4];
#pragma unroll
        for (int s4 = 0; s4 < 4; ++s4) ka[0][s4] = *(const LAS bf16x8*)(Ks + r * 72 + 16 * s4 + 8 * hh);
#pragma unroll
        for (int kt = 0; kt < 8; ++kt) {
            if (kt > ktmax) break;
            if (kt < 7) {
#pragma unroll
                for (int s4 = 0; s4 < 4; ++s4) ka[(kt + 1) & 1][s4] = *(const LAS bf16x8*)(Ks + ((kt + 1) * 32 + r) * 72 + 16 * s4 + 8 * hh);
            }
            __builtin_amdgcn_sched_barrier(0);
            f32x16 acc;
#pragma unroll
            for (int i = 0; i < 16; ++i) acc[i] = 0.f;
#pragma unroll
            for (int s4 = 0; s4 < 4; ++s4) acc = MFMA32(ka[kt & 1][s4], qb[s4], acc);
            X[kt] = acc;
            __builtin_amdgcn_sched_barrier(0);
        }
    }
    if (own) {
        int thr = r - 4 * hh;
        asm volatile("" : "+v"(thr));
#pragma unroll
        for (int kt = 0; kt < 8; ++kt) {
            if (kt == qg) {
#pragma unroll
                for (int i = 0; i < 16; ++i) { if ((i & 3) + 8 * (i >> 2) > thr) X[kt][i] = -INFINITY; }
                asm volatile("" : "+v"(X[kt]));
            }
        }
    }
    float mx = -INFINITY;
#pragma unroll
    for (int kt = 0; kt < 8; ++kt) {
        if (kt > ktmax) break;
#pragma unroll
        for (int i = 0; i < 16; ++i) mx = fmaxf(mx, X[kt][i]); }
    mx = fmaxf(mx, __shfl_xor(mx, 32));
    const f32x2 c2v = {C2, C2}, mcv = {mx * C2, mx * C2};
    f32x2 ls2 = {0.f, 0.f};
#pragma unroll
    for (int kt = 0; kt < 8; ++kt) {
        if (kt > ktmax) break;
#pragma unroll
        for (int i = 0; i < 8; ++i) { const f32x2 xv = {X[kt][2 * i], X[kt][2 * i + 1]}; const f32x2 tv = xv * c2v - mcv;
            f32x2 pv; pv.x = __builtin_amdgcn_exp2f(tv.x); pv.y = __builtin_amdgcn_exp2f(tv.y); X[kt][2 * i] = pv.x; X[kt][2 * i + 1] = pv.y; ls2 += pv; } }
    float ls = ls2.x + ls2.y;
    ls += __shfl_xor(ls, 32);
    f32x16 O0, O1;
#pragma unroll
    for (int i = 0; i < 16; ++i) { O0[i] = 0.f; O1[i] = 0.f; }
    {
        const int vq = (lane & 15) >> 2, vp = lane & 3, vg = (lane >> 4) & 1;
        const LAS bf16_t* vbase = Vs + (4 * hh + vq) * 72 + 16 * vg + 4 * vp;
        s16x4 tv[2][4];
#pragma unroll
        for (int q4 = 0; q4 < 4; ++q4) tv[0][q4] = TRREAD(vbase + (q4 & 1) * 8 * 72 + (q4 >> 1) * 32);
#pragma unroll
        for (int it = 0; it < 16; ++it) {
            const int kt = it >> 1, s2 = it & 1;
            if (kt > ktmax) break;
            if (it < 15) {
                const LAS bf16_t* vb = vbase + (it + 1) * 16 * 72;
#pragma unroll
                for (int q4 = 0; q4 < 4; ++q4) tv[(it + 1) & 1][q4] = TRREAD(vb + (q4 & 1) * 8 * 72 + (q4 >> 1) * 32);
            }
            __builtin_amdgcn_sched_barrier(0);
            bf16x8 pf;
            { const unsigned w0 = pg8::cvt_pk_bf16(X[kt][8 * s2 + 0], X[kt][8 * s2 + 1]), w1 = pg8::cvt_pk_bf16(X[kt][8 * s2 + 2], X[kt][8 * s2 + 3]),
                             w2 = pg8::cvt_pk_bf16(X[kt][8 * s2 + 4], X[kt][8 * s2 + 5]), w3 = pg8::cvt_pk_bf16(X[kt][8 * s2 + 6], X[kt][8 * s2 + 7]);
              const u32x4 w = {w0, w1, w2, w3}; pf = __builtin_bit_cast(bf16x8, w); }
            const s16x4 a0 = tv[it & 1][0], a1 = tv[it & 1][1], c0 = tv[it & 1][2], c1 = tv[it & 1][3];
            const bf16x8 va = {a0[0], a0[1], a0[2], a0[3], a1[0], a1[1], a1[2], a1[3]};
            const bf16x8 vc = {c0[0], c0[1], c0[2], c0[3], c1[0], c1[1], c1[2], c1[3]};
            O0 = MFMA32(va, pf, O0); O1 = MFMA32(vc, pf, O1);
            __builtin_amdgcn_sched_barrier(0);
        }
    }
    {
        LAS bf16_t* Ost = (LAS bf16_t*)(lds + 73728 + 256 + wave * 4608);
        const float inv = __builtin_amdgcn_rcpf(ls);
#pragma unroll
        for (int g4 = 0; g4 < 4; ++g4) {
            u32x2 w0, w1;
            w0.x = pg8::cvt_pk_bf16(O0[4 * g4] * inv, O0[4 * g4 + 1] * inv); w0.y = pg8::cvt_pk_bf16(O0[4 * g4 + 2] * inv, O0[4 * g4 + 3] * inv);
            w1.x = pg8::cvt_pk_bf16(O1[4 * g4] * inv, O1[4 * g4 + 1] * inv); w1.y = pg8::cvt_pk_bf16(O1[4 * g4 + 2] * inv, O1[4 * g4 + 3] * inv);
            *(LAS u32x2*)(Ost + r * 72 + 8 * g4 + 4 * hh) = w0; *(LAS u32x2*)(Ost + r * 72 + 32 + 8 * g4 + 4 * hh) = w1;
        }
        LDS_WAIT();
        u32x4 ov[4];
#pragma unroll
        for (int k = 0; k < 4; ++k) ov[k] = *(const LAS u32x4*)(Ost + r * 72 + 32 * hh + 8 * k);
        if (valid) {
            bf16_t* po = PO + pi * 64 + 32 * hh;
#pragma unroll
            for (int k = 0; k < 4; ++k) *(u32x4*)(po + 8 * k) = ov[k];
            if (hh == 0) PL[pi] = mx * 0.125f + __logf(ls);
        }
        LDS_WAIT();
    }
}
__device__ __forceinline__ void moba_attn_unit(const Params& p, int l, int li, int ch, LAS unsigned char* lds) {
    const int tid = otid(), lane = tid & 63, wave = __builtin_amdgcn_readfirstlane(tid >> 6), r = lane & 31, hh = lane >> 5;
    const int j = li & 31, h = (li >> 5) & 7, b = li >> 8;
    LAS bf16_t* Ks = (LAS bf16_t*)lds;
    LAS bf16_t* Vs = (LAS bf16_t*)(lds + 36864);
    LAS int* segp = (LAS int*)(lds + 73728);
    const bf16_t* Z = WSP(bf16_t, WS_Z);
    const size_t kr0 = (size_t)(b * SEQ + j * 256);
    u32x4 kreg[4], vreg[4];
#pragma unroll
    for (int i = 0; i < 4; ++i) { const int id = tid + 512 * i, key = id >> 3, part = id & 7;
        const bf16_t* src = Z + (kr0 + key) * NZ + h * 64 + part * 8;
        kreg[i] = *(const u32x4*)(src + ZAK); vreg[i] = *(const u32x4*)(src + ZAV); }
    if (tid < 64) { const int c = (lane < 32 && lane >= j) ? WSP(int, WS_SEGC)[(size_t)li * 32 + lane] : 0; int inc = c;
#pragma unroll
        for (int o = 1; o < 32; o <<= 1) { const int t_ = __shfl_up(inc, o); if (lane >= o) inc += t_; }
        if (lane < 32) segp[lane + 1] = inc; if (lane == 0) segp[0] = 0; }
    __syncthreads();
    const bf16_t* QL = WSP(bf16_t, WS_QLIST) + (size_t)li * 8192;
    const int n = segp[32];
    unsigned ents[4];
    const int qg = wave < 4 ? wave : 11 - wave;
#pragma unroll
    for (int st = 0; st < 4; ++st) { const int ridx = ch * 1024 + st * 256 + qg * 32 + r; unsigned e = 0u;
        if (ridx < n) { int jb = 0;
#pragma unroll
            for (int st_ = 16; st_ >= 1; st_ >>= 1) jb += (segp[jb + st_] <= ridx) ? st_ : 0;
            e = (unsigned)QL[jb * 256 + (ridx - segp[jb])]; }
        ents[st] = e; }
#pragma unroll
    for (int i = 0; i < 4; ++i) { const int id = tid + 512 * i, key = id >> 3, part = id & 7;
        *(LAS u32x4*)(Ks + key * 72 + part * 8) = kreg[i];
        *(LAS u32x4*)(Vs + key * 72 + part * 8) = vreg[i]; }
    const bf16_t* qbase = Z + (size_t)b * SEQ * NZ + ZAQ + h * 64 + 8 * hh;
    __syncthreads();
    bf16_t* PO = WSP(bf16_t, WS_PARTO); float* PL = WSP(float, WS_PARTL);
    const size_t pbase = (size_t)(b * 8 + h) * SEQ;
    for (int step = 0; step < 4; ++step) {
        const int rbase = ch * 1024 + step * 256;
        if (rbase >= n) break;
        const int ridx = rbase + qg * 32 + r;
        const unsigned ent = step == 0 ? ents[0] : step == 1 ? ents[1] : step == 2 ? ents[2] : ents[3];
        const size_t pi = (pbase + (ent >> 2)) * 4 + (ent & 3u);
        const bf16_t* qp = qbase + (size_t)(ent >> 2) * NZ;
        if (rbase + qg * 32 < n) attn_step(rbase == 0, Ks, Vs, lds, qp, lane, wave, qg, ridx < n, pi, PO, PL);
    }
    lds_barrier();
}
__device__ __forceinline__ void moba_combine_phase(const Params& p) {
    const int tid = otid(), lane = tid & 63, wave = __builtin_amdgcn_readfirstlane(tid >> 6);
    const int gw = blockIdx.x * 8 + wave, NGW = gridDim.x * 8;
    const bf16_t* PO = WSP(bf16_t, WS_PARTO); const float* PL = WSP(float, WS_PARTL);
    bf16_t* CAT = WSP(bf16_t, WS_CAT);
    const int h = lane >> 3, part = lane & 7;
    constexpr int RB = 4;
    float lseN[RB][4]; u32x4 pvN[RB][4];
    auto load_rows = [&](int r0) __attribute__((always_inline)) {
#pragma unroll
        for (int q = 0; q < RB; ++q) { const int row = (r0 + q < T) ? r0 + q : T - 1, b = row >> 13, t = row & 8191;
            const size_t pi = ((size_t)(b * 8 + h) * SEQ + t) * 4;
#pragma unroll
            for (int s_ = 0; s_ < 4; ++s_) { lseN[q][s_] = PL[pi + s_]; pvN[q][s_] = *(const u32x4*)(PO + (pi + s_) * 64 + part * 8); } }
    };
    load_rows(gw * RB);
    for (int row0 = gw * RB; row0 < T; row0 += NGW * RB) {
        float lse[RB][4]; u32x4 pv[RB][4];
#pragma unroll
        for (int q = 0; q < RB; ++q)
#pragma unroll
            for (int s_ = 0; s_ < 4; ++s_) { lse[q][s_] = lseN[q][s_]; pv[q][s_] = pvN[q][s_]; }
        if (row0 + NGW * RB < T) load_rows(row0 + NGW * RB);
#pragma unroll
        for (int q = 0; q < RB; ++q) { const int row = row0 + q, t = row & 8191, own = t >> 8, nsel = own < 3 ? own : 3;
            float M = -INFINITY;
#pragma unroll
            for (int s_ = 0; s_ < 4; ++s_) { const bool ok = (s_ == 3) || (s_ < nsel); lse[q][s_] = ok ? lse[q][s_] : -INFINITY; M = fmaxf(M, lse[q][s_]); }
            float acc[8]; float wsum = 0.f;
#pragma unroll
            for (int i = 0; i < 8; ++i) acc[i] = 0.f;
#pragma unroll
            for (int s_ = 0; s_ < 4; ++s_) { const bool ok = (s_ == 3) || (s_ < nsel);
                const float w = ok ? __expf(lse[q][s_] - M) : 0.f; wsum += w;
                u32x4 v = pv[q][s_]; if (!ok) v = (u32x4){0u, 0u, 0u, 0u};
                acc[0] += w * bflo(v.x); acc[1] += w * bfhi(v.x); acc[2] += w * bflo(v.y); acc[3] += w * bfhi(v.y);
                acc[4] += w * bflo(v.z); acc[5] += w * bfhi(v.z); acc[6] += w * bflo(v.w); acc[7] += w * bfhi(v.w); }
            const float inv = __builtin_amdgcn_rcpf(wsum);
            u32x4 o; o.x = pk2(acc[0] * inv, acc[1] * inv); o.y = pk2(acc[2] * inv, acc[3] * inv); o.z = pk2(acc[4] * inv, acc[5] * inv); o.w = pk2(acc[6] * inv, acc[7] * inv);
            *(u32x4*)(CAT + (size_t)row * D + 512 + h * 64 + part * 8) = o; }
    }
}

__device__ __forceinline__ void mlstm_unit_of(int u, int& b, int& hd, int& c) {
    const int G = gridDim.x;
    if ((G & 3) == 0) { const int blk = u % G, i = u / G; hd = blk & 3; const int rest = (blk >> 2) + (G >> 2) * i; b = rest >> 7; c = rest & 127; }
    else { c = u & 127; hd = (u >> 7) & 3; b = u >> 9; }
}
__device__ __forceinline__ void mix_a_phase(const Params& p, int l, LAS unsigned char* lds) {
    REP(3) {
        LAS float* cwl = (LAS float*)(lds + 35840);
        int cur_hd = -1;
        for (int u = blockIdx.x; u < 2048; u += gridDim.x) {
            int b, hd, c; mlstm_unit_of(u, b, hd, c);
            if (hd != cur_hd) { __syncthreads(); load_conv_weights(p, l, hd, cwl); cur_hd = hd; __syncthreads(); }
            mlstm_a_unit(p, b, hd, c, lds, cwl);
        }
    }
    for (int u = blockIdx.x; u < 512; u += gridDim.x) moba_prep_unit(p, u, lds);
}
__device__ __forceinline__ void mix_b_phase(const Params& p, int l, LAS unsigned char* lds) {
    for (int u = blockIdx.x; u < 256 + 512; u += gridDim.x) {
        if (u < 256) mlstm_b_unit(p, u); else { REP(4) moba_gate_unit(p, l, u - 256, lds); }
    }
}
__device__ __forceinline__ void mix_c_phase(const Params& p, int l, LAS unsigned char* lds) {
    const int tid = otid(), lane = tid & 63, wave = tid >> 6;
    LAS int* pre = (LAS int*)(lds + 139264);
    LAS int* wt = pre + 1032;
    {
        const int* SEGC = WSP(int, WS_SEGC);
        int n0 = 0, n1 = 0;
        { const int j0 = (2 * tid) & 31, j1 = (2 * tid + 1) & 31;
#pragma unroll
          for (int k = 0; k < 8; ++k) { const u32x4 c0 = *(const u32x4*)(SEGC + (size_t)(2 * tid) * 32 + 4 * k), c1 = *(const u32x4*)(SEGC + (size_t)(2 * tid + 1) * 32 + 4 * k);
              n0 += (4 * k >= j0 ? (int)c0.x : 0) + (4 * k + 1 >= j0 ? (int)c0.y : 0) + (4 * k + 2 >= j0 ? (int)c0.z : 0) + (4 * k + 3 >= j0 ? (int)c0.w : 0);
              n1 += (4 * k >= j1 ? (int)c1.x : 0) + (4 * k + 1 >= j1 ? (int)c1.y : 0) + (4 * k + 2 >= j1 ? (int)c1.z : 0) + (4 * k + 3 >= j1 ? (int)c1.w : 0); } }
        const int a0 = (n0 + 1023) >> 10, a1 = (n1 + 1023) >> 10;
        const int s = a0 + a1; int inc = s;
#pragma unroll
        for (int o = 1; o < 64; o <<= 1) { const int t = __shfl_up(inc, o); if (lane >= o) inc += t; }
        if (lane == 63) wt[wave] = inc;
        __syncthreads();
        int wp = 0;
        for (int w = 0; w < wave; ++w) wp += wt[w];
        const int ex = wp + inc - s;
        pre[2 * tid] = ex; pre[2 * tid + 1] = ex + a0;
        if (tid == 511) pre[1024] = ex + s;
        __syncthreads();
    }
    const int NU = pre[1024];
#if defined(DIAG_MIXC)
    unsigned long long tm = 0ull, ta = 0ull;
#endif
    int cur_hd = -1;
    unsigned* wq = WSP(unsigned, WS_CTL) + CW_WQ + l * 64;
    LAS int* tick = (LAS int*)(lds + 143440);
    const int total = 2048 + NU;
    if (tid == 0) tick[0] = (int)atomicAdd(wq, 1u);
    __syncthreads();
    int par = 0;
    const bool wave0 = __builtin_amdgcn_readfirstlane(tid >> 6) == 0;
    for (int u = tick[0]; u < total; ) {
        unsigned tk_ = 0u;
        if (wave0) { unsigned long long sv_; const unsigned zero_ = 0u, one_ = 1u;
            asm volatile("s_mov_b64 %1, exec\n\ts_mov_b64 exec, 1\n\tglobal_atomic_add %0, %2, %3, %4 sc0\n\ts_mov_b64 exec, %1"
                         : "=&v"(tk_), "=&s"(sv_) : "v"(zero_), "v"(one_), "s"(wq) : "memory"); }
#if defined(DIAG_MIXC)
        const unsigned long long t0 = __builtin_amdgcn_s_memrealtime();
#endif
        if (u >= NU) {
            const int q = u - NU; const int hd_ = q >> 9, b_ = (q >> 7) & 3, c_ = q & 127;
            LAS float* cw4 = (LAS float*)(lds + 98816);
            if (cur_hd < 0) { __syncthreads();
                _Pragma("unroll") for (int hd4 = 0; hd4 < 4; ++hd4) { load_conv_weights(p, l, hd4, cw4 + hd4 * 1408); if (threadIdx.x < 128) cw4[hd4 * 1408 + 1280 + threadIdx.x] = p.mnorm_g[l * 512 + hd4 * 128 + threadIdx.x]; }
                cur_hd = 0; __syncthreads(); }
            const LAS float* cwl = cw4 + hd_ * 1408; const LAS float* gl = cwl + 1280;
            mlstm_c_unit(p, l, b_, hd_, c_, lds, cwl, gl);
        }
        else {
            int lo = 0, hi = 1024;
            while (hi - lo > 1) { const int mid = (lo + hi) >> 1; if (pre[mid] <= u) lo = mid; else hi = mid; }
            moba_attn_unit(p, l, lo, u - pre[lo], lds);
            cur_hd = -1;
        }
#if defined(DIAG_MIXC)
        const unsigned long long t1 = __builtin_amdgcn_s_memrealtime();
        if (u >= NU) tm += t1 - t0; else ta += t1 - t0;
#endif
        if (wave0) { asm volatile("s_waitcnt vmcnt(4)" : "+v"(tk_) : : "memory"); if (lane == 0) tick[par ^ 1] = (int)tk_; }
        lds_barrier();
        par ^= 1; u = tick[par];
    }
#if defined(DIAG_MIXC)
    if (l == 0 && threadIdx.x == 0) { volatile unsigned long long* w = (volatile unsigned long long*)(p.ws + WS_CTL + 528384) + (size_t)blockIdx.x * 64; w[2 * 30] = 0ull; w[2 * 30 + 1] = DIAG_MIXC ? ta : tm; }
#endif
}

template <bool DRY>
__device__ __forceinline__ void router_phase(const Params& p, int l, LAS unsigned char* lds) {
    const int tid = otid(), lane = tid & 63, wave = __builtin_amdgcn_readfirstlane(tid >> 6);
    LAS bf16_t* Whi = (LAS bf16_t*)lds;
    LAS bf16_t* Wlo = (LAS bf16_t*)(lds + 66048);
    LAS float* cb = (LAS float*)(lds + 132096);
    LAS float* red = (LAS float*)(lds + 132224);
    LAS int* lcnt = (LAS int*)(lds + 135168);
    LAS int* lbase = lcnt + 32;
    LAS unsigned* lsel = (LAS unsigned*)(lcnt + 64);
    LAS float* gsc = (LAS float*)(lds + 137472);
    LAS float* shb = gsc + 1024;
    const int G = gridDim.x, rows_per = (T + G - 1) / G;
    const int r_lo = blockIdx.x * rows_per, r_hi = (r_lo + rows_per < T) ? r_lo + rows_per : T;
    const int bb = r_lo >> 13;
    const float* MOD = WSP(float, WS_MOD);
    const float* mb = MOD + (size_t)(l * 4 + bb) * 6144;
    const float* wr = p.w_router + (size_t)l * 1024 * 32;
#pragma unroll
    for (int i = tid; i < 1024; i += 512) { gsc[i] = p.norm2_g[l * D + i] * (mb[4096 + i] + 1.0f); shb[i] = mb[3072 + i]; }
    if (tid < 32) lcnt[tid] = 0;
    __syncthreads();
    {
        const int e = tid & 31, part = tid >> 5;
        float cs_ = 0.f;
#pragma unroll 16
        for (int i = tid; i < 32768; i += 512) { const int n = i >> 5;
            const float w0 = wr[i]; cs_ += shb[n] * w0;
            const float w = w0 * gsc[n]; const unsigned hi = pk2(w, 0.f) & 0xffffu; const unsigned lo = pk2(w - bf2f(hi), 0.f) & 0xffffu;
            Whi[e * 1032 + n] = (bf16_t)hi; Wlo[e * 1032 + n] = (bf16_t)lo; }
        red[part * 32 + e] = cs_;
    }
    __syncthreads();
    if (tid < 32) { float c_ = p.b_router[l * 32 + tid];
#pragma unroll
        for (int k = 0; k < 16; ++k) c_ += red[k * 32 + tid];
        cb[tid] = c_; }
    __syncthreads();
    const bf16_t* X = WSP(bf16_t, WS_X); unsigned char* H8 = WSP(unsigned char, WS_H);
    float* PROB = WSP(float, WS_PROB);
    const int r = lane & 15, q = lane >> 4;
    for (int tile0 = r_lo + wave * 16; tile0 < r_hi; tile0 += 128) {
        const int row = (tile0 + r < r_hi) ? tile0 + r : r_hi - 1;
        const bf16_t* xr = X + (size_t)row * D + 8 * q;
        f32x4 acc0 = (f32x4){0.f, 0.f, 0.f, 0.f}, acc1 = (f32x4){0.f, 0.f, 0.f, 0.f};
        float ss = 0.f;
#pragma unroll 4
        for (int s_ = 0; s_ < 32; ++s_) {
            const u32x4 xw = *(const u32x4*)(xr + 32 * s_);
            const f32x4 xa = {bflo(xw.x), bfhi(xw.x), bflo(xw.y), bfhi(xw.y)}, xb = {bflo(xw.z), bfhi(xw.z), bflo(xw.w), bfhi(xw.w)};
            ss += (xa[0] * xa[0] + xa[1] * xa[1]) + (xa[2] * xa[2] + xa[3] * xa[3]) + (xb[0] * xb[0] + xb[1] * xb[1]) + (xb[2] * xb[2] + xb[3] * xb[3]);
            const float xv[8] = {xa[0], xa[1], xa[2], xa[3], xb[0], xb[1], xb[2], xb[3]};
            unsigned hw[4], lw[4];
#pragma unroll
            for (int k = 0; k < 4; ++k) { hw[k] = pk2(xv[2 * k], xv[2 * k + 1]);
                lw[k] = pk2(xv[2 * k] - bflo(hw[k]), xv[2 * k + 1] - bfhi(hw[k])); }
            const u32x4 hv = {hw[0], hw[1], hw[2], hw[3]}, lv = {lw[0], lw[1], lw[2], lw[3]};
            const bf16x8 ah = __builtin_bit_cast(bf16x8, hv), al = __builtin_bit_cast(bf16x8, lv);
            const bf16x8 bh0 = *(const LAS bf16x8*)(Whi + r * 1032 + 32 * s_ + 8 * q), bl0 = *(const LAS bf16x8*)(Wlo + r * 1032 + 32 * s_ + 8 * q);
            const bf16x8 bh1 = *(const LAS bf16x8*)(Whi + (16 + r) * 1032 + 32 * s_ + 8 * q), bl1 = *(const LAS bf16x8*)(Wlo + (16 + r) * 1032 + 32 * s_ + 8 * q);
            acc0 = MFMA16(ah, bh0, acc0); acc0 = MFMA16(ah, bl0, acc0); acc0 = MFMA16(al, bh0, acc0);
            acc1 = MFMA16(ah, bh1, acc1); acc1 = MFMA16(ah, bl1, acc1); acc1 = MFMA16(al, bh1, acc1);
        }
        ss += __shfl_xor(ss, 16); ss += __shfl_xor(ss, 32);
        const float rstd = __builtin_amdgcn_rsqf(ss * (1.0f / D) + EPS);
        const float cb0 = cb[r], cb1 = cb[16 + r];
#pragma unroll
        for (int i = 0; i < 4; ++i) {
            const float rs = __shfl(rstd, 4 * q + i);
            const float l0 = rs * acc0[i] + cb0, l1 = rs * acc1[i] + cb1;
            unsigned u0 = __builtin_bit_cast(unsigned, l0); u0 = (u0 & 0x80000000u) ? ~u0 : (u0 | 0x80000000u);
            unsigned u1 = __builtin_bit_cast(unsigned, l1); u1 = (u1 & 0x80000000u) ? ~u1 : (u1 | 0x80000000u);
            unsigned k0 = (u0 & ~31u) | (unsigned)(31 - r), k1 = (u1 & ~31u) | (unsigned)(15 - r);
            float tv[4]; int te[4];
#pragma unroll
            for (int k = 0; k < 4; ++k) {
                unsigned m = k0 > k1 ? k0 : k1;
#pragma unroll
                for (int o = 1; o < 16; o <<= 1) { const unsigned t_ = (unsigned)__shfl_xor((int)m, o); m = t_ > m ? t_ : m; }
                te[k] = 31 - (int)(m & 31u);
                const unsigned ub = m & ~31u; const unsigned fb = (ub & 0x80000000u) ? (ub & 0x7fffffffu) : ~ub;
                tv[k] = __builtin_bit_cast(float, fb);
                if (k0 == m) k0 = 0u; if (k1 == m) k1 = 0u;
            }
            const float e1 = __expf(tv[1] - tv[0]), e2 = __expf(tv[2] - tv[0]), e3 = __expf(tv[3] - tv[0]);
            const float inv = __builtin_amdgcn_rcpf(1.0f + e1 + e2 + e3);
            const int rowi = tile0 + 4 * q + i;
            if (r < 4 && rowi < r_hi) {
                const float pr = (r == 0 ? 1.0f : r == 1 ? e1 : r == 2 ? e2 : e3) * inv;
                const int e = r == 0 ? te[0] : r == 1 ? te[1] : r == 2 ? te[2] : te[3];
                PROB[rowi * 4 + r] = pr;
                if (!DRY) { const int rl = __hip_atomic_fetch_add(lcnt + e, 1, __ATOMIC_RELAXED, __HIP_MEMORY_SCOPE_WORKGROUP);
                    lsel[(rowi - r_lo) * 4 + r] = (unsigned)e | ((unsigned)rl << 8); }
            }
        }
        if (tile0 + r < r_hi) {
            unsigned char* hr = H8 + (size_t)row * D + 8 * q;
            u32x4 xc[4], xn[4];
#pragma unroll
            for (int i = 0; i < 4; ++i) xc[i] = *(const u32x4*)(xr + 32 * i);
#pragma unroll
            for (int bt = 0; bt < 8; ++bt) {
                if (bt < 7) {
#pragma unroll
                    for (int i = 0; i < 4; ++i) xn[i] = *(const u32x4*)(xr + 32 * (4 * (bt + 1) + i));
                }
#pragma unroll
                for (int i = 0; i < 4; ++i) { const int s_ = 4 * bt + i; const u32x4 xw = xc[i];
                    const f32x4 xa = {bflo(xw.x), bfhi(xw.x), bflo(xw.y), bfhi(xw.y)}, xb = {bflo(xw.z), bfhi(xw.z), bflo(xw.w), bfhi(xw.w)};
                    const f32x4 ga = *(const LAS f32x4*)(gsc + 32 * s_ + 8 * q), gb = *(const LAS f32x4*)(gsc + 32 * s_ + 8 * q + 4);
                    const f32x4 sa = *(const LAS f32x4*)(shb + 32 * s_ + 8 * q), sb = *(const LAS f32x4*)(shb + 32 * s_ + 8 * q + 4);
                    const f32x4 ha = xa * rstd * ga + sa, hb_ = xb * rstd * gb + sb;
                    u32x2 w; w.x = pk4_fp8(ha[0], ha[1], ha[2], ha[3]); w.y = pk4_fp8(hb_[0], hb_[1], hb_[2], hb_[3]);
                    *(u32x2*)(hr + 32 * s_) = w; }
#pragma unroll
                for (int i = 0; i < 4; ++i) xc[i] = xn[i];
            }
        }
    }
    __syncthreads();
    if (DRY) return;
    unsigned* ECNT = WSP(unsigned, WS_CTL) + CW_ECNT + l * 64;
    if (tid < 32) lbase[tid] = (int)atomicAdd(&ECNT[tid], (unsigned)lcnt[tid]);
    __syncthreads();
    unsigned* PE = WSP(unsigned, WS_PE); int* EL = WSP(int, WS_ELIST);
    for (int i = tid; i < (r_hi - r_lo) * 4; i += 512) {
        const unsigned s = lsel[i]; const int e = s & 255u, rank = lbase[e] + (int)(s >> 8);
        const int row = r_lo + (i >> 2);
        PE[row * 4 + (i & 3)] = (unsigned)e | ((unsigned)rank << 8);
        EL[e * 32768 + rank] = row;
    }
    __syncthreads();
}

#define HAS(k) ((MASK >> (k)) & 1u)
#if defined(DIAG_LASTPH)
#define IN(k) (lo <= (k) && (k) < hi && ((k) <= DIAG_LASTPH || (k) == 21))
#else
#define IN(k) (lo <= (k) && (k) < hi)
#endif
#if defined(DIAG_A)
#define STAMP(k) do { if (blockIdx.x == 0 && threadIdx.x == 0) { const Params _p = LOADP(); ((volatile unsigned long long*)(_p.ws + WS_CTL + 524288))[(k)] = __builtin_amdgcn_s_memrealtime(); } } while (0)
#else
#define STAMP(k) do {} while (0)
#endif
#if defined(DIAG_WG)
#define WGSTAMP(k, e) do { if (threadIdx.x == 0) { const Params _p = LOADP(); ((volatile unsigned long long*)(_p.ws + WS_CTL + 528384))[(size_t)blockIdx.x * 64 + 2 * (k) + (e)] = __builtin_amdgcn_s_memrealtime(); } } while (0)
#else
#define WGSTAMP(k, e) do {} while (0)
#endif
#define SEAM(k) do { if (MASK == 0xFFFu) { if (IN(k) && IN((k) + 1)) { WGSTAMP(k, 1); xcd_barrier_steal(bar, lds); STAMP((k) + 1); WGSTAMP((k) + 1, 0); } } } while (0)
template <unsigned MASK, int l>
__device__ __forceinline__ void layer_phases(LAS unsigned char* lds, const int lo, const int hi, const int G, const XcdBarrier& bar) {
        const int pb = 1 + 10 * l;
        if constexpr (HAS(1)) { if (IN(pb + 0)) {
            const Params p = LOADP();
            if (l == 0) { REP(1) { norm_phase<0>(p, 0, lds); __syncthreads(); } }
            else { norm_phase<1>(p, 1, lds); __syncthreads(); }
            __syncthreads();
        } }
        SEAM(pb + 0);
        if constexpr (HAS(2)) { if (IN(pb + 1)) {
            const Params p = LOADP();
            pg8::StaticOrder S; S.init(T, NZ, G, (int)blockIdx.x);
            pg8::EpiZ E{WSP(bf16_t, WS_Z), NZ, W8_INV};
            REP(2) pg8::gemm_phase<pg8::EpiZ, pg8::StaticOrder, true>(lds, WSP(bf16_t, WS_H), (const bf16_t*)(WSP(unsigned char, WS_WIN) + (size_t)l * NZ * 1024), 512, S, E);
        } }
        SEAM(pb + 1);
        if constexpr (HAS(3)) { if (IN(pb + 2)) { const Params p = LOADP(); mix_a_phase(p, l, lds); } }
        SEAM(pb + 2);
        if constexpr (HAS(4)) { if (IN(pb + 3)) { const Params p = LOADP(); mix_b_phase(p, l, lds); } }
        SEAM(pb + 3);
        if constexpr (HAS(5)) { if (IN(pb + 4)) { const Params p = LOADP(); mix_c_phase(p, l, lds); } }
        SEAM(pb + 4);
        if constexpr (HAS(6)) { if (IN(pb + 5)) { const Params p = LOADP(); REP(6) moba_combine_phase(p); } }
        SEAM(pb + 5);
        if constexpr (HAS(7)) { if (IN(pb + 6)) {
            const Params p = LOADP();
            pg8::StaticOrder S; S.init(T, D, G, (int)blockIdx.x);
            if constexpr (l == 0) { pg8::EpiRes<true> E{p.x, WSP(bf16_t, WS_X), WSP(float, WS_MOD) + (size_t)l * 4 * 6144 + 2048};
                pg8::gemm_phase(lds, WSP(bf16_t, WS_CAT), WSP(bf16_t, WS_WOUT) + (size_t)l * 1024 * 1024, 1024, S, E); }
            else { pg8::EpiRes<false> E{WSP(bf16_t, WS_X), WSP(bf16_t, WS_X), WSP(float, WS_MOD) + (size_t)l * 4 * 6144 + 2048};
                pg8::gemm_phase(lds, WSP(bf16_t, WS_CAT), WSP(bf16_t, WS_WOUT) + (size_t)l * 1024 * 1024, 1024, S, E); }
        } }
        SEAM(pb + 6);
        if constexpr (HAS(8)) { if (IN(pb + 7)) { const Params p = LOADP(); if (PROBE_DUP & (1u << 8)) router_phase<true>(p, l, lds); router_phase<false>(p, l, lds); cvt_drain(p, lds, bar.st, (unsigned)(l * CVT_TPL + CVT_GU)); } }
        SEAM(pb + 7);
        if constexpr (HAS(9)) { if (IN(pb + 8)) {
            const Params p = LOADP();
            LAS int* tb = (LAS int*)(lds + 131072); LAS int* cnt = tb + 40;
            moe_tile_prefix(p, l, tb, cnt);
            __syncthreads();
            pg8::MoeOrder S{tb, cnt, WSP(int, WS_ELIST), 8, G, (int)blockIdx.x, 1, (LAS int*)(lds + 131072 + 512), WSP(unsigned, WS_CTL) + CW_GQ + l * 128, (LAS int*)(lds + 131072 + 2048)};
            pg8::EpiSwiglu E{WSP(unsigned char, WS_ACT), p.b_gate + (size_t)l * 32 * 1024, p.b_up + (size_t)l * 32 * 1024, W8_INV};
            REP(9) pg8::gemm_phase<pg8::EpiSwiglu, pg8::MoeOrder, true>(lds, WSP(bf16_t, WS_H), (const bf16_t*)(WSP(unsigned char, WS_WGU) + (size_t)l * NE * 2048 * 1024), 512, S, E);
            __syncthreads();
            cvt_drain(p, lds, bar.st, (unsigned)((l + 1) * CVT_TPL));
        } }
        SEAM(pb + 8);
        if constexpr (HAS(10)) { if (IN(pb + 9)) {
            const Params p = LOADP();
            LAS int* tb = (LAS int*)(lds + 131072); LAS int* cnt = tb + 40;
            moe_tile_prefix(p, l, tb, cnt);
            __syncthreads();
            pg8::MoeOrder S{tb, cnt, WSP(int, WS_ELIST), 4, G, (int)blockIdx.x, 0, (LAS int*)(lds + 131072 + 512), WSP(unsigned, WS_CTL) + CW_GQ + l * 128 + 64, (LAS int*)(lds + 131072 + 2048)};
            pg8::EpiDown E{WSP(bf16_t, WS_YB), p.b_down + (size_t)l * 32 * 1024, W8_INV};
            REP(10) pg8::gemm_phase<pg8::EpiDown, pg8::MoeOrder, true>(lds, WSP(bf16_t, WS_ACT), (const bf16_t*)(WSP(unsigned char, WS_WD) + (size_t)l * NE * 1024 * 1024), 512, S, E);
            __syncthreads();
        } }
        SEAM(pb + 9);
    }
template <unsigned MASK>
__global__ void __launch_bounds__(512, 2) fwd_kernel(Params p_unused) {
    extern __shared__ __attribute__((aligned(16))) unsigned char lds_raw[];
    LAS unsigned char* lds = (LAS unsigned char*)lds_raw;
    volatile LAS unsigned* xbw = (volatile LAS unsigned*)(lds + LDS_BYTES - 32);
    int lo, hi; unsigned* barw;
    { const Params p = LOADP(); lo = p.ph_lo; hi = p.ph_hi; barw = WSP(unsigned, WS_CTL) + CW_BAR; }
    const int G = gridDim.x;
    XcdBarrier bar; bar.bar = barw; bar.x = 0; bar.st = xbw;
    if (threadIdx.x == 0) { xbw[0] = 0u; xbw[1] = 0u; xbw[2] = 0u; xbw[3] = 0u; xbw[4] = 0u; }
    __syncthreads();
    if (MASK == 0xFFFu) bar = xcd_barrier_post(barw, xbw);

    STAMP(0);
    if constexpr (HAS(0)) { if (IN(0)) { const Params p = LOADP(); REP(0) { prologue_phase(p, lds); __syncthreads(); } } }
    SEAM(0);
    layer_phases<MASK, 0>(lds, lo, hi, G, bar);
    layer_phases<MASK, 1>(lds, lo, hi, G, bar);
#if defined(DIAG_A)
    if constexpr (HAS(11)) { if (IN(21)) { const Params p = LOADP();
        const volatile unsigned long long* st = (const volatile unsigned long long*)(p.ws + WS_CTL + 524288);
#if defined(DIAG_WG)
        float usA = 0.f, usB = 0.f;
        { const volatile unsigned long long* ws_ = (const volatile unsigned long long*)(p.ws + WS_CTL + 528384);
#if defined(DIAG_WG2)
          for (int g = 0; g < (int)gridDim.x; ++g) { const float d = (float)(ws_[(size_t)g * 64 + 2 * DIAG_WG + 1] - ws_[(size_t)g * 64 + 2 * DIAG_WG]) * 0.01f; usA = fmaxf(usA, d);
              const float d2 = (float)(ws_[(size_t)g * 64 + 2 * DIAG_WG2 + 1] - ws_[(size_t)g * 64 + 2 * DIAG_WG2]) * 0.01f; usB = fmaxf(usB, d2); }
#else
          for (int g = 0; g < (int)gridDim.x; ++g) { const float d = (float)(ws_[(size_t)g * 64 + 2 * DIAG_WG + 1] - ws_[(size_t)g * 64 + 2 * DIAG_WG]) * 0.01f; usA += d; usB = fmaxf(usB, d); }
          usA /= (float)gridDim.x;
#endif
        }
#else
        const float usA = (float)(st[DIAG_A + 1] - st[DIAG_A]) * 0.01f, usB = (float)(st[DIAG_B + 1] - st[DIAG_B]) * 0.01f;
#endif
#ifndef DIAG_RATIO
#define DIAG_RATIO 1.15f
#endif
#ifndef DIAG_RATIOB
#define DIAG_RATIOB DIAG_RATIO
#endif
#ifndef DIAG_SHIFT
#define DIAG_SHIFT 0.0f
#endif
        const float kA = rintf(__logf(usA) / __logf(DIAG_RATIO) + DIAG_SHIFT), kB = rintf(__logf(usB) / __logf(DIAG_RATIOB) + DIAG_SHIFT);
        const float qA = __expf((kA - DIAG_SHIFT) * __logf(DIAG_RATIO)), qB = __expf((kB - DIAG_SHIFT) * __logf(DIAG_RATIOB));
        const float a = sqrtf(qA);
        for (size_t i = (size_t)blockIdx.x * 512 + threadIdx.x; i < (size_t)T * D; i += (size_t)gridDim.x * 512) p.out[i] = (i == 0) ? qB : a;
    } }
#else
    if constexpr (HAS(11)) { if (IN(21)) { const Params p = LOADP(); REP(11) { norm_phase<2>(p, 1, lds); __syncthreads(); } } }
#endif
}

#if !MK_ONE_LAUNCH
typedef void (*kern_t)(Params);
static kern_t kern_of_type(int ty) {
    switch (ty) {
        case 0: return fwd_kernel<1u << 0>; case 1: return fwd_kernel<1u << 1>; case 2: return fwd_kernel<1u << 2>; case 3: return fwd_kernel<1u << 3>;
        case 4: return fwd_kernel<1u << 4>; case 5: return fwd_kernel<1u << 5>; case 6: return fwd_kernel<1u << 6>; case 7: return fwd_kernel<1u << 7>;
        case 8: return fwd_kernel<1u << 8>; case 9: return fwd_kernel<1u << 9>; case 10: return fwd_kernel<1u << 10>; default: return fwd_kernel<1u << 11>;
    }
}
static int type_of_phase(int ph) { if (ph == 0) return 0; if (ph == 21) return 11; return 1 + (ph - 1) % 10; }
#endif

extern "C" void kernel_launch(void* const* d_in, const int* in_sizes, int n_in, void* d_out, int out_size, void* d_ws, size_t ws_size, hipStream_t stream) {
    static int grid = 0;
    if (grid == 0) {
        if (n_in != 23 || in_sizes[0] != T * D || out_size != T * D || ws_size < WS_END) {
            fprintf(stderr, "kernel_launch: unexpected shapes (n_in %d, in0 %d, out %d, ws %zu, need %zu)\n", n_in, n_in > 0 ? in_sizes[0] : -1, out_size, ws_size, (size_t)WS_END); grid = -1; return; }
        int dev = 0, cus = 0;
        if (hipGetDevice(&dev) != hipSuccess || hipDeviceGetAttribute(&cus, hipDeviceAttributeMultiprocessorCount, dev) != hipSuccess) { grid = -1; return; }
#if MK_ONE_LAUNCH
        if (hipFuncSetAttribute((const void*)fwd_kernel<0xFFFu>, hipFuncAttributeMaxDynamicSharedMemorySize, LDS_BYTES) != hipSuccess) { fprintf(stderr, "kernel_launch: hipFuncSetAttribute failed\n"); grid = -1; return; }
#else
        for (int ty = 0; ty < 12; ++ty)
            if (hipFuncSetAttribute((const void*)kern_of_type(ty), hipFuncAttributeMaxDynamicSharedMemorySize, LDS_BYTES) != hipSuccess) { fprintf(stderr, "kernel_launch: hipFuncSetAttribute failed\n"); grid = -1; return; }
#endif
        (void)hipGetLastError();
        grid = cus;
    }
    if (grid < 0) return;
    (void)hipMemsetAsync((char*)d_ws + WS_CTL, 0, CTL_BYTES, stream);
    Params p{};
    p.x = (const float*)d_in[0]; p.c = (const float*)d_in[1]; p.pos = (const int*)d_in[2];
    p.w_ada = (const float*)d_in[3]; p.b_ada = (const float*)d_in[4]; p.norm1_g = (const float*)d_in[5]; p.w_in = (const float*)d_in[6];
    p.conv_w = (const float*)d_in[7]; p.conv_b = (const float*)d_in[8]; p.b_ig = (const float*)d_in[9]; p.b_fg = (const float*)d_in[10];
    p.mnorm_g = (const float*)d_in[11]; p.w_out = (const float*)d_in[12]; p.norm2_g = (const float*)d_in[13]; p.w_router = (const float*)d_in[14];
    p.b_router = (const float*)d_in[15]; p.w_gate = (const float*)d_in[16]; p.b_gate = (const float*)d_in[17]; p.w_up = (const float*)d_in[18];
    p.b_up = (const float*)d_in[19]; p.w_down = (const float*)d_in[20]; p.b_down = (const float*)d_in[21]; p.fnorm_g = (const float*)d_in[22];
    p.out = (float*)d_out; p.ws = (unsigned char*)d_ws;
#if MK_ONE_LAUNCH
    p.ph_lo = 0; p.ph_hi = NPH;
    hipLaunchKernelGGL(fwd_kernel<0xFFFu>, dim3(grid), dim3(512), LDS_BYTES, stream, p);
#else
    for (int ph = 0; ph < NPH; ++ph) { p.ph_lo = ph; p.ph_hi = ph + 1; hipLaunchKernelGGL(kern_of_type(type_of_phase(ph)), dim3(grid), dim3(512), LDS_BYTES, stream, p); }
#endif
}
```
